# Optimizing an MI355X kernel written in HIP

```python
import math
import jax, jax.numpy as jnp
from jax import lax
import numpy as np

D_MODEL = 4096
BATCH = 4
SEQ = 2048
DEPTH = 1
DEC_BATCH = 32
DEC_SEQ = 1
PAST_LEN = 8192
PAGE_SIZE = 128

HEAD_DIM = 128
N_GROUPS_A = 3
HEADS_PER_GROUP = 8
N_HEADS_A = N_GROUPS_A * HEADS_PER_GROUP
WINDOWS = (128, 512, 2048)
DILATIONS = (1, 4, 16)
QBLOCK = 128
A_OUT = HEADS_PER_GROUP * HEAD_DIM
QKV_WIDTH = 3 * N_HEADS_A * HEAD_DIM
POOL_WINDOWS = (2, 4, 8, 16)
N_POOL_GROUPS = len(POOL_WINDOWS)
POOL_WIDTH = D_MODEL // 2
POOL_GROUP_WIDTH = POOL_WIDTH // N_POOL_GROUPS
POOL_OUT_GROUP = D_MODEL // N_POOL_GROUPS
POOL_HIST = max(POOL_WINDOWS) - 1
IN_WIDTH = QKV_WIDTH + POOL_WIDTH + 2 * D_MODEL
D_FF = -((-8 * D_MODEL) // (3 * 256)) * 256
RMS_EPS = 1e-6
ALIBI_MAX_EXP = 8.0

kernel_name = 'dilated_pool_gated_hybrid_step'


def rms_norm(x, g):
    xf = x.astype(jnp.float32)
    y = xf * lax.rsqrt(jnp.mean(xf * xf, axis=-1, keepdims=True) + RMS_EPS)
    return (y * g.astype(jnp.float32)).astype(x.dtype)


def alibi_slopes():
    s = np.array([2.0 ** (-ALIBI_MAX_EXP * (i + 1) / N_HEADS_A) for i in range(N_HEADS_A)], dtype=np.float32)
    return jnp.asarray(s.reshape(N_GROUPS_A, HEADS_PER_GROUP))


def project_inputs(h, w_in):
    b, t, _ = h.shape
    z = jnp.einsum('btd,de->bte', h, w_in)
    qkv = z[..., :QKV_WIDTH].reshape(b, t, 3, N_GROUPS_A, HEADS_PER_GROUP, HEAD_DIM)
    u = z[..., QKV_WIDTH:QKV_WIDTH + POOL_WIDTH]
    gates = z[..., QKV_WIDTH + POOL_WIDTH:].reshape(b, t, 2, D_MODEL)
    return qkv[:, :, 0], qkv[:, :, 1], qkv[:, :, 2], u, gates


def dilated_band_attention(q, k, v, dil, band, slopes):
    b, s_len, h, dh = q.shape
    n_sub = s_len // dil
    n_blk = -(-n_sub // QBLOCK)
    l_pad = n_blk * QBLOCK

    def to_sub(a):
        a = a.reshape(b, n_sub, dil, h, dh).transpose(0, 2, 1, 3, 4)
        return jnp.pad(a, ((0, 0), (0, 0), (0, l_pad - n_sub), (0, 0), (0, 0)))

    def windows(a):
        a = jnp.pad(a, ((0, 0), (0, 0), (QBLOCK, 0), (0, 0), (0, 0)))
        a = a.reshape(b, dil, n_blk + 1, QBLOCK, h, dh)
        return jnp.concatenate([a[:, :, :-1], a[:, :, 1:]], axis=3)

    qb = to_sub(q).reshape(b, dil, n_blk, QBLOCK, h, dh)
    kw = windows(to_sub(k))
    vw = windows(to_sub(v))
    scores = jnp.einsum('brnqhd,brnkhd->brnhqk', qb, kw,
                        preferred_element_type=jnp.float32) * (HEAD_DIM ** -0.5)
    q_idx = jnp.arange(QBLOCK)
    k_idx = jnp.arange(2 * QBLOCK) - QBLOCK
    delta = q_idx[:, None] - k_idx[None, :]
    k_sub = (jnp.arange(n_blk) * QBLOCK)[:, None, None] + k_idx[None, None, :]
    valid = (delta >= 0) & (delta <= band) & (k_sub >= 0)
    bias = -slopes[:, None, None] * (dil * delta).astype(jnp.float32)[None]
    scores = jnp.where(valid[None, None, :, None], scores + bias[None, None, None], -jnp.inf)
    m = jnp.max(scores, axis=-1)
    p = jnp.exp(scores - m[..., None])
    den = jnp.sum(p, axis=-1)
    num = jnp.einsum('brnhqk,brnkhd->brnqhd', p, vw.astype(jnp.float32))

    def from_sub(a):
        a = a.reshape((b, dil, l_pad) + a.shape[4:])[:, :, :n_sub]
        a = jnp.moveaxis(a, 1, 2)
        return a.reshape((b, s_len) + a.shape[3:])

    return from_sub(num), from_sub(jnp.swapaxes(m, 3, 4)), from_sub(jnp.swapaxes(den, 3, 4))


def dilated_cached_attention(q, k_new, v_new, k_buf, v_buf, dil, band, slopes):
    bd, t_new, h, dh = q.shape
    l_buf = k_buf.shape[1]
    kf = jnp.concatenate([k_buf, k_new.astype(k_buf.dtype)], axis=1)
    vf = jnp.concatenate([v_buf, v_new.astype(v_buf.dtype)], axis=1)
    steps = jnp.arange(band + 1)
    idx = l_buf + jnp.arange(t_new)[:, None] - dil * steps[None, :]
    valid = idx >= 0
    flat = jnp.clip(idx, 0).reshape(-1)
    kg = jnp.take(kf, flat, axis=1).reshape(bd, t_new, band + 1, h, dh)
    vg = jnp.take(vf, flat, axis=1).reshape(bd, t_new, band + 1, h, dh)
    scores = jnp.einsum('bthd,btkhd->bthk', q, kg,
                        preferred_element_type=jnp.float32) * (HEAD_DIM ** -0.5)
    scores = scores - (slopes[:, None] * (dil * steps).astype(jnp.float32)[None, :])[None, None]
    scores = jnp.where(valid[None, :, None, :], scores, -jnp.inf)
    m = jnp.max(scores, axis=-1)
    p = jnp.exp(scores - m[..., None])
    den = jnp.sum(p, axis=-1)
    num = jnp.einsum('bthk,btkhd->bthd', p, vg.astype(jnp.float32))
    return num, m, den, kf[:, t_new:], vf[:, t_new:]


def multi_scale_pool(u_hist, u_new, start_pos):
    b, t_new, _ = u_new.shape
    u = jnp.concatenate([u_hist.astype(jnp.float32), u_new.astype(jnp.float32)], axis=1)
    cs = jnp.concatenate([jnp.zeros((b, 1, POOL_WIDTH), jnp.float32), jnp.cumsum(u, axis=1)], axis=1)
    pos = start_pos + jnp.arange(t_new)
    un = u_new.astype(jnp.float32)
    outs = []
    for g, w in enumerate(POOL_WINDOWS):
        sl = slice(g * POOL_GROUP_WIDTH, (g + 1) * POOL_GROUP_WIDTH)
        tot = cs[:, POOL_HIST + 1:, sl] - cs[:, POOL_HIST + 1 - w:POOL_HIST + 1 - w + t_new, sl]
        cnt = jnp.minimum(w, pos + 1).astype(jnp.float32)
        outs.append(tot / cnt[None, :, None] - un[..., sl])
    return jnp.stack(outs, axis=2)


def finish_layer(x, attn_parts, pooled, gates, w_up_attn, w_pool_map, pool_scale, w_out,
                 norm_ffn, w_ffn_gate, w_ffn_up, w_ffn_down):
    b, t, _ = x.shape
    num = jnp.stack([p[0] for p in attn_parts])
    m = jnp.stack([p[1] for p in attn_parts])
    den = jnp.stack([p[2] for p in attn_parts])
    e = jnp.exp(m - jnp.max(m, axis=0, keepdims=True))
    attn = jnp.sum(e[..., None] * num, axis=0) / jnp.sum(e * den, axis=0)[..., None]
    a = jnp.einsum('bte,ed->btd', attn.reshape(b, t, A_OUT).astype(x.dtype), w_up_attn)
    pb = jnp.einsum('btgc,gce->btge', pooled.astype(x.dtype), w_pool_map).reshape(b, t, D_MODEL) * pool_scale
    mix = jax.nn.sigmoid(gates[:, :, 0]) * a + jax.nn.sigmoid(gates[:, :, 1]) * pb
    x = x + jnp.einsum('btd,de->bte', mix, w_out)
    hf = rms_norm(x, norm_ffn)
    ff = jax.nn.silu(jnp.einsum('btd,df->btf', hf, w_ffn_gate)) * jnp.einsum('btd,df->btf', hf, w_ffn_up)
    return x + jnp.einsum('btf,fd->btd', ff, w_ffn_down)


def setup_inputs(seed: int = 0) -> dict:
    key = jax.random.key(seed)
    ks = jax.random.split(key, 20)
    f32 = jnp.float32

    def nrm(k, shape, scale=1.0):
        return jax.random.normal(k, shape, f32) * scale

    def cache_shape(w):
        return (DEPTH, DEC_BATCH, min(w, PAST_LEN), HEADS_PER_GROUP, HEAD_DIM)

    return {
        'x_prompt': nrm(ks[0], (BATCH, SEQ, D_MODEL)),
        'x_sample': nrm(ks[1], (DEC_BATCH, DEC_SEQ, D_MODEL)),
        'cache_k_w128': nrm(ks[2], cache_shape(WINDOWS[0])),
        'cache_v_w128': nrm(ks[3], cache_shape(WINDOWS[0])),
        'cache_k_w512': nrm(ks[4], cache_shape(WINDOWS[1])),
        'cache_v_w512': nrm(ks[5], cache_shape(WINDOWS[1])),
        'cache_k_w2048': nrm(ks[6], cache_shape(WINDOWS[2])),
        'cache_v_w2048': nrm(ks[7], cache_shape(WINDOWS[2])),
        'state_pool': nrm(ks[8], (DEPTH, DEC_BATCH, POOL_HIST, POOL_WIDTH)),
        'norm_mix': 1.0 + nrm(ks[9], (DEPTH, D_MODEL), 0.02),
        'w_in': nrm(ks[10], (DEPTH, D_MODEL, IN_WIDTH), D_MODEL ** -0.5),
        'w_up_attn': nrm(ks[11], (DEPTH, A_OUT, D_MODEL), A_OUT ** -0.5),
        'w_pool_map': nrm(ks[12], (DEPTH, N_POOL_GROUPS, POOL_GROUP_WIDTH, POOL_OUT_GROUP), POOL_GROUP_WIDTH ** -0.5),
        'pool_scale': 1.0 + nrm(ks[13], (DEPTH, D_MODEL), 0.02),
        'w_out': nrm(ks[14], (DEPTH, D_MODEL, D_MODEL), D_MODEL ** -0.5),
        'norm_ffn': 1.0 + nrm(ks[15], (DEPTH, D_MODEL), 0.02),
        'w_ffn_gate': nrm(ks[16], (DEPTH, D_MODEL, D_FF), D_MODEL ** -0.5),
        'w_ffn_up': nrm(ks[17], (DEPTH, D_MODEL, D_FF), D_MODEL ** -0.5),
        'w_ffn_down': nrm(ks[18], (DEPTH, D_FF, D_MODEL), D_FF ** -0.5),
        'norm_final': 1.0 + nrm(ks[19], (D_MODEL,), 0.02),
    }


def reference(x_prompt, x_sample, cache_k_w128, cache_v_w128, cache_k_w512, cache_v_w512,
              cache_k_w2048, cache_v_w2048, state_pool, norm_mix, w_in, w_up_attn, w_pool_map,
              pool_scale, w_out, norm_ffn, w_ffn_gate, w_ffn_up, w_ffn_down, norm_final):
    slopes = alibi_slopes()
    k_caches = (cache_k_w128, cache_k_w512, cache_k_w2048)
    v_caches = (cache_v_w128, cache_v_w512, cache_v_w2048)
    xp, xs = x_prompt, x_sample
    n_prompt, seq_len = x_prompt.shape[0], x_prompt.shape[1]
    kp_out = [[] for _ in WINDOWS]
    vp_out = [[] for _ in WINDOWS]
    ksm_out = [[] for _ in WINDOWS]
    vsm_out = [[] for _ in WINDOWS]
    pool_p_out, pool_s_out = [], []
    for l in range(DEPTH):
        hp = rms_norm(xp, norm_mix[l])
        hs = rms_norm(xs, norm_mix[l])
        qp, kp, vp, up, gp = project_inputs(hp, w_in[l])
        qs, ksm, vsm, us, gs = project_inputs(hs, w_in[l])
        parts_p, parts_s = [], []
        for g in range(N_GROUPS_A):
            dil = DILATIONS[g]
            band = WINDOWS[g] // dil
            parts_p.append(dilated_band_attention(qp[:, :, g], kp[:, :, g], vp[:, :, g], dil, band, slopes[g]))
            num, m, den, kb, vb = dilated_cached_attention(
                qs[:, :, g], ksm[:, :, g], vsm[:, :, g], k_caches[g][l], v_caches[g][l], dil, band, slopes[g])
            parts_s.append((num, m, den))
            rows = min(WINDOWS[g], seq_len)
            kp_out[g].append(kp[:, seq_len - rows:, g])
            vp_out[g].append(vp[:, seq_len - rows:, g])
            ksm_out[g].append(kb)
            vsm_out[g].append(vb)
        pooled_p = multi_scale_pool(jnp.zeros((n_prompt, POOL_HIST, POOL_WIDTH), up.dtype), up, 0)
        pooled_s = multi_scale_pool(state_pool[l], us, PAST_LEN)
        pool_p_out.append(up[:, seq_len - POOL_HIST:])
        pool_s_out.append(jnp.concatenate([state_pool[l], us.astype(state_pool.dtype)], axis=1)[:, -POOL_HIST:])
        xp = finish_layer(xp, parts_p, pooled_p, gp, w_up_attn[l], w_pool_map[l], pool_scale[l], w_out[l],
                          norm_ffn[l], w_ffn_gate[l], w_ffn_up[l], w_ffn_down[l])
        xs = finish_layer(xs, parts_s, pooled_s, gs, w_up_attn[l], w_pool_map[l], pool_scale[l], w_out[l],
                          norm_ffn[l], w_ffn_gate[l], w_ffn_up[l], w_ffn_down[l])
    y_prompt = rms_norm(xp, norm_final)
    y_sample = rms_norm(xs, norm_final)
    return (y_prompt, y_sample,
            jnp.stack(kp_out[0]), jnp.stack(vp_out[0]), jnp.stack(kp_out[1]), jnp.stack(vp_out[1]),
            jnp.stack(kp_out[2]), jnp.stack(vp_out[2]), jnp.stack(pool_p_out),
            jnp.stack(ksm_out[0]), jnp.stack(vsm_out[0]), jnp.stack(ksm_out[1]), jnp.stack(vsm_out[1]),
            jnp.stack(ksm_out[2]), jnp.stack(vsm_out[2]), jnp.stack(pool_s_out))
```

```cpp
#include <hip/hip_runtime.h>
#include <cstdio>
#include <cstdint>
#include <cmath>
namespace pg8 {
#define PG8_LAS __attribute__((address_space(3)))
typedef unsigned short bf16_t;
typedef short bf16x8 __attribute__((ext_vector_type(8)));
typedef float f32x4 __attribute__((ext_vector_type(4)));
typedef unsigned u32x4 __attribute__((ext_vector_type(4)));
constexpr int BM = 256, BK = 64, HALF = 128, HTB = HALF * BK * 2  , STAGE_BYTES = 8 * HTB, NXCD = 8, WGM = 8;

__host__ __device__ __forceinline__ int lds_byte(int r, int c) { const int st = (r >> 4) * 2 + (c >> 5), rr = r & 15, cc = c & 31, ob = rr * 64 + cc * 2; return st * 1024 + (ob ^ (((ob >> 9) & 1) << 5)); }
__host__ __device__ __forceinline__ void stage_rc(int b, int& R, int& C) { const int st = b / 1024, sb = b % 1024, swz = sb ^ (((sb >> 9) & 1) << 5); R = (st >> 1) * 16 + swz / 64; C = (st & 1) * 32 + (swz % 64) / 2; }
__host__ __device__ __forceinline__ int perm32(int rho) { const int n = rho >> 4, i = rho & 15; return 8 * (i >> 2) + 4 * n + (i & 3); }

struct Unit { int pm, pn; };
struct Gemm { const bf16_t* A; const bf16_t* Bt; int K, lda, ashift; size_t astride; };

struct StaticOrder {
    int nM, nN, nwg, G, c;
    __host__ __device__ void init(int M, int N, int G_, int c_) { nM = M / BM; nN = N / BM; nwg = nM * nN; G = G_; c = c_; }
    __host__ __device__ bool next(int i, Unit& u) const {
        const long L = (long)i * G + c; if (L >= nwg) return false;
        int wgid = (int)L; { const int q = nwg / NXCD, r = nwg % NXCD, xcd = wgid % NXCD, off = wgid / NXCD; wgid = (xcd < r ? xcd * (q + 1) : r * (q + 1) + (xcd - r) * q) + off; }
        const int nig = WGM * nN, gid = wgid / nig, fm = gid * WGM, gsz = (nM - fm) < WGM ? (nM - fm) : WGM;
        u.pm = fm + ((wgid % nig) % gsz); u.pn = (wgid % nig) / gsz; return true;
    }
    __device__ __forceinline__ void a_ready(const Unit&) const {}
    __device__ __forceinline__ void done(const Unit&) const {}
};

typedef float f32x2_cv __attribute__((ext_vector_type(2))); typedef __bf16 bf16x2_cv __attribute__((ext_vector_type(2)));
__device__ __forceinline__ unsigned cvt_pk_bf16(float lo, float hi) { const f32x2_cv v = {lo, hi}; const bf16x2_cv b = __builtin_convertvector(v, bf16x2_cv); return __builtin_bit_cast(unsigned, b); }
typedef float f32x2 __attribute__((ext_vector_type(2)));

struct NoBg { __device__ __forceinline__ void step() {} __device__ __forceinline__ void flush() {} };
template <class Epi, class Sched, bool ALIGN_EPI = false, bool SP2 = false, class Bg = NoBg>
__device__ __forceinline__ void gemm_phase(PG8_LAS unsigned char* lds, const Gemm g, const Sched& S, const Epi& E, Bg& bg) {
    const int tid = threadIdx.x, wid = __builtin_amdgcn_readfirstlane(tid >> 6), lane = tid & 63, wr = wid >> 2, wc = wid & 3, fr = lane & 15, fq = lane >> 4;
    const int K = g.K, nt = K / BK, lda = g.lda;
    unsigned voffA[2], voffB[2];
#pragma unroll
    for (int i = 0; i < 2; ++i) { int R, C; stage_rc(tid * 16 + i * 8192, R, C); const int Rb = Epi::PERM ? ((R & ~31) + perm32(R & 31)) : R;
        voffA[i] = (unsigned)(R * lda + C) * 2u; voffB[i] = (unsigned)(Rb * K + C) * 2u; }
    const size_t kstep = (size_t)(BK * 2);
    const size_t hsB = (size_t)HALF * K * 2, hsA = (size_t)HALF * lda * 2;
    const size_t tsB = 2 * hsB, tsA = 2 * hsA;
    const unsigned ldsw = (unsigned)wid * 1024u;
    const int aoff = lds_byte(wr * 64 + fr, fq * 8), boff = lds_byte(wc * 32 + fr, fq * 8);
#define PG8_SA(b, h) (((b) * 2 + (h)) * HTB)
#define PG8_SB(b, h) ((4 + (b) * 2 + (h)) * HTB)
#define PG8_STAGE(bufoff, gbase, voff) do { _Pragma("unroll") for (int _i = 0; _i < 2; ++_i) \
        __builtin_amdgcn_global_load_lds((const unsigned*)((const char*)(gbase) + (voff)[_i]), (PG8_LAS unsigned*)(lds + (bufoff) + ldsw + _i * 8192), 16, 0, 0); } while (0)
#define PG8_LDA(dst, b, h) do { _Pragma("unroll") for (int m = 0; m < 4; ++m) _Pragma("unroll") for (int k = 0; k < 2; ++k) dst[m][k] = *(const PG8_LAS bf16x8*)(lds + PG8_SA(b, h) + aoff + m * 2048 + k * 1024); } while (0)
#define PG8_LDB(dst, b, h) do { _Pragma("unroll") for (int n = 0; n < 2; ++n) _Pragma("unroll") for (int k = 0; k < 2; ++k) dst[n][k] = *(const PG8_LAS bf16x8*)(lds + PG8_SB(b, h) + boff + n * 2048 + k * 1024); } while (0)
#define PG8_MMA(ai, bj, At, Bt) do { __builtin_amdgcn_s_setprio(1); _Pragma("unroll") for (int m = 0; m < 4; ++m) _Pragma("unroll") for (int n = 0; n < 2; ++n) _Pragma("unroll") for (int k = 0; k < 2; ++k) \
        acc[ai][bj][m][n] = __builtin_amdgcn_mfma_f32_16x16x32_bf16(Bt[n][k], At[m][k], acc[ai][bj][m][n], 0, 0, 0); __builtin_amdgcn_s_setprio(0); } while (0)
#define PG8_WAIT_V(n) asm volatile("s_waitcnt vmcnt(" #n ")" ::: "memory")
#define PG8_WAIT_L(n) asm volatile("s_waitcnt lgkmcnt(" #n ")" ::: "memory")
#define PG8_BAR __builtin_amdgcn_s_barrier()
#define PG8_SCHED __builtin_amdgcn_sched_barrier(0)
    Unit cur, nxt; int ui = 0;
    if (!S.next(0, cur)) return;
    f32x4 acc[2][2][4][2];
#pragma unroll
    for (int a = 0; a < 2; ++a)
#pragma unroll
        for (int b = 0; b < 2; ++b)
#pragma unroll
            for (int m = 0; m < 4; ++m)
#pragma unroll
                for (int n = 0; n < 2; ++n) acc[a][b][m][n] = (f32x4){0.f, 0.f, 0.f, 0.f};
    bf16x8 At[4][2], B0[2][2], B1[2][2];
    const char* cA = (const char*)g.A + (size_t)cur.pm * tsA + (size_t)(cur.pn >> g.ashift) * g.astride; const char* cB = (const char*)g.Bt + (size_t)cur.pn * tsB;
    S.a_ready(cur);
    if constexpr (SP2) {
        PG8_STAGE(PG8_SB(0, 0), cB, voffB); PG8_STAGE(PG8_SB(0, 1), cB + hsB, voffB); PG8_STAGE(PG8_SA(0, 0), cA, voffA); PG8_STAGE(PG8_SA(0, 1), cA + hsA, voffA);
        if (wr == 1) PG8_BAR;
        PG8_WAIT_V(2); PG8_BAR;
        PG8_STAGE(PG8_SB(1, 0), cB + kstep, voffB); PG8_STAGE(PG8_SA(1, 0), cA + kstep, voffA); PG8_STAGE(PG8_SB(1, 1), cB + hsB + kstep, voffB);
        PG8_WAIT_V(6); PG8_BAR;
    } else {
        PG8_STAGE(PG8_SB(0, 0), cB, voffB); PG8_STAGE(PG8_SA(0, 0), cA, voffA); PG8_STAGE(PG8_SB(0, 1), cB + hsB, voffB); PG8_STAGE(PG8_SA(0, 1), cA + hsA, voffA);
        if (wr == 1) PG8_BAR;
        PG8_WAIT_V(4); PG8_BAR;
        PG8_STAGE(PG8_SB(1, 0), cB + kstep, voffB); PG8_STAGE(PG8_SA(1, 0), cA + kstep, voffA); PG8_STAGE(PG8_SB(1, 1), cB + hsB + kstep, voffB);
        PG8_WAIT_V(6); PG8_BAR;
    }
    for (;;) {
        const bool has_next = S.next(ui + 1, nxt);
        const char* nA = has_next ? (const char*)g.A + (size_t)nxt.pm * tsA + (size_t)(nxt.pn >> g.ashift) * g.astride : cA; const char* nB = has_next ? (const char*)g.Bt + (size_t)nxt.pn * tsB : cB;
        for (int t = 0; t < nt; t += 2) {
            const bool last = (t == nt - 2);
            const char* a1 = cA + (size_t)(t + 1) * kstep;
            const char* a2 = last ? nA : cA + (size_t)(t + 2) * kstep; const char* b2 = last ? nB : cB + (size_t)(t + 2) * kstep;
            const char* a3 = a2 + kstep; const char* b3 = b2 + kstep;
            if (last && has_next) S.a_ready(nxt);
            bg.step();
            if constexpr (SP2) {
            PG8_LDB(B0, 0, 0); PG8_LDB(B1, 0, 1); PG8_SCHED; PG8_LDA(At, 0, 0); PG8_STAGE(PG8_SA(1, 1), a1 + hsA, voffA);
            PG8_WAIT_V(8); PG8_WAIT_L(0); PG8_BAR; PG8_MMA(0, 0, At, B0); PG8_MMA(0, 1, At, B1); PG8_BAR; PG8_SCHED;
            PG8_LDA(At, 0, 1); PG8_STAGE(PG8_SB(0, 0), b2, voffB); PG8_STAGE(PG8_SB(0, 1), b2 + hsB, voffB); PG8_STAGE(PG8_SA(0, 0), a2, voffA);
            PG8_WAIT_V(8); PG8_WAIT_L(0); PG8_BAR; PG8_MMA(1, 0, At, B0); PG8_MMA(1, 1, At, B1); PG8_BAR; PG8_SCHED;
            PG8_LDB(B0, 1, 0); PG8_LDB(B1, 1, 1); PG8_SCHED; PG8_LDA(At, 1, 0); PG8_STAGE(PG8_SA(0, 1), a2 + hsA, voffA);
            PG8_WAIT_V(8); PG8_WAIT_L(0); PG8_BAR; PG8_MMA(0, 0, At, B0); PG8_MMA(0, 1, At, B1); PG8_BAR; PG8_SCHED;
            PG8_LDA(At, 1, 1); PG8_STAGE(PG8_SB(1, 0), b3, voffB); PG8_STAGE(PG8_SB(1, 1), b3 + hsB, voffB); PG8_STAGE(PG8_SA(1, 0), a3, voffA);
            PG8_WAIT_V(8); PG8_WAIT_L(0); PG8_BAR; PG8_MMA(1, 0, At, B0); PG8_MMA(1, 1, At, B1); PG8_BAR; PG8_SCHED;
            } else {
            PG8_LDB(B0, 0, 0); PG8_SCHED; PG8_LDA(At, 0, 0); PG8_STAGE(PG8_SA(1, 1), a1 + hsA, voffA);
            PG8_WAIT_L(8); PG8_BAR; PG8_WAIT_L(0); PG8_MMA(0, 0, At, B0); PG8_BAR; PG8_SCHED;
            PG8_LDB(B1, 0, 1); PG8_STAGE(PG8_SB(0, 0), b2, voffB);
            PG8_BAR; PG8_WAIT_L(0); PG8_MMA(0, 1, At, B1); PG8_BAR;
            PG8_LDA(At, 0, 1); PG8_STAGE(PG8_SA(0, 0), a2, voffA);
            PG8_BAR; PG8_WAIT_L(0); PG8_MMA(1, 0, At, B0); PG8_BAR; PG8_SCHED;
            PG8_STAGE(PG8_SB(0, 1), b2 + hsB, voffB);
            PG8_WAIT_V(6); PG8_BAR; PG8_MMA(1, 1, At, B1); PG8_BAR;
            PG8_LDB(B0, 1, 0); PG8_SCHED; PG8_LDA(At, 1, 0); PG8_STAGE(PG8_SA(0, 1), a2 + hsA, voffA);
            PG8_WAIT_L(8); PG8_BAR; PG8_WAIT_L(0); PG8_MMA(0, 0, At, B0); PG8_BAR; PG8_SCHED;
            PG8_LDB(B1, 1, 1); PG8_STAGE(PG8_SB(1, 0), b3, voffB);
            PG8_BAR; PG8_WAIT_L(0); PG8_MMA(0, 1, At, B1); PG8_BAR;
            PG8_LDA(At, 1, 1); PG8_STAGE(PG8_SA(1, 0), a3, voffA);
            PG8_BAR; PG8_WAIT_L(0); PG8_MMA(1, 0, At, B0); PG8_BAR; PG8_SCHED;
            PG8_STAGE(PG8_SB(1, 1), b3 + hsB, voffB);
            PG8_WAIT_V(6); PG8_BAR; PG8_MMA(1, 1, At, B1); PG8_BAR;
            }
        }
        if constexpr (ALIGN_EPI) { if (wr == 0) PG8_BAR; }
        if constexpr (!Epi::AFTER_DRAIN) { E(acc, cur, wr, wc, fr, fq); S.done(cur); }
        if (!has_next) break;
#pragma unroll
        for (int a = 0; a < 2; ++a)
#pragma unroll
            for (int b = 0; b < 2; ++b)
#pragma unroll
                for (int m = 0; m < 4; ++m)
#pragma unroll
                    for (int n = 0; n < 2; ++n) acc[a][b][m][n] = (f32x4){0.f, 0.f, 0.f, 0.f};
        cur = nxt; cA = nA; cB = nB; ++ui;
        if constexpr (ALIGN_EPI) { if (wr == 1) PG8_BAR; }
    }
    bg.flush();
    PG8_WAIT_V(0);
    if constexpr (!ALIGN_EPI) { if (wr == 0) PG8_BAR; }
    PG8_BAR;
    if constexpr (Epi::AFTER_DRAIN) { E.fused(acc, cur, wr, wc, fr, fq, lds, wid, lane); S.done(cur); }
#undef PG8_SA
#undef PG8_SB
#undef PG8_STAGE
#undef PG8_LDA
#undef PG8_LDB
#undef PG8_MMA
#undef PG8_WAIT_V
#undef PG8_WAIT_L
#undef PG8_BAR
#undef PG8_SCHED
}
}

constexpr int D = 4096, NB = 4, SEQ = 2048, MPR = NB * SEQ  , NSMP = 32, MREAL = MPR + NSMP  , MP = 8448  ;
constexpr int HD = 128, NH = 8, GW = NH * HD  , QKVW = 3 * GW  , PW = 2048, INW = 3 * QKVW + PW + 2 * D  , FF = 11008;
constexpr int PHIST = 15;
constexpr float RMS_EPS = 1e-6f;
constexpr size_t O_Y = 0;
constexpr size_t O_KP0 = (size_t)MREAL * D;
constexpr size_t O_VP0 = O_KP0 + (size_t)NB * 128 * GW;
constexpr size_t O_KP1 = O_VP0 + (size_t)NB * 128 * GW;
constexpr size_t O_VP1 = O_KP1 + (size_t)NB * 512 * GW;
constexpr size_t O_KP2 = O_VP1 + (size_t)NB * 512 * GW;
constexpr size_t O_VP2 = O_KP2 + (size_t)NB * 2048 * GW;
constexpr size_t O_PP  = O_VP2 + (size_t)NB * 2048 * GW;
constexpr size_t O_KS0 = O_PP + (size_t)NB * PHIST * PW;
constexpr size_t O_VS0 = O_KS0 + (size_t)NSMP * 128 * GW;
constexpr size_t O_KS1 = O_VS0 + (size_t)NSMP * 128 * GW;
constexpr size_t O_VS1 = O_KS1 + (size_t)NSMP * 512 * GW;
constexpr size_t O_KS2 = O_VS1 + (size_t)NSMP * 512 * GW;
constexpr size_t O_VS2 = O_KS2 + (size_t)NSMP * 2048 * GW;
constexpr size_t O_PS  = O_VS2 + (size_t)NSMP * 2048 * GW;
constexpr size_t O_END = O_PS + (size_t)NSMP * PHIST * PW;

namespace pg8 {
__device__ __forceinline__ float bf_lo(unsigned w) { return __uint_as_float(w << 16); }
__device__ __forceinline__ float bf_hi(unsigned w) { return __uint_as_float(w & 0xffff0000u); }
__device__ __forceinline__ float sigmoidf_(float x) { return __builtin_amdgcn_rcpf(1.0f + __builtin_amdgcn_exp2f(-1.4426950408889634f * x)); }

struct EpiIn {
    static constexpr bool PERM = true, AFTER_DRAIN = false;
    bf16_t *QB; size_t qkv_stride  ; bf16_t* GB; float* UB; float* out; float qscale;
    __device__ __forceinline__ void operator()(const f32x4 (&acc)[2][2][4][2], const Unit& u, int wr, int wc, int fr, int fq) const {
        const int colt = u.pn * BM, cl = wc * 32 + 8 * fq, rbase = u.pm * BM + wr * 64 + fr;
        if (colt < 3 * QKVW) {
            const int which = colt / QKVW, c3 = colt - which * QKVW;
            bf16_t* B = QB + (size_t)which * qkv_stride; const float sc = which == 0 ? qscale : 1.0f;
#pragma unroll
            for (int ai = 0; ai < 2; ++ai)
#pragma unroll
                for (int m = 0; m < 4; ++m) { bf16_t* rowp = B + (size_t)(rbase + ai * HALF + m * 16) * QKVW + c3 + cl;
#pragma unroll
                    for (int bj = 0; bj < 2; ++bj) { const f32x4 v0 = acc[ai][bj][m][0] * sc, v1 = acc[ai][bj][m][1] * sc; u32x4 w;
                        w.x = cvt_pk_bf16(v0[0], v0[1]); w.y = cvt_pk_bf16(v0[2], v0[3]); w.z = cvt_pk_bf16(v1[0], v1[1]); w.w = cvt_pk_bf16(v1[2], v1[3]);
                        *(u32x4*)(rowp + bj * HALF) = w; } }
            if (which != 0) {
                const int g = c3 / GW, cg = c3 - g * GW + cl, W = g == 0 ? 128 : (g == 1 ? 512 : 2048);
                float* op = out + (g == 0 ? (which == 1 ? O_KP0 : O_VP0) : g == 1 ? (which == 1 ? O_KP1 : O_VP1) : (which == 1 ? O_KP2 : O_VP2));
                float* os = out + (g == 0 ? (which == 1 ? O_KS0 : O_VS0) : g == 1 ? (which == 1 ? O_KS1 : O_VS1) : (which == 1 ? O_KS2 : O_VS2));
#pragma unroll
                for (int ai = 0; ai < 2; ++ai)
#pragma unroll
                    for (int m = 0; m < 4; ++m) { const int row = rbase + ai * HALF + m * 16; float* dst = nullptr;
                        if (row < MPR) { const int b = row >> 11, tt = (row & (SEQ - 1)) - (SEQ - W); if (tt >= 0) dst = op + ((size_t)(b * W + tt)) * GW + cg; }
                        else if (row < MREAL) { dst = os + ((size_t)((row - MPR) * W + (W - 1))) * GW + cg; }
                        if (dst) {
#pragma unroll
                            for (int bj = 0; bj < 2; ++bj)
#pragma unroll
                                for (int n = 0; n < 2; ++n) *(f32x4*)(dst + bj * HALF + 4 * n) = acc[ai][bj][m][n]; } }
            }
        } else if (colt < 3 * QKVW + PW) {
            const int c = colt - 3 * QKVW + cl;
#pragma unroll
            for (int ai = 0; ai < 2; ++ai)
#pragma unroll
                for (int m = 0; m < 4; ++m) { const int row = rbase + ai * HALF + m * 16; float* up = UB + (size_t)row * PW + c; float* dst = nullptr;
                    if (row < MPR) { const int b = row >> 11, tt = (row & (SEQ - 1)) - (SEQ - PHIST); if (tt >= 0) dst = out + O_PP + ((size_t)(b * PHIST + tt)) * PW + c; }
                    else if (row < MREAL) { dst = out + O_PS + ((size_t)((row - MPR) * PHIST + (PHIST - 1))) * PW + c; }
#pragma unroll
                    for (int bj = 0; bj < 2; ++bj)
#pragma unroll
                        for (int n = 0; n < 2; ++n) { *(f32x4*)(up + bj * HALF + 4 * n) = acc[ai][bj][m][n]; if (dst) *(f32x4*)(dst + bj * HALF + 4 * n) = acc[ai][bj][m][n]; } }
        } else {
            const int c = colt - (3 * QKVW + PW) + cl;
#pragma unroll
            for (int ai = 0; ai < 2; ++ai)
#pragma unroll
                for (int m = 0; m < 4; ++m) { bf16_t* rowp = GB + (size_t)(rbase + ai * HALF + m * 16) * (2 * D) + c;
#pragma unroll
                    for (int bj = 0; bj < 2; ++bj) { const f32x4 v0 = acc[ai][bj][m][0], v1 = acc[ai][bj][m][1]; u32x4 w;
                        w.x = cvt_pk_bf16(sigmoidf_(v0[0]), sigmoidf_(v0[1])); w.y = cvt_pk_bf16(sigmoidf_(v0[2]), sigmoidf_(v0[3]));
                        w.z = cvt_pk_bf16(sigmoidf_(v1[0]), sigmoidf_(v1[1])); w.w = cvt_pk_bf16(sigmoidf_(v1[2]), sigmoidf_(v1[3]));
                        *(u32x4*)(rowp + bj * HALF) = w; } }
        }
    }
};

#define EPI_FENCE() asm volatile("" ::: "memory")
struct EpiPool {
    static constexpr bool PERM = true, AFTER_DRAIN = false;
    const bf16_t* GB; const float* pscale; bf16_t* T;
    __device__ __forceinline__ void operator()(const f32x4 (&acc)[2][2][4][2], const Unit& u, int wr, int wc, int fr, int fq) const {
        const int col0 = u.pn * BM + wc * 32 + 8 * fq, rbase = u.pm * BM + wr * 64 + fr;
        f32x4 sv[2][2];
#pragma unroll
        for (int bj = 0; bj < 2; ++bj)
#pragma unroll
            for (int n = 0; n < 2; ++n) sv[bj][n] = *(const f32x4*)(pscale + col0 + bj * HALF + 4 * n);
#pragma unroll
        for (int ai = 0; ai < 2; ++ai) {
            u32x4 gq[4][2];
#pragma unroll
            for (int m = 0; m < 4; ++m)
#pragma unroll
                for (int bj = 0; bj < 2; ++bj) gq[m][bj] = *(const u32x4*)(GB + (size_t)(rbase + ai * HALF + m * 16) * (2 * D) + D + col0 + bj * HALF);
            EPI_FENCE();
#pragma unroll
            for (int m = 0; m < 4; ++m) { const size_t row = (size_t)(rbase + ai * HALF + m * 16);
#pragma unroll
                for (int bj = 0; bj < 2; ++bj) { const u32x4 g = gq[m][bj];
                    const f32x4 v0 = acc[ai][bj][m][0] * sv[bj][0], v1 = acc[ai][bj][m][1] * sv[bj][1]; u32x4 w;
                    w.x = cvt_pk_bf16(v0[0] * bf_lo(g.x), v0[1] * bf_hi(g.x)); w.y = cvt_pk_bf16(v0[2] * bf_lo(g.y), v0[3] * bf_hi(g.y));
                    w.z = cvt_pk_bf16(v1[0] * bf_lo(g.z), v1[1] * bf_hi(g.z)); w.w = cvt_pk_bf16(v1[2] * bf_lo(g.w), v1[3] * bf_hi(g.w));
                    *(u32x4*)(T + row * D + col0 + bj * HALF) = w; } }
            EPI_FENCE();
        }
    }
};
struct EpiUp {
    static constexpr bool PERM = true, AFTER_DRAIN = false;
    const bf16_t* GB; const bf16_t* T; bf16_t* MIX;
    __device__ __forceinline__ void operator()(const f32x4 (&acc)[2][2][4][2], const Unit& u, int wr, int wc, int fr, int fq) const {
        const int col0 = u.pn * BM + wc * 32 + 8 * fq, rbase = u.pm * BM + wr * 64 + fr;
#pragma unroll
        for (int ai = 0; ai < 2; ++ai) {
            u32x4 gq[4][2], tq[4][2];
#pragma unroll
            for (int m = 0; m < 4; ++m)
#pragma unroll
                for (int bj = 0; bj < 2; ++bj) { const size_t row = (size_t)(rbase + ai * HALF + m * 16);
                    gq[m][bj] = *(const u32x4*)(GB + row * (2 * D) + col0 + bj * HALF); tq[m][bj] = *(const u32x4*)(T + row * D + col0 + bj * HALF); }
            EPI_FENCE();
#pragma unroll
            for (int m = 0; m < 4; ++m) { const size_t row = (size_t)(rbase + ai * HALF + m * 16);
#pragma unroll
                for (int bj = 0; bj < 2; ++bj) { const u32x4 g = gq[m][bj], t = tq[m][bj];
                    const f32x4 v0 = acc[ai][bj][m][0], v1 = acc[ai][bj][m][1]; u32x4 w;
                    w.x = cvt_pk_bf16(v0[0] * bf_lo(g.x) + bf_lo(t.x), v0[1] * bf_hi(g.x) + bf_hi(t.x)); w.y = cvt_pk_bf16(v0[2] * bf_lo(g.y) + bf_lo(t.y), v0[3] * bf_hi(g.y) + bf_hi(t.y));
                    w.z = cvt_pk_bf16(v1[0] * bf_lo(g.z) + bf_lo(t.z), v1[1] * bf_hi(g.z) + bf_hi(t.z)); w.w = cvt_pk_bf16(v1[2] * bf_lo(g.w) + bf_lo(t.w), v1[3] * bf_hi(g.w) + bf_hi(t.w));
                    *(u32x4*)(MIX + row * D + col0 + bj * HALF) = w; } }
            EPI_FENCE();
        }
    }
};
struct EpiOut {
    static constexpr bool PERM = false, AFTER_DRAIN = false;
    const float* xp; const float* xs; float* y; bf16_t* X1B; float* rowss;
    __device__ __forceinline__ void operator()(const f32x4 (&acc)[2][2][4][2], const Unit& u, int wr, int wc, int fr, int fq) const {
        const int col0 = u.pn * BM + wc * 32 + 4 * fq, rbase = u.pm * BM + wr * 64 + fr;
        typedef unsigned u32x2v __attribute__((ext_vector_type(2)));
#pragma unroll
        for (int ai = 0; ai < 2; ++ai) {
            f32x4 xin[4][2][2];
#pragma unroll
            for (int m = 0; m < 4; ++m) { const int row = rbase + ai * HALF + m * 16; const int rc = row < MREAL ? row : MREAL - 1;
                const float* xr = (rc < MPR ? xp + (size_t)rc * D : xs + (size_t)(rc - MPR) * D) + col0;
#pragma unroll
                for (int bj = 0; bj < 2; ++bj)
#pragma unroll
                    for (int n = 0; n < 2; ++n) xin[m][bj][n] = *(const f32x4*)(xr + bj * HALF + n * 16); }
            EPI_FENCE();
#pragma unroll
            for (int m = 0; m < 4; ++m) { const int row = rbase + ai * HALF + m * 16; const bool real = row < MREAL; float ss = 0.f;
#pragma unroll
                for (int bj = 0; bj < 2; ++bj)
#pragma unroll
                    for (int n = 0; n < 2; ++n) { const f32x4 o = acc[ai][bj][m][n] + xin[m][bj][n];
                        if (real) *(f32x4*)(y + (size_t)row * D + col0 + bj * HALF + n * 16) = o;
                        u32x2v w; w.x = cvt_pk_bf16(o[0], o[1]); w.y = cvt_pk_bf16(o[2], o[3]); *(u32x2v*)(X1B + (size_t)row * D + col0 + bj * HALF + n * 16) = w;
                        ss += (o[0] * o[0] + o[1] * o[1]) + (o[2] * o[2] + o[3] * o[3]); }
                ss += __shfl_xor(ss, 16); ss += __shfl_xor(ss, 32);
                if (fq == 0 && real) atomicAdd(rowss + row, ss); }
            EPI_FENCE();
        }
    }
};
struct EpiFF {
    static constexpr bool PERM = true, AFTER_DRAIN = false;
    const float* rowss; bf16_t* FFB;
    __device__ __forceinline__ void operator()(const f32x4 (&acc)[2][2][4][2], const Unit& u, int wr, int wc, int fr, int fq) const {
        const int col0 = u.pn * HALF + wc * 32 + 8 * fq, rbase = u.pm * BM + wr * 64 + fr;
        float rs[2][4];
#pragma unroll
        for (int ai = 0; ai < 2; ++ai)
#pragma unroll
            for (int m = 0; m < 4; ++m) rs[ai][m] = rowss[rbase + ai * HALF + m * 16];
        EPI_FENCE();
#pragma unroll
        for (int ai = 0; ai < 2; ++ai)
#pragma unroll
            for (int m = 0; m < 4; ++m) { const int row = rbase + ai * HALF + m * 16; const float r = 1.0f / sqrtf(rs[ai][m] * (1.0f / D) + RMS_EPS);
                u32x4 w; float o[8];
#pragma unroll
                for (int n = 0; n < 2; ++n)
#pragma unroll
                    for (int j = 0; j < 4; ++j) { const float gv = acc[ai][0][m][n][j] * r, uv = acc[ai][1][m][n][j] * r; o[4 * n + j] = gv * sigmoidf_(gv) * uv; }
                w.x = cvt_pk_bf16(o[0], o[1]); w.y = cvt_pk_bf16(o[2], o[3]); w.z = cvt_pk_bf16(o[4], o[5]); w.w = cvt_pk_bf16(o[6], o[7]);
                *(u32x4*)(FFB + (size_t)row * FF + col0) = w; }
    }
};
struct EpiDown {
    static constexpr bool PERM = false, AFTER_DRAIN = false;
    float* y;
    __device__ __forceinline__ void operator()(const f32x4 (&acc)[2][2][4][2], const Unit& u, int wr, int wc, int fr, int fq) const {
        const int col0 = u.pn * BM + wc * 32 + 4 * fq, rbase = u.pm * BM + wr * 64 + fr;
#pragma unroll
        for (int ai = 0; ai < 2; ++ai) {
            f32x4 yin[4][2][2];
#pragma unroll
            for (int m = 0; m < 4; ++m) { const int row = rbase + ai * HALF + m * 16; const int rc = row < MREAL ? row : MREAL - 1; const float* yr = y + (size_t)rc * D + col0;
#pragma unroll
                for (int bj = 0; bj < 2; ++bj)
#pragma unroll
                    for (int n = 0; n < 2; ++n) yin[m][bj][n] = *(const f32x4*)(yr + bj * HALF + n * 16); }
            EPI_FENCE();
#pragma unroll
            for (int m = 0; m < 4; ++m) { const int row = rbase + ai * HALF + m * 16;
                if (row < MREAL) { float* yr = y + (size_t)row * D + col0;
#pragma unroll
                    for (int bj = 0; bj < 2; ++bj)
#pragma unroll
                        for (int n = 0; n < 2; ++n) *(f32x4*)(yr + bj * HALF + n * 16) = yin[m][bj][n] + acc[ai][bj][m][n]; } }
            EPI_FENCE();
        }
    }
};
}

constexpr int NWAVES = 8;
#ifndef MK_N_LAUNCHES
#define MK_N_LAUNCHES 1
#endif
constexpr int PER_PHASE = 9;
constexpr int N_LAUNCHES = MK_N_LAUNCHES;

constexpr size_t MiB = 1u << 20;
constexpr size_t al256(size_t x) { return (x + 255) & ~(size_t)255; }
constexpr size_t WS_CTL = 0, CTL_ZERO_BYTES = 1 * MiB;
constexpr size_t WS_WIN  = 1 * MiB;
constexpr size_t WS_WUP  = WS_WIN  + al256((size_t)INW * D * 2);
constexpr size_t WS_WPL  = WS_WUP  + al256((size_t)D * GW * 2);
constexpr size_t WS_WOUT = WS_WPL  + al256((size_t)D * 512 * 2);
constexpr size_t WS_WGU  = WS_WOUT + al256((size_t)D * D * 2);
constexpr size_t WS_WDN  = WS_WGU  + al256((size_t)2 * FF * D * 2);
constexpr size_t WS_HN   = WS_WDN  + al256((size_t)D * FF * 2);
constexpr size_t WS_QB   = WS_HN   + al256((size_t)MP * D * 2);
constexpr size_t WS_KB   = WS_QB   + al256((size_t)MP * QKVW * 2);
constexpr size_t WS_VB   = WS_KB   + al256((size_t)MP * QKVW * 2);
constexpr size_t WS_UB   = WS_VB   + al256((size_t)MP * QKVW * 2);
constexpr size_t WS_GB   = WS_UB   + al256((size_t)MP * PW * 4);
constexpr size_t WS_ATT  = WS_GB   + al256((size_t)MP * 2 * D * 2);
constexpr size_t WS_PL   = WS_ATT  + al256((size_t)MP * GW * 2);
constexpr size_t WS_T    = WS_PL   + al256((size_t)MP * PW * 2);
constexpr size_t WS_MIX  = WS_T    + al256((size_t)MP * D * 2);
constexpr size_t WS_X1B  = WS_MIX  + al256((size_t)MP * D * 2);
constexpr size_t WS_FFB  = WS_X1B  + al256((size_t)MP * D * 2);
constexpr size_t WS_DUMP = WS_FFB  + al256((size_t)MP * FF * 2);
constexpr size_t WS_END  = WS_DUMP + 2 * MiB;
constexpr int CW_BAR = 4096;
constexpr int CW_RSS = 16384;
static_assert((CW_RSS + MP) * 4 <= (int)CTL_ZERO_BYTES && CW_BAR + 3456 <= CW_RSS, "CTL map");

constexpr int RING_OFF = 0, RING_BYTES = 131072;
constexpr int LDSCTL_OFF = RING_BYTES, MISC_OFF = LDSCTL_OFF + 320;
constexpr int LDS_BYTES = 147456;
static_assert(MISC_OFF + 128 <= LDS_BYTES, "LDS map");

#define GAS __attribute__((address_space(1)))
#define LAS __attribute__((address_space(3)))
typedef unsigned short bf16;
typedef unsigned v4u __attribute__((ext_vector_type(4)));
typedef unsigned v2u __attribute__((ext_vector_type(2)));
typedef float f32x4 __attribute__((ext_vector_type(4)));
typedef GAS unsigned gu32;
#define RLX_AGENT __ATOMIC_RELAXED, __HIP_MEMORY_SCOPE_AGENT
#define LDS_WAIT() asm volatile("s_waitcnt lgkmcnt(0)" ::: "memory")
#define VM_WAIT() asm volatile("s_waitcnt vmcnt(0)" ::: "memory")
__device__ __forceinline__ unsigned f2bf(float f) { unsigned u = __builtin_bit_cast(unsigned, f); return (u + 0x7fffu + ((u >> 16) & 1u)) >> 16; }
__device__ __forceinline__ unsigned pk2(float lo, float hi) { return f2bf(lo) | (f2bf(hi) << 16); }
__device__ __forceinline__ float bflo(unsigned w) { return __uint_as_float(w << 16); }
__device__ __forceinline__ float bfhi(unsigned w) { return __uint_as_float(w & 0xffff0000u); }

#define XB_TMO      128
#define XB_XCNT(j)  (256  + 64 * (j))
#define XB_XSUB(j)  (1280 + 64 * (j))
#define XB_XGEN(j)  (2304 + 64 * (j))
#define XB_TOP      3328
#define XB_TOPGEN   3392
#define XCD_BAR_WORDS 3456
#define XB_SPIN_CAP (1u << 18)

__device__ __forceinline__ unsigned xb_ld(unsigned* p)              { return __hip_atomic_load(p, __ATOMIC_RELAXED, __HIP_MEMORY_SCOPE_AGENT); }
__device__ __forceinline__ unsigned xb_add(unsigned* p, unsigned v) { return __hip_atomic_fetch_add(p, v, __ATOMIC_RELAXED, __HIP_MEMORY_SCOPE_AGENT); }
__device__ __forceinline__ unsigned xb_xcc_id() { return (unsigned)__builtin_amdgcn_s_getreg((3 << 11) | 20) & 0xFu; }
#define XB_SPIN(cond, bar) do { unsigned _sp = 0; while (cond) { __builtin_amdgcn_s_sleep(1); \
    if ((++_sp & 255u) == 0u) { if (xb_ld(&(bar)[XB_TMO])) break; if (_sp > XB_SPIN_CAP) { atomicAdd(&(bar)[XB_TMO], 1u); break; } } } } while (0)

struct XcdBarrier {
    unsigned* bar; unsigned x;
    volatile LAS unsigned* st;
};

__device__ __forceinline__ XcdBarrier xcd_barrier_post(unsigned* bar, volatile LAS unsigned* st) {
    XcdBarrier b; b.bar = bar; b.x = xb_xcc_id(); b.st = st;
    if (threadIdx.x == 0) (void)xb_add(&bar[XB_XCNT(b.x)], 1u);
    return b;
}
__device__ __forceinline__ void xcd_barrier_complete(unsigned* bar, unsigned x, unsigned& nloc, unsigned& nx) {
    const unsigned G = gridDim.x * gridDim.y * gridDim.z;
    unsigned sum, cnt, mine, sp = 0u;
    for (;;) {
        sum = 0u; cnt = 0u; mine = 0u;
#pragma unroll
        for (unsigned j = 0; j < 16; ++j) { const unsigned c = xb_ld(&bar[XB_XCNT(j)]); sum += c; cnt += (c > 0u) ? 1u : 0u; mine = (j == x) ? c : mine; }
        if (sum == G) break;
        __builtin_amdgcn_s_sleep(1);
        if ((++sp & 255u) == 0u) { if (xb_ld(&bar[XB_TMO])) break; if (sp > XB_SPIN_CAP) { atomicAdd(&bar[XB_TMO], 1u); break; } }
    }
    nloc = mine > 0u ? mine : 1u; nx = cnt > 0u ? cnt : 1u;
}

__device__ __forceinline__ void xcd_barrier(const XcdBarrier& b) {
    asm volatile("s_waitcnt vmcnt(0)" ::: "memory");
    __syncthreads();
    if (threadIdx.x == 0) {
        unsigned* bar = b.bar;
        __builtin_amdgcn_s_waitcnt(0);
        unsigned nloc = b.st[0], nx = b.st[1];
        if (nloc == 0u) { xcd_barrier_complete(bar, b.x, nloc, nx); b.st[0] = nloc; b.st[1] = nx; }
        const unsigned old = xb_add(&bar[XB_XSUB(b.x)], 1u);
        const unsigned gen = old / nloc;
        if (old + 1u == (gen + 1u) * nloc) {
            __builtin_amdgcn_fence(__ATOMIC_RELEASE, "agent");
            asm volatile("s_waitcnt vmcnt(0)" ::: "memory");
            const unsigned og = xb_add(&bar[XB_TOP], 1u);
            const unsigned tg = og / nx;
            if (og + 1u == (tg + 1u) * nx) xb_add(&bar[XB_TOPGEN], 1u);
            else XB_SPIN(xb_ld(&bar[XB_TOPGEN]) == tg, bar);
            __builtin_amdgcn_fence(__ATOMIC_ACQUIRE, "agent");
            xb_add(&bar[XB_XGEN(b.x)], 1u);
            asm volatile("s_waitcnt vmcnt(0)" ::: "memory");
        } else {
            XB_SPIN(xb_ld(&bar[XB_XGEN(b.x)]) == gen, bar);
            __builtin_amdgcn_fence(__ATOMIC_ACQUIRE, "agent");
            asm volatile("s_waitcnt vmcnt(0)" ::: "memory");
        }
    }
    __syncthreads();
}


struct Frame {
    LAS unsigned char* lds;
    volatile LAS unsigned* MISC;
    gu32* ctl;
    int tid, lane, wave;
    int vcu, G;
    const float *p_XP, *p_XS, *p_CK0, *p_CV0, *p_CK1, *p_CV1, *p_CK2, *p_CV2, *p_SP, *p_NMIX, *p_WIN, *p_WUP, *p_WPOOL, *p_PSCALE, *p_WOUT, *p_NFFN, *p_WG, *p_WU, *p_WD, *p_NFIN;
    float* out; unsigned char* ws;
};
enum { I_XP = 0, I_XS, I_CK0, I_CV0, I_CK1, I_CV1, I_CK2, I_CV2, I_SP, I_NMIX, I_WIN, I_WUP, I_WPOOL, I_PSCALE, I_WOUT, I_NFFN, I_WG, I_WU, I_WD, I_NFIN };

__device__ __forceinline__ float wave_sum(float v) {
#pragma unroll
    for (int o = 1; o < 64; o <<= 1) v += __shfl_xor(v, o);
    return v;
}
__device__ __forceinline__ float wave_max(float v) {
#pragma unroll
    for (int o = 1; o < 64; o <<= 1) v = fmaxf(v, __shfl_xor(v, o));
    return v;
}
__device__ __forceinline__ void p0_transpose_item(const float* W, int K, int N, bf16* WT, int k0, int n0, int out_row0, const float* kscale, LAS float* scr, int lane) {
    float wv[32];
#pragma unroll
    for (int i = 0; i < 32; ++i) wv[i] = W[(size_t)(k0 + 2 * i + (lane >> 5)) * N + n0 + (lane & 31)];
    if (kscale) {
#pragma unroll
        for (int i = 0; i < 32; ++i) wv[i] *= kscale[k0 + 2 * i + (lane >> 5)]; }
#pragma unroll
    for (int i = 0; i < 32; ++i) scr[(2 * i + (lane >> 5)) * 33 + (lane & 31)] = wv[i];
    LDS_WAIT(); asm volatile("" ::: "memory");
    const int c = lane & 7;
#pragma unroll
    for (int j = 0; j < 4; ++j) { const int n = (lane >> 3) + 8 * j; const LAS float* s = scr + (8 * c) * 33 + n;
        v4u o; o.x = pk2(s[0 * 33], s[1 * 33]); o.y = pk2(s[2 * 33], s[3 * 33]); o.z = pk2(s[4 * 33], s[5 * 33]); o.w = pk2(s[6 * 33], s[7 * 33]);
        *(GAS v4u*)(WT + (size_t)(out_row0 + n) * K + k0 + 8 * c) = o; }
    LDS_WAIT(); asm volatile("" ::: "memory");
}
__device__ __forceinline__ void rms_row_to_bf16(const float* xrow, const float* gain, bf16* orow, int lane) {
    const GAS f32x4* xr = (const GAS f32x4*)xrow + lane; const GAS f32x4* gr = (const GAS f32x4*)gain + lane;
    f32x4 v[16]; float s = 0.f;
#pragma unroll
    for (int j = 0; j < 16; ++j) { v[j] = xr[64 * j]; s += (v[j].x * v[j].x + v[j].y * v[j].y) + (v[j].z * v[j].z + v[j].w * v[j].w); }
    const float rstd = 1.0f / sqrtf(wave_sum(s) * (1.0f / D) + RMS_EPS);
    GAS v2u* o8 = (GAS v2u*)orow + lane;
#pragma unroll
    for (int j = 0; j < 16; ++j) { const f32x4 g = gr[64 * j]; v2u w; w.x = pk2(v[j].x * rstd * g.x, v[j].y * rstd * g.y); w.y = pk2(v[j].z * rstd * g.z, v[j].w * rstd * g.w); o8[64 * j] = w; }
}
__device__ __forceinline__ void p0_cache_copy(const float* src, float* dst, int W, int gt, int NT) {
    const int per = (W - 1) * 256; const int total = NSMP * per;
    const GAS f32x4* s4 = (const GAS f32x4*)src; GAS f32x4* d4 = (GAS f32x4*)dst;
    for (int i0 = gt; i0 < total; i0 += 4 * NT) {
        f32x4 v[4]; int di[4];
#pragma unroll
        for (int k = 0; k < 4; ++k) { const int i = i0 + k * NT; const int n = i / per, rem = i - n * per; di[k] = n * W * 256 + rem; if (i < total) v[k] = s4[(size_t)di[k] + 256]; }
#pragma unroll
        for (int k = 0; k < 4; ++k) { const int i = i0 + k * NT; if (i < total) d4[(size_t)di[k]] = v[k]; }
    }
}
__device__ __forceinline__ void p0_prologue(Frame& F) {
    LAS float* scr = (LAS float*)(F.lds + RING_OFF + F.wave * 16384);
    const int gw = F.vcu * NWAVES + F.wave, NGW = F.G * NWAVES;
    bf16* WIN = (bf16*)(F.ws + WS_WIN); bf16* WUP = (bf16*)(F.ws + WS_WUP); bf16* WPL = (bf16*)(F.ws + WS_WPL); bf16* WOUT = (bf16*)(F.ws + WS_WOUT); bf16* WGU = (bf16*)(F.ws + WS_WGU); bf16* WDN = (bf16*)(F.ws + WS_WDN);
    constexpr int IT_IN = (D / 64) * (INW / 32), IT_UP = (GW / 64) * (D / 32), IT_PL1 = (512 / 64) * (GW / 32), IT_PL = 4 * IT_PL1, IT_OUT = (D / 64) * (D / 32), IT_G = (D / 64) * (FF / 32), IT_DN = (FF / 64) * (D / 32);
    constexpr int NITEMS = IT_IN + IT_UP + IT_PL + IT_OUT + IT_DN;
    for (int it = gw; it < NITEMS; it += NGW) {
        int r = it;
        if (r < IT_IN) { const int nb = r % (INW / 32), kb = r / (INW / 32); p0_transpose_item(F.p_WIN, D, INW, WIN, 64 * kb, 32 * nb, 32 * nb, nullptr, scr, F.lane); continue; } r -= IT_IN;
        if (r < IT_UP) { const int nb = r % (D / 32), kb = r / (D / 32); p0_transpose_item(F.p_WUP, GW, D, WUP, 64 * kb, 32 * nb, 32 * nb, nullptr, scr, F.lane); continue; } r -= IT_UP;
        if (r < IT_PL) { const int g = r / IT_PL1, q = r % IT_PL1, nb = q % (GW / 32), kb = q / (GW / 32);
            p0_transpose_item(F.p_WPOOL + (size_t)g * 512 * GW, 512, GW, WPL, 64 * kb, 32 * nb, g * GW + 32 * nb, nullptr, scr, F.lane); continue; } r -= IT_PL;
        if (r < IT_OUT) { const int nb = r % (D / 32), kb = r / (D / 32); p0_transpose_item(F.p_WOUT, D, D, WOUT, 64 * kb, 32 * nb, 32 * nb, nullptr, scr, F.lane); continue; } r -= IT_OUT;
        { const int nb = r % (D / 32), kb = r / (D / 32); p0_transpose_item(F.p_WD, FF, D, WDN, 64 * kb, 32 * nb, 32 * nb, nullptr, scr, F.lane); }
    }
    bf16* HN = (bf16*)(F.ws + WS_HN);
    for (int m = gw; m < MP; m += NGW) {
        if (m < MPR) rms_row_to_bf16(F.p_XP + (size_t)m * D, F.p_NMIX, HN + (size_t)m * D, F.lane);
        else if (m < MREAL) rms_row_to_bf16(F.p_XS + (size_t)(m - MPR) * D, F.p_NMIX, HN + (size_t)m * D, F.lane);
        else { GAS v4u* o = (GAS v4u*)(HN + (size_t)m * D) + F.lane;
#pragma unroll
            for (int j = 0; j < 8; ++j) o[64 * j] = (v4u){0u, 0u, 0u, 0u}; }
    }
    const int gt = F.vcu * (NWAVES * 64) + F.tid, NT = F.G * NWAVES * 64;
    { float* rs = (float*)(F.ws + WS_CTL) + CW_RSS; for (int i = gt; i < MP; i += NT) rs[i] = 0.f; }
    { const GAS f32x4* s4 = (const GAS f32x4*)F.p_SP; GAS f32x4* d4 = (GAS f32x4*)(F.out + O_PS); constexpr int per = (PHIST - 1) * (PW / 4), tot = NSMP * per;
      for (int i = gt; i < tot; i += NT) { const int n = i / per, rem = i - n * per; d4[(size_t)n * PHIST * (PW / 4) + rem] = s4[(size_t)n * PHIST * (PW / 4) + (PW / 4) + rem]; } }
}

__device__ __forceinline__ void p2_convert_wgu(Frame& F, LAS float* scr, int gwave, int ngw) {
    bf16* WGU = (bf16*)(F.ws + WS_WGU); constexpr int IT_G = (D / 64) * (FF / 32);
    for (int r = gwave; r < 2 * IT_G; r += ngw) { const int up = r >= IT_G ? 1 : 0, q = r - up * IT_G, nb = q % (FF / 32), kb = q / (FF / 32), n0 = 32 * nb;
        if (up) p0_transpose_item(F.p_WU, D, FF, WGU, 64 * kb, n0, (n0 >> 7) * 256 + (n0 & 127) + 128, F.p_NFFN, scr, F.lane);
        else    p0_transpose_item(F.p_WG, D, FF, WGU, 64 * kb, n0, (n0 >> 7) * 256 + (n0 & 127), F.p_NFFN, scr, F.lane); }
}
__device__ __forceinline__ float alibi_slope_log2e(int g, int h) { return exp2f(-8.0f * (float)(g * 8 + h + 1) / 24.0f) * 1.4426950408889634f; }
__device__ __forceinline__ float dot8(v4u a, v4u b) {
    return (bflo(a.x) * bflo(b.x) + bfhi(a.x) * bfhi(b.x)) + (bflo(a.y) * bflo(b.y) + bfhi(a.y) * bfhi(b.y)) + (bflo(a.z) * bflo(b.z) + bfhi(a.z) * bfhi(b.z)) + (bflo(a.w) * bflo(b.w) + bfhi(a.w) * bfhi(b.w));
}
__device__ __forceinline__ void attn_naive_prompt(const bf16* QB, const bf16* KB, const bf16* VB, bf16* ATT, int m, int j, LAS float* pl, int lane) {
    const int t = m & (SEQ - 1);
    float Mx = -INFINITY, den = 0.f, a0 = 0.f, a1 = 0.f;
#pragma unroll 1
    for (int g = 0; g < 3; ++g) {
        const int d = g == 0 ? 1 : (g == 1 ? 4 : 16); const int tq = t / d; const int nk = (tq < 128 ? tq : 128) + 1;
        const float sl = alibi_slope_log2e(g, j) * (float)d;
        const size_t hoff = (size_t)g * GW + j * HD;
        const GAS v4u* qp = (const GAS v4u*)(QB + (size_t)m * QKVW + hoff);
        float s[3];
#pragma unroll
        for (int i = 0; i < 3; ++i) { const int jj = lane + 64 * i; s[i] = -INFINITY;
            if (jj < nk) { const GAS v4u* kp = (const GAS v4u*)(KB + (size_t)(m - d * jj) * QKVW + hoff); float acc = 0.f;
#pragma unroll
                for (int c = 0; c < 16; ++c) acc += dot8(qp[c], kp[c]);
                s[i] = acc - sl * (float)jj; } }
        const float mg = wave_max(fmaxf(fmaxf(s[0], s[1]), s[2])); const float nM = fmaxf(Mx, mg); const float so = __builtin_amdgcn_exp2f(Mx - nM);
        float ps = 0.f;
#pragma unroll
        for (int i = 0; i < 3; ++i) { const int jj = lane + 64 * i; const float p = (jj < nk) ? __builtin_amdgcn_exp2f(s[i] - nM) : 0.f; ps += p; if (jj < 129) pl[jj] = p; }
        den = den * so + wave_sum(ps); a0 *= so; a1 *= so; Mx = nM;
        LDS_WAIT(); asm volatile("" ::: "memory");
        const GAS unsigned* vp = (const GAS unsigned*)(VB + (size_t)m * QKVW + hoff) + lane;
        for (int jj = 0; jj < nk; ++jj) { const float p = pl[jj]; const unsigned w = vp[-(long)(d * jj) * (QKVW / 2)]; a0 += p * bflo(w); a1 += p * bfhi(w); }
        LDS_WAIT(); asm volatile("" ::: "memory");
    }
    const float inv = 1.0f / den;
    ((GAS unsigned*)(ATT + (size_t)m * GW + j * HD))[lane] = pk2(a0 * inv, a1 * inv);
}
typedef float f32x16 __attribute__((ext_vector_type(16)));
typedef short bf16x8_t __attribute__((ext_vector_type(8)));
typedef short s16x4_t __attribute__((ext_vector_type(4)));
constexpr int VPITCH = 272;
__device__ __forceinline__ int crow16(int i, int h) { return (i & 3) + 8 * (i >> 2) + 4 * h; }
__device__ __forceinline__ unsigned cvtpk(float lo, float hi) { typedef float f2 __attribute__((ext_vector_type(2))); typedef __bf16 b2 __attribute__((ext_vector_type(2))); const f2 v = {lo, hi}; const b2 b = __builtin_convertvector(v, b2); return __builtin_bit_cast(unsigned, b); }
__device__ __forceinline__ s16x4_t vtr(LAS const unsigned char* p) { typedef short v4i16_t __attribute__((ext_vector_type(4))); return __builtin_bit_cast(s16x4_t, __builtin_amdgcn_ds_read_tr16_b64_v4i16((LAS v4i16_t*)p)); }
__device__ __forceinline__ void attn_mfma_tile(const bf16* QB, const bf16* KB, const bf16* VB, bf16* NUM, float* ML, int item, LAS unsigned char* vlds, int lane) {
    const int blk = ((item & 63) + 21 * (item >> 11)) & 63, h = (item >> 6) & 7, bg = item >> 9, g = bg % 3, b = bg / 3;
    const int ds = 2 * g, d = 1 << ds, nbs = 6 - ds, r = blk >> nbs, ib = blk & ((1 << nbs) - 1), i0 = 32 * ib;
    const int r32 = lane & 31, hh = lane >> 5;
    const size_t colbase = (size_t)g * GW + h * HD;
    const int rowb = b * SEQ + r;
    const float sl = alibi_slope_log2e(g, h) * (float)d;
    const int rq = r32 - 4 * hh; const float slrq = sl * (float)rq;
    bf16x8_t qf[8];
    { const bf16* qrow = QB + (size_t)(rowb + d * (i0 + r32)) * QKVW + colbase + 8 * hh;
#pragma unroll
      for (int s_ = 0; s_ < 8; ++s_) qf[s_] = *(const GAS bf16x8_t*)(qrow + 16 * s_); }
    f32x16 S[5];
#pragma unroll
    for (int kb = 0; kb < 5; ++kb) {
        if (ib + kb >= 4) {
            const int kk0 = 32 * (ib + kb - 4);
            const bf16* krow = KB + (size_t)(rowb + d * (kk0 + r32)) * QKVW + colbase + 8 * hh;
            f32x16 acc;
#pragma unroll
            for (int i = 0; i < 16; ++i) acc[i] = 0.f;
#pragma unroll
            for (int s_ = 0; s_ < 8; ++s_) { const bf16x8_t kf = *(const GAS bf16x8_t*)(krow + 16 * s_); acc = __builtin_amdgcn_mfma_f32_32x32x16_bf16(kf, qf[s_], acc, 0, 0, 0); }
#pragma unroll
            for (int i = 0; i < 16; ++i) { const int ci = (i & 3) + 8 * (i >> 2);
                float v = fmaf(-sl, (float)(32 * (4 - kb) - ci), acc[i]) - slrq;
                if (kb == 0 && rq > ci) v = -INFINITY;
                if (kb == 4 && rq < ci) v = -INFINITY;
                acc[i] = v; }
            S[kb] = acc;
        } else {
#pragma unroll
            for (int i = 0; i < 16; ++i) S[kb][i] = -INFINITY;
        }
    }
    float mx = -INFINITY;
#pragma unroll
    for (int kb = 0; kb < 5; ++kb)
#pragma unroll
        for (int i = 0; i < 16; ++i) mx = fmaxf(mx, S[kb][i]);
    mx = fmaxf(mx, __shfl_xor(mx, 32));
    float den = 0.f;
#pragma unroll
    for (int kb = 0; kb < 5; ++kb)
#pragma unroll
        for (int i = 0; i < 16; ++i) { const float p = __builtin_amdgcn_exp2f(S[kb][i] - mx); S[kb][i] = p; den += p; }
    den += __shfl_xor(den, 32);
    f32x16 y[4];
#pragma unroll
    for (int c = 0; c < 4; ++c)
#pragma unroll
        for (int i = 0; i < 16; ++i) y[c][i] = 0.f;
    const int q4 = (lane & 15) >> 2, p4 = lane & 3, bk = (lane >> 4) & 1;
    LAS const unsigned char* vrd = vlds + (4 * hh + q4) * VPITCH + 32 * bk + 8 * p4;
#pragma unroll
    for (int kb = 0; kb < 5; ++kb) {
        if (ib + kb >= 4) {
            const int kk0 = 32 * (ib + kb - 4);
#pragma unroll
            for (int k = 0; k < 8; ++k) { const int id = lane + 64 * k, key = id >> 4, ch = id & 15;
                const v4u v = *(const GAS v4u*)(VB + (size_t)(rowb + d * (kk0 + key)) * QKVW + colbase + 8 * ch);
                *(LAS v4u*)(vlds + key * VPITCH + ch * 16) = v; }
#pragma unroll
            for (int s_ = 0; s_ < 2; ++s_) {
                v4u pk; pk.x = cvtpk(S[kb][8 * s_ + 0], S[kb][8 * s_ + 1]); pk.y = cvtpk(S[kb][8 * s_ + 2], S[kb][8 * s_ + 3]); pk.z = cvtpk(S[kb][8 * s_ + 4], S[kb][8 * s_ + 5]); pk.w = cvtpk(S[kb][8 * s_ + 6], S[kb][8 * s_ + 7]);
                const bf16x8_t xs = __builtin_bit_cast(bf16x8_t, pk);
#pragma unroll
                for (int c = 0; c < 4; ++c) { const s16x4_t lo = vtr(vrd + (16 * s_) * VPITCH + 64 * c), hi = vtr(vrd + (16 * s_ + 8) * VPITCH + 64 * c);
                    const bf16x8_t vf = __builtin_shufflevector(lo, hi, 0, 1, 2, 3, 4, 5, 6, 7);
                    y[c] = __builtin_amdgcn_mfma_f32_32x32x16_bf16(vf, xs, y[c], 0, 0, 0); }
            }
        }
    }
    const int m = rowb + d * (i0 + r32);
    bf16* np = NUM + ((size_t)g * MREAL + m) * GW + h * HD + 4 * hh;
#pragma unroll
    for (int c = 0; c < 4; ++c)
#pragma unroll
        for (int k = 0; k < 4; ++k) { v2u w; w.x = cvtpk(y[c][4 * k + 0], y[c][4 * k + 1]); w.y = cvtpk(y[c][4 * k + 2], y[c][4 * k + 3]); *(GAS v2u*)(np + 32 * c + 8 * k) = w; }
    if (hh == 0) { typedef float f2 __attribute__((ext_vector_type(2))); *(GAS f2*)(ML + (((size_t)g * MREAL + m) * NH + h) * 2) = (f2){mx, den}; }
}
__device__ __forceinline__ void attn_combine(const bf16* NUM, const float* ML, bf16* ATT, int gt, int NT) {
    typedef float f2 __attribute__((ext_vector_type(2)));
    for (int i = gt; i < MREAL * (GW / 8); i += NT) {
        const int m = i >> 7, c8 = i & 127, h = c8 >> 4;
        f2 st[3]; float M = -INFINITY;
#pragma unroll
        for (int g = 0; g < 3; ++g) { st[g] = *(const GAS f2*)(ML + (((size_t)g * MREAL + m) * NH + h) * 2); M = fmaxf(M, st[g].x); }
        float o[8] = {0.f, 0.f, 0.f, 0.f, 0.f, 0.f, 0.f, 0.f}; float dn = 0.f;
#pragma unroll
        for (int g = 0; g < 3; ++g) { const float e = __builtin_amdgcn_exp2f(st[g].x - M); dn += e * st[g].y;
            const v4u w = *(const GAS v4u*)(NUM + ((size_t)g * MREAL + m) * GW + 8 * c8);
            o[0] += e * bflo(w.x); o[1] += e * bfhi(w.x); o[2] += e * bflo(w.y); o[3] += e * bfhi(w.y); o[4] += e * bflo(w.z); o[5] += e * bfhi(w.z); o[6] += e * bflo(w.w); o[7] += e * bfhi(w.w); }
        const float inv = 1.0f / dn; v4u r; r.x = cvtpk(o[0] * inv, o[1] * inv); r.y = cvtpk(o[2] * inv, o[3] * inv); r.z = cvtpk(o[4] * inv, o[5] * inv); r.w = cvtpk(o[6] * inv, o[7] * inv);
        *(GAS v4u*)(ATT + (size_t)m * GW + 8 * c8) = r;
    }
}
template <int G_>
__device__ __forceinline__ void attn_sample_partial(const float* ck, const float* cv, const float* out, const bf16* QB, bf16* NUM, float* ML, int n, int j, LAS float* pl, int lane) {
    constexpr int d = G_ == 0 ? 1 : (G_ == 1 ? 4 : 16), W = G_ == 0 ? 128 : (G_ == 1 ? 512 : 2048);
    constexpr size_t OK_ = G_ == 0 ? O_KS0 : (G_ == 1 ? O_KS1 : O_KS2), OV_ = G_ == 0 ? O_VS0 : (G_ == 1 ? O_VS1 : O_VS2);
    const int m = MPR + n, g4 = lane >> 4, i16 = lane & 15;
    const float* nk_ = out + OK_ + ((size_t)n * W + (W - 1)) * GW + j * HD; const float* nv_ = out + OV_ + ((size_t)n * W + (W - 1)) * GW + j * HD;
    const float* kb = ck + (size_t)n * W * GW + j * HD; const float* vb = cv + (size_t)n * W * GW + j * HD;
    const float sl = alibi_slope_log2e(G_, j) * (float)d;
    float q[8];
    { const v4u w = *(const GAS v4u*)(QB + (size_t)m * QKVW + (size_t)G_ * GW + j * HD + 8 * i16);
      q[0] = bflo(w.x); q[1] = bfhi(w.x); q[2] = bflo(w.y); q[3] = bfhi(w.y); q[4] = bflo(w.z); q[5] = bfhi(w.z); q[6] = bflo(w.w); q[7] = bfhi(w.w); }
    float sc[3] = {-INFINITY, -INFINITY, -INFINITY};
#pragma unroll
    for (int c0 = 0; c0 < 33; c0 += 11) {
        f32x4 ka[11], kc[11];
#pragma unroll
        for (int u = 0; u < 11; ++u) { const int jj = 4 * (c0 + u) + g4; const int jc = jj <= 128 ? jj : 128;
            const float* kp = (jc == 0 ? nk_ : kb + (size_t)(W - d * jc) * GW) + 8 * i16; ka[u] = *(const GAS f32x4*)kp; kc[u] = *(const GAS f32x4*)(kp + 4); }
#pragma unroll
        for (int u = 0; u < 11; ++u) { const int c = c0 + u, jj = 4 * c + g4;
            float sdot = (ka[u].x * q[0] + ka[u].y * q[1]) + (ka[u].z * q[2] + ka[u].w * q[3]) + (kc[u].x * q[4] + kc[u].y * q[5]) + (kc[u].z * q[6] + kc[u].w * q[7]);
            sdot += __shfl_xor(sdot, 1); sdot += __shfl_xor(sdot, 2); sdot += __shfl_xor(sdot, 4); sdot += __shfl_xor(sdot, 8);
            const float sv = jj <= 128 ? sdot - sl * (float)jj : -INFINITY;
            if ((c & 15) == i16) sc[c >> 4] = sv; }
    }
    const float mx = wave_max(fmaxf(fmaxf(sc[0], sc[1]), sc[2]));
    float ps = 0.f;
#pragma unroll
    for (int k = 0; k < 3; ++k) { const int jj = 4 * (i16 + 16 * k) + g4; const float p = __builtin_amdgcn_exp2f(sc[k] - mx); ps += p; if (jj <= 128) pl[jj] = p; }
    const float den = wave_sum(ps);
    LDS_WAIT(); asm volatile("" ::: "memory");
    typedef float f32x2g __attribute__((ext_vector_type(2)));
    float a0 = 0.f, a1 = 0.f;
#pragma unroll 1
    for (int j0 = 0; j0 < 128; j0 += 16) { f32x2g vv[16];
#pragma unroll
        for (int u = 0; u < 16; ++u) { const int jj = j0 + u; const float* vp = jj == 0 ? nv_ : vb + (size_t)(W - d * jj) * GW; vv[u] = ((const GAS f32x2g*)vp)[lane]; }
#pragma unroll
        for (int u = 0; u < 16; ++u) { const float p = pl[j0 + u]; a0 += p * vv[u].x; a1 += p * vv[u].y; } }
    { const f32x2g v128 = ((const GAS f32x2g*)vb)[lane]; const float p = pl[128]; a0 += p * v128.x; a1 += p * v128.y; }
    LDS_WAIT(); asm volatile("" ::: "memory");
    ((GAS unsigned*)(NUM + ((size_t)G_ * MREAL + m) * GW + j * HD))[lane] = cvtpk(a0, a1);
    if (lane == 0) { *(GAS f32x2g*)(ML + (((size_t)G_ * MREAL + m) * NH + j) * 2) = (f32x2g){mx, den}; }
}
template <int WN>
__device__ __forceinline__ void pool_task(const float* UB, const float* sp, bf16* PL, int m, int c) {
    const f32x4 u0 = *(const GAS f32x4*)(UB + (size_t)m * PW + c); f32x4 r[WN - 1]; float wgt[WN - 1]; float cnt;
    if (m < MPR) { const int t = m & (SEQ - 1); cnt = (float)((t < WN - 1 ? t : WN - 1) + 1);
#pragma unroll
        for (int q = 1; q < WN; ++q) { const int qq = q <= t ? q : t; wgt[q - 1] = q <= t ? 1.f : 0.f; r[q - 1] = *(const GAS f32x4*)(UB + (size_t)(m - qq) * PW + c); } }
    else { const int n = m - MPR; cnt = (float)WN;
#pragma unroll
        for (int q = 1; q < WN; ++q) { wgt[q - 1] = 1.f; r[q - 1] = *(const GAS f32x4*)(sp + ((size_t)n * PHIST + (PHIST - q)) * PW + c); } }
    f32x4 tot = u0;
#pragma unroll
    for (int q = 1; q < WN; ++q) tot = tot + r[q - 1] * wgt[q - 1];
    const float ic = 1.0f / cnt; v2u o; o.x = pk2(tot.x * ic - u0.x, tot.y * ic - u0.y); o.y = pk2(tot.z * ic - u0.z, tot.w * ic - u0.w);
    *(GAS v2u*)(PL + (size_t)m * PW + c) = o;
}
template <int WN>
__device__ __forceinline__ void pool_chunk(const float* UB, bf16* PL, int b, int t0, int c) {
    const float* ub = UB + (size_t)b * SEQ * PW + c; bf16* pb = PL + (size_t)b * SEQ * PW + c;
    f32x4 ring[WN]; f32x4 tot = (f32x4){0.f, 0.f, 0.f, 0.f};
    if (t0 != 0) {
#pragma unroll
        for (int j = 0; j < WN; ++j) ring[j] = *(const GAS f32x4*)(ub + (size_t)(t0 - WN + j) * PW);
#pragma unroll
        for (int j = 0; j < WN; ++j) tot = tot + ring[j];
    } else {
#pragma unroll
        for (int j = 0; j < WN; ++j) ring[j] = (f32x4){0.f, 0.f, 0.f, 0.f};
    }
#pragma unroll
    for (int s0 = 0; s0 < 32; s0 += 16) {
        f32x4 nw[16];
#pragma unroll
        for (int u = 0; u < 16; ++u) nw[u] = *(const GAS f32x4*)(ub + (size_t)(t0 + s0 + u) * PW);
#pragma unroll
        for (int u = 0; u < 16; ++u) { const int s_ = s0 + u, t = t0 + s_; const f32x4 x = nw[u];
            tot = tot + (x - ring[s_ % WN]); ring[s_ % WN] = x;
            const int cn = t + 1 < WN ? t + 1 : WN; const float ic = 1.0f / (float)cn;
            v2u o; o.x = pk2(tot.x * ic - x.x, tot.y * ic - x.y); o.y = pk2(tot.z * ic - x.z, tot.w * ic - x.w);
            *(GAS v2u*)(pb + (size_t)t * PW) = o; }
    }
}
__device__ __forceinline__ void pool_naive(const Frame& F, const float* UB, bf16* PL, int gt, int NT) {
    constexpr int C4 = PW / 4, NCH = SEQ / 32;
    for (int i = gt; i < NB * NCH * C4; i += NT) {
        const int c4 = i % C4, rc = (i / C4) % NCH, b = i / (C4 * NCH), c = 4 * c4; const int grp = __builtin_amdgcn_readfirstlane(c >> 9);
        if (grp == 0) pool_chunk<2>(UB, PL, b, 32 * rc, c); else if (grp == 1) pool_chunk<4>(UB, PL, b, 32 * rc, c); else if (grp == 2) pool_chunk<8>(UB, PL, b, 32 * rc, c); else pool_chunk<16>(UB, PL, b, 32 * rc, c);
    }
    for (int i = gt; i < NSMP * C4; i += NT) {
        const int n = i / C4, c = 4 * (i - n * C4); const int grp = __builtin_amdgcn_readfirstlane(c >> 9);
        if (grp == 0) pool_task<2>(UB, F.p_SP, PL, MPR + n, c); else if (grp == 1) pool_task<4>(UB, F.p_SP, PL, MPR + n, c); else if (grp == 2) pool_task<8>(UB, F.p_SP, PL, MPR + n, c); else pool_task<16>(UB, F.p_SP, PL, MPR + n, c);
    }
}
constexpr int SK_RED_PITCH = 33;
template <int NACC>
__device__ __forceinline__ void skinny_partial(const bf16* A, int lda, const bf16* B0, const bf16* B1, int ldb, int K, LAS float* red, int wave, int lane) {
    const int r32 = lane & 31, hh = lane >> 5, ks = K >> 3, nst = ks >> 4;
    const bf16* ap = A + (size_t)r32 * lda + wave * ks + 8 * hh;
    const bf16* bp0 = B0 + (size_t)r32 * ldb + wave * ks + 8 * hh;
    const bf16* bp1 = B1 + (size_t)r32 * ldb + wave * ks + 8 * hh;
    f32x16 acc0, acc1;
#pragma unroll
    for (int i = 0; i < 16; ++i) { acc0[i] = 0.f; acc1[i] = 0.f; }
#pragma unroll 16
    for (int s_ = 0; s_ < nst; ++s_) {
        const bf16x8_t af = *(const GAS bf16x8_t*)(ap + 16 * s_);
        const bf16x8_t bf0 = *(const GAS bf16x8_t*)(bp0 + 16 * s_);
        acc0 = __builtin_amdgcn_mfma_f32_32x32x16_bf16(af, bf0, acc0, 0, 0, 0);
        if (NACC == 2) { const bf16x8_t bf1 = *(const GAS bf16x8_t*)(bp1 + 16 * s_); acc1 = __builtin_amdgcn_mfma_f32_32x32x16_bf16(af, bf1, acc1, 0, 0, 0); }
    }
    LAS float* rw = red + wave * (NACC * 32 * SK_RED_PITCH);
#pragma unroll
    for (int i = 0; i < 16; ++i) { rw[crow16(i, hh) * SK_RED_PITCH + r32] = acc0[i]; if (NACC == 2) rw[(32 + crow16(i, hh)) * SK_RED_PITCH + r32] = acc1[i]; }
}
template <int NACC>
__device__ __forceinline__ void skinny_reduce(LAS const float* red, int tid, float (&v)[NACC][2]) {
    const int row = tid >> 4, c = (tid & 15) * 2;
#pragma unroll
    for (int a = 0; a < NACC; ++a) { float s0 = 0.f, s1 = 0.f;
#pragma unroll
        for (int w = 0; w < NWAVES; ++w) { const LAS float* p = red + w * (NACC * 32 * SK_RED_PITCH) + (a * 32 + row) * SK_RED_PITCH + c; s0 += p[0]; s1 += p[1]; }
        v[a][0] = s0; v[a][1] = s1; }
}
__device__ __forceinline__ void skinny_share(int nmain, int G, int c, int& idx, int& share) { const int first = nmain % G; if (first == 0) { idx = c; share = G; } else { idx = c - first; share = G - first; } }

__device__ __forceinline__ void final_norm_row(float* yrow, const float* gain, int lane) {
    GAS f32x4* xr = (GAS f32x4*)yrow + lane; const GAS f32x4* gr = (const GAS f32x4*)gain + lane;
    f32x4 v[16]; float s = 0.f;
#pragma unroll
    for (int j = 0; j < 16; ++j) { v[j] = xr[64 * j]; s += (v[j].x * v[j].x + v[j].y * v[j].y) + (v[j].z * v[j].z + v[j].w * v[j].w); }
    const float rstd = 1.0f / sqrtf(wave_sum(s) * (1.0f / D) + RMS_EPS);
#pragma unroll
    for (int j = 0; j < 16; ++j) { const f32x4 g = gr[64 * j]; xr[64 * j] = v[j] * rstd * g; }
}

typedef float f32x2e __attribute__((ext_vector_type(2)));
__device__ __forceinline__ float sigm(float x) { return __builtin_amdgcn_rcpf(1.0f + __builtin_amdgcn_exp2f(-1.4426950408889634f * x)); }
__device__ __forceinline__ void sk_emit_in(bf16* QB, size_t qkv_stride, bf16* GB, float* UB, float* out, float qscale, int n, int col, float v0, float v1) {
    const size_t m = (size_t)(MPR + n);
    if (col < 3 * QKVW) {
        const int which = col / QKVW, c3 = col - which * QKVW; const float sc = which == 0 ? qscale : 1.0f;
        *(GAS unsigned*)(QB + (size_t)which * qkv_stride + m * QKVW + c3) = cvtpk(v0 * sc, v1 * sc);
        if (which != 0) { const int g = c3 / GW, cg = c3 - g * GW, W = g == 0 ? 128 : (g == 1 ? 512 : 2048);
            float* os = out + (g == 0 ? (which == 1 ? O_KS0 : O_VS0) : g == 1 ? (which == 1 ? O_KS1 : O_VS1) : (which == 1 ? O_KS2 : O_VS2)) + ((size_t)n * W + (W - 1)) * GW + cg;
            *(GAS f32x2e*)os = (f32x2e){v0, v1}; }
    } else if (col < 3 * QKVW + PW) {
        const int c = col - 3 * QKVW; *(GAS f32x2e*)(UB + m * PW + c) = (f32x2e){v0, v1}; *(GAS f32x2e*)(out + O_PS + ((size_t)n * PHIST + (PHIST - 1)) * PW + c) = (f32x2e){v0, v1};
    } else { const int c = col - (3 * QKVW + PW); *(GAS unsigned*)(GB + m * (2 * D) + c) = cvtpk(sigm(v0), sigm(v1)); }
}
__device__ __forceinline__ void sk_emit_pool(const bf16* GB, const float* pscale, bf16* T, int n, int col, float v0, float v1) {
    const size_t m = (size_t)(MPR + n); const unsigned g = *(const GAS unsigned*)(GB + m * (2 * D) + D + col); const f32x2e ps = *(const GAS f32x2e*)(pscale + col);
    *(GAS unsigned*)(T + m * D + col) = cvtpk(v0 * ps.x * bflo(g), v1 * ps.y * bfhi(g));
}
__device__ __forceinline__ void sk_emit_up(const bf16* GB, const bf16* T, bf16* MIX, int n, int col, float v0, float v1) {
    const size_t m = (size_t)(MPR + n); const unsigned g = *(const GAS unsigned*)(GB + m * (2 * D) + col), t = *(const GAS unsigned*)(T + m * D + col);
    *(GAS unsigned*)(MIX + m * D + col) = cvtpk(v0 * bflo(g) + bflo(t), v1 * bfhi(g) + bfhi(t));
}
__device__ __forceinline__ void sk_emit_out(const float* xs, float* y, bf16* X1B, float* rowss, int n, int col, float v0, float v1, int tid) {
    const size_t m = (size_t)(MPR + n); const f32x2e x = *(const GAS f32x2e*)(xs + (size_t)n * D + col); const float o0 = x.x + v0, o1 = x.y + v1;
    *(GAS f32x2e*)(y + m * D + col) = (f32x2e){o0, o1}; *(GAS unsigned*)(X1B + m * D + col) = cvtpk(o0, o1);
    float ss = o0 * o0 + o1 * o1; ss += __shfl_xor(ss, 1); ss += __shfl_xor(ss, 2); ss += __shfl_xor(ss, 4); ss += __shfl_xor(ss, 8);
    if ((tid & 15) == 0) atomicAdd(rowss + m, ss);
}
__device__ __forceinline__ void sk_emit_ff(const float* rowss, bf16* FFB, int n, int f, float g0, float g1, float u0, float u1) {
    const size_t m = (size_t)(MPR + n); const float r = 1.0f / sqrtf(rowss[m] * (1.0f / D) + RMS_EPS); g0 *= r; g1 *= r; u0 *= r; u1 *= r;
    *(GAS unsigned*)(FFB + m * FF + f) = cvtpk(g0 * sigm(g0) * u0, g1 * sigm(g1) * u1);
}
__device__ __forceinline__ void sk_emit_down(float* y, int n, int col, float v0, float v1) {
    GAS f32x2e* p = (GAS f32x2e*)(y + (size_t)(MPR + n) * D + col); const f32x2e b = *p; *p = (f32x2e){b.x + v0, b.y + v1};
}

__device__ __forceinline__ int lane_now() { int l; asm volatile("v_mbcnt_lo_u32_b32 %0, -1, 0\n\tv_mbcnt_hi_u32_b32 %0, -1, %0" : "=v"(l)); return l; }
struct BgStream {
    unsigned long long src, dst, pdst, dump;
    unsigned left;
    f32x4 data; unsigned voff;
    __device__ __forceinline__ void init(const float* k0, const float* v0, const float* k1, const float* v1, const float* k2, const float* v2, float* out, unsigned char* dump_, int gwave) {
        dump = (unsigned long long)(uintptr_t)dump_; pdst = dump; src = (unsigned long long)(uintptr_t)k0; dst = dump; left = 0u;
        const int slot = gwave & 31; if (slot >= 24) return;
        const int w = (gwave >> 5) * 24 + slot; const float* sb; size_t db; int W, n, start, count;
        if (w < 1088) { const int t = w / 544, rem = w - t * 544, piece = rem % 17; n = rem / 17; W = 2048; start = piece * 482; count = (start + 482 <= 8188) ? 482 : 8188 - start; if (t == 0) { sb = k2; db = O_KS2; } else { sb = v2; db = O_VS2; } }
        else if (w < 1408) { const int rem0 = w - 1088, t = rem0 / 160, r2 = rem0 - t * 160, piece = r2 % 5; n = r2 / 5; W = 512; start = piece * 409; count = (start + 409 <= 2044) ? 409 : 2044 - start; if (t == 0) { sb = k1; db = O_KS1; } else { sb = v1; db = O_VS1; } }
        else { const int rem0 = w - 1408, t = rem0 >> 6, r2 = rem0 & 63; n = r2 >> 1; W = 128; start = (r2 & 1) * 254; count = 254; if (t == 0) { sb = k0; db = O_KS0; } else { sb = v0; db = O_VS0; } }
        src = (unsigned long long)(uintptr_t)sb + ((size_t)n * W + 1) * 4096 + (size_t)start * 1024; dst = (unsigned long long)(uintptr_t)out + db * 4 + (size_t)n * W * 4096 + (size_t)start * 1024; left = (unsigned)count;
    }
    __device__ __forceinline__ void begin(int lane) { voff = (unsigned)lane * 16u; data = (f32x4){0.f, 0.f, 0.f, 0.f}; pdst = dump; }
    __device__ __forceinline__ void step() {
        if (left) {
            asm volatile("global_store_dwordx4 %1, %0, %2\n\tglobal_load_dwordx4 %0, %1, %3" : "+v"(data) : "v"(voff), "s"(pdst), "s"(src) : "memory");
            pdst = dst; src += 1024; dst += 1024; --left;
        }
    }
    __device__ __forceinline__ void flush() {
        asm volatile("s_waitcnt vmcnt(0)\n\tglobal_store_dwordx4 %1, %0, %2" : : "v"(data), "v"(voff), "s"(pdst) : "memory");
        pdst = dump;
    }
};

struct Args { const float* in[20]; float* out; unsigned char* ws; int ph_lo, ph_hi; };
__global__ void __launch_bounds__(NWAVES * 64, 2) mega_fwd(Args args) {
    extern __shared__ __attribute__((aligned(16))) unsigned char lds[];
    Frame F;
    F.lds = (LAS unsigned char*)lds;
    F.MISC = (volatile LAS unsigned*)(F.lds + MISC_OFF);
    F.tid = threadIdx.x; F.lane = F.tid & 63; F.wave = __builtin_amdgcn_readfirstlane(F.tid >> 6);
    F.G = gridDim.x; { const int bx = blockIdx.x; F.vcu = (F.G % 8 == 0) ? (bx % 8) * (F.G / 8) + bx / 8 : bx; }
    F.ws = args.ws; F.out = args.out; F.ctl = (gu32*)(args.ws + WS_CTL);
    F.p_XP = args.in[I_XP]; F.p_XS = args.in[I_XS]; F.p_CK0 = args.in[I_CK0]; F.p_CV0 = args.in[I_CV0]; F.p_CK1 = args.in[I_CK1]; F.p_CV1 = args.in[I_CV1]; F.p_CK2 = args.in[I_CK2]; F.p_CV2 = args.in[I_CV2]; F.p_SP = args.in[I_SP]; F.p_NMIX = args.in[I_NMIX]; F.p_WIN = args.in[I_WIN]; F.p_WUP = args.in[I_WUP]; F.p_WPOOL = args.in[I_WPOOL]; F.p_PSCALE = args.in[I_PSCALE]; F.p_WOUT = args.in[I_WOUT]; F.p_NFFN = args.in[I_NFFN]; F.p_WG = args.in[I_WG]; F.p_WU = args.in[I_WU]; F.p_WD = args.in[I_WD]; F.p_NFIN = args.in[I_NFIN];
    for (int u = F.tid; u < (LDS_BYTES - LDSCTL_OFF) / 4; u += NWAVES * 64) ((LAS unsigned*)(F.lds + LDSCTL_OFF))[u] = 0u;
    __syncthreads();
    XcdBarrier bar; bar.bar = (unsigned*)(F.ctl + CW_BAR); bar.x = 0; bar.st = nullptr;
    if (N_LAUNCHES != PER_PHASE) bar = xcd_barrier_post((unsigned*)(F.ctl + CW_BAR), F.MISC + 8);
#define GRID_BAR() do { if (N_LAUNCHES != PER_PHASE) xcd_barrier(bar); } while (0)
    const int lo = args.ph_lo, hi = args.ph_hi;
#define IN(k) (lo <= (k) && (k) < hi)
#define BOTH(k) (IN(k) && IN((k) + 1))
    bf16* WIN = (bf16*)(F.ws + WS_WIN); bf16* WUP = (bf16*)(F.ws + WS_WUP); bf16* WPL = (bf16*)(F.ws + WS_WPL); bf16* WOUT = (bf16*)(F.ws + WS_WOUT); bf16* WGU = (bf16*)(F.ws + WS_WGU); bf16* WDN = (bf16*)(F.ws + WS_WDN);
    bf16* HN = (bf16*)(F.ws + WS_HN); bf16* QB = (bf16*)(F.ws + WS_QB); bf16* KB = (bf16*)(F.ws + WS_KB); bf16* VB = (bf16*)(F.ws + WS_VB); float* UB = (float*)(F.ws + WS_UB); bf16* GB = (bf16*)(F.ws + WS_GB);
    bf16* ATT = (bf16*)(F.ws + WS_ATT); bf16* PL = (bf16*)(F.ws + WS_PL); bf16* TB = (bf16*)(F.ws + WS_T); bf16* MIX = (bf16*)(F.ws + WS_MIX); bf16* X1B = (bf16*)(F.ws + WS_X1B); bf16* FFB = (bf16*)(F.ws + WS_FFB);
    float* rowss = (float*)(args.ws + WS_CTL) + CW_RSS;
    bf16* NUMB = (bf16*)(F.ws + WS_FFB); float* MLB = (float*)(F.ws + WS_FFB + 64 * MiB);
    const int gw = F.vcu * NWAVES + F.wave, NGW = F.G * NWAVES;
    pg8::NoBg nobg;
    BgStream bgs; bgs.init(F.p_CK0, F.p_CV0, F.p_CK1, F.p_CV1, F.p_CK2, F.p_CV2, F.out, F.ws + WS_DUMP + (size_t)(F.vcu * NWAVES + F.wave) * 1024, F.vcu * NWAVES + F.wave); bgs.begin(lane_now());
    LAS float* SKRED = (LAS float*)(F.lds + RING_OFF);

    if (IN(0)) { p0_prologue(F); if (BOTH(0)) GRID_BAR(); }

    if (IN(1)) {
        pg8::Gemm g{HN, WIN, D, D, 30, 0}; pg8::StaticOrder S; S.init(MPR, INW, F.G, (int)blockIdx.x);
        static_assert(WS_KB - WS_QB == WS_VB - WS_KB, "q/k/v buffers equally spaced");
        pg8::EpiIn E{QB, (WS_KB - WS_QB) / 2, GB, UB, F.out, 0.08838834764831845f * 1.4426950408889634f};
        pg8::gemm_phase<pg8::EpiIn, pg8::StaticOrder, true, true>(F.lds + RING_OFF, g, S, E, nobg);
        { int idx, share; skinny_share((MPR / 256) * (INW / 256), F.G, (int)blockIdx.x, idx, share);
          if (idx >= 0) for (int t = idx; t < INW / 32; t += share) {
              skinny_partial<1>(HN + (size_t)MPR * D, D, WIN + (size_t)32 * t * D, WIN, D, D, SKRED, F.wave, F.lane); LDS_WAIT(); __syncthreads();
              float v[1][2]; skinny_reduce<1>(SKRED, F.tid, v);
              sk_emit_in(QB, (WS_KB - WS_QB) / 2, GB, UB, F.out, 0.08838834764831845f * 1.4426950408889634f, F.tid >> 4, 32 * t + 2 * (F.tid & 15), v[0][0], v[0][1]); __syncthreads(); } }
        if (BOTH(1)) GRID_BAR();
    }

    if (IN(2)) {
        LAS unsigned char* wb = F.lds + RING_OFF + F.wave * 16384;
        LAS float* pl = (LAS float*)(wb + 9216);
        _Pragma("unroll 1") for (int ph = 0; ph < 2; ++ph) {
            if ((ph == 0) == (F.wave < 4)) p2_convert_wgu(F, (LAS float*)wb, gw, NGW);
            else { for (int it = gw; it < NB * 3 * NH * 64; it += NGW) attn_mfma_tile(QB, KB, VB, NUMB, MLB, it, wb, F.lane); }
        }
        if (F.wave < 3) { const int t = F.vcu * 3 + F.wave;
            if (t < NSMP * NH * 3) { const int gq = t % 3, nj = t / 3, n = nj >> 3, j = nj & 7;
                if (gq == 0) attn_sample_partial<0>(F.p_CK0, F.p_CV0, F.out, QB, NUMB, MLB, n, j, pl, F.lane);
                else if (gq == 1) attn_sample_partial<1>(F.p_CK1, F.p_CV1, F.out, QB, NUMB, MLB, n, j, pl, F.lane);
                else attn_sample_partial<2>(F.p_CK2, F.p_CV2, F.out, QB, NUMB, MLB, n, j, pl, F.lane); } }
        pool_naive(F, UB, PL, F.vcu * (NWAVES * 64) + F.tid, F.G * NWAVES * 64);
        if (BOTH(2)) GRID_BAR();
    }

    if (IN(3)) {
        attn_combine(NUMB, MLB, ATT, F.vcu * (NWAVES * 64) + F.tid, F.G * NWAVES * 64);
        pg8::Gemm g{PL, WPL, 512, PW, 2, 512 * 2}; pg8::StaticOrder S; S.init(MPR, D, F.G, (int)blockIdx.x);
        pg8::EpiPool E{GB, F.p_PSCALE, TB};
        pg8::gemm_phase<pg8::EpiPool, pg8::StaticOrder, true, true>(F.lds + RING_OFF, g, S, E, nobg);
        { int idx, share; skinny_share((MPR / 256) * (D / 256), F.G, (int)blockIdx.x, idx, share);
          if (idx >= 0) for (int t = idx; t < D / 32; t += share) {
              skinny_partial<1>(PL + (size_t)MPR * PW + (t >> 5) * 512, PW, WPL + (size_t)32 * t * 512, WPL, 512, 512, SKRED, F.wave, F.lane); LDS_WAIT(); __syncthreads();
              float v[1][2]; skinny_reduce<1>(SKRED, F.tid, v);
              sk_emit_pool(GB, F.p_PSCALE, TB, F.tid >> 4, 32 * t + 2 * (F.tid & 15), v[0][0], v[0][1]); __syncthreads(); } }
        if (BOTH(3)) GRID_BAR();
    }
    if (IN(4)) {
        pg8::Gemm g{ATT, WUP, GW, GW, 30, 0}; pg8::StaticOrder S; S.init(MPR, D, F.G, (int)blockIdx.x);
        pg8::EpiUp E{GB, TB, MIX};
        pg8::gemm_phase<pg8::EpiUp, pg8::StaticOrder, true, true>(F.lds + RING_OFF, g, S, E, nobg);
        { int idx, share; skinny_share((MPR / 256) * (D / 256), F.G, (int)blockIdx.x, idx, share);
          if (idx >= 0) for (int t = idx; t < D / 32; t += share) {
              skinny_partial<1>(ATT + (size_t)MPR * GW, GW, WUP + (size_t)32 * t * GW, WUP, GW, GW, SKRED, F.wave, F.lane); LDS_WAIT(); __syncthreads();
              float v[1][2]; skinny_reduce<1>(SKRED, F.tid, v);
              sk_emit_up(GB, TB, MIX, F.tid >> 4, 32 * t + 2 * (F.tid & 15), v[0][0], v[0][1]); __syncthreads(); } }
        if (BOTH(4)) GRID_BAR();
    }

    if (IN(5)) {
        pg8::Gemm g{MIX, WOUT, D, D, 30, 0}; pg8::StaticOrder S; S.init(MPR, D, F.G, (int)blockIdx.x);
        pg8::EpiOut E{F.p_XP, F.p_XS, F.out + O_Y, X1B, rowss};
        pg8::gemm_phase<pg8::EpiOut, pg8::StaticOrder, true, true>(F.lds + RING_OFF, g, S, E, nobg);
        { int idx, share; skinny_share((MPR / 256) * (D / 256), F.G, (int)blockIdx.x, idx, share);
          if (idx >= 0) for (int t = idx; t < D / 32; t += share) {
              skinny_partial<1>(MIX + (size_t)MPR * D, D, WOUT + (size_t)32 * t * D, WOUT, D, D, SKRED, F.wave, F.lane); LDS_WAIT(); __syncthreads();
              float v[1][2]; skinny_reduce<1>(SKRED, F.tid, v);
              sk_emit_out(F.p_XS, F.out + O_Y, X1B, rowss, F.tid >> 4, 32 * t + 2 * (F.tid & 15), v[0][0], v[0][1], F.tid); __syncthreads(); } }
        if (BOTH(5)) GRID_BAR();
    }

    if (IN(6)) {
        pg8::Gemm g{X1B, WGU, D, D, 30, 0}; pg8::StaticOrder S; S.init(MPR, 2 * FF, F.G, (int)blockIdx.x);
        pg8::EpiFF E{rowss, FFB};
        bgs.begin(lane_now());
        pg8::gemm_phase<pg8::EpiFF, pg8::StaticOrder, true, true, BgStream>(F.lds + RING_OFF, g, S, E, bgs);
        { int idx, share; skinny_share((MPR / 256) * (2 * FF / 256), F.G, (int)blockIdx.x, idx, share);
          if (idx >= 0) for (int t = idx; t < FF / 32; t += share) { const int f0 = 32 * t; const bf16* b0 = WGU + (size_t)((f0 >> 7) * 256 + (f0 & 127)) * D;
              skinny_partial<2>(X1B + (size_t)MPR * D, D, b0, b0 + (size_t)128 * D, D, D, SKRED, F.wave, F.lane); LDS_WAIT(); __syncthreads();
              float v[2][2]; skinny_reduce<2>(SKRED, F.tid, v);
              sk_emit_ff(rowss, FFB, F.tid >> 4, f0 + 2 * (F.tid & 15), v[0][0], v[0][1], v[1][0], v[1][1]); __syncthreads(); } }
        if (BOTH(6)) GRID_BAR();
    }

    if (IN(7)) {
        pg8::Gemm g{FFB, WDN, FF, FF, 30, 0}; pg8::StaticOrder S; S.init(MPR, D, F.G, (int)blockIdx.x);
        pg8::EpiDown E{F.out + O_Y};
        bgs.begin(lane_now());
        pg8::gemm_phase<pg8::EpiDown, pg8::StaticOrder, true, true, BgStream>(F.lds + RING_OFF, g, S, E, bgs);
        { int idx, share; skinny_share((MPR / 256) * (D / 256), F.G, (int)blockIdx.x, idx, share);
          if (idx >= 0) for (int t = idx; t < D / 32; t += share) {
              skinny_partial<1>(FFB + (size_t)MPR * FF, FF, WDN + (size_t)32 * t * FF, WDN, FF, FF, SKRED, F.wave, F.lane); LDS_WAIT(); __syncthreads();
              float v[1][2]; skinny_reduce<1>(SKRED, F.tid, v);
              sk_emit_down(F.out + O_Y, F.tid >> 4, 32 * t + 2 * (F.tid & 15), v[0][0], v[0][1]); __syncthreads(); } }
        if (BOTH(7)) GRID_BAR();
    }

    if (IN(8)) {
        bgs.begin(lane_now());
        while (bgs.left) { asm volatile("s_waitcnt vmcnt(0)" ::: "memory"); bgs.step(); }
        bgs.flush();
        { const int ln = lane_now(); for (int m = gw; m < MREAL; m += NGW) final_norm_row(F.out + O_Y + (size_t)m * D, F.p_NFIN, ln); }
    }
#undef IN
#undef BOTH
#undef GRID_BAR
}

extern "C" void kernel_launch(void* const* d_in, const int* in_sizes, int n_in, void* d_out, int out_size, void* d_ws, size_t ws_size, hipStream_t stream) {
    static int grid = 0;
    if (grid == 0) {
        if (n_in != 20 || in_sizes[0] != MPR * D || (size_t)out_size != O_END || ws_size < WS_END) {
            fprintf(stderr, "kernel_launch: shape mismatch: n_in %d in0 %d out %d (want %zu) ws %zu (want %zu); nothing launched\n", n_in, n_in > 0 ? in_sizes[0] : -1, out_size, (size_t)O_END, ws_size, (size_t)WS_END); grid = -1; return; }
        int dev = 0, cus = 0, per_cu = 0;
        if (hipGetDevice(&dev) != hipSuccess || hipDeviceGetAttribute(&cus, hipDeviceAttributeMultiprocessorCount, dev) != hipSuccess) { grid = -1; return; }
        if (hipFuncSetAttribute((const void*)mega_fwd, hipFuncAttributeMaxDynamicSharedMemorySize, LDS_BYTES) != hipSuccess) { fprintf(stderr, "kernel_launch: hipFuncSetAttribute failed\n"); grid = -1; return; }
        if (hipOccupancyMaxActiveBlocksPerMultiprocessor(&per_cu, (const void*)mega_fwd, NWAVES * 64, LDS_BYTES) != hipSuccess || per_cu < 1) { fprintf(stderr, "kernel_launch: occupancy query says %d blocks per CU\n", per_cu); }
        (void)hipGetLastError();
        grid = cus;
    }
    if (grid < 0) return;
    (void)hipMemsetAsync((char*)d_ws + WS_CTL, 0, CTL_ZERO_BYTES, stream);
    Args a{};
    for (int i = 0; i < 20; ++i) a.in[i] = (const float*)d_in[i];
    a.out = (float*)d_out; a.ws = (unsigned char*)d_ws;
    for (int li = 0; li < N_LAUNCHES; ++li) {
        a.ph_lo = (N_LAUNCHES == PER_PHASE) ? li : 0; a.ph_hi = (N_LAUNCHES == PER_PHASE) ? li + 1 : PER_PHASE;
        hipLaunchKernelGGL(mega_fwd, dim3(grid), dim3(NWAVES * 64), LDS_BYTES, stream, a);
    }
}
```

```cpp
#include <hip/hip_runtime.h>
#include <cstdio>
#include <cstdint>
#include <cmath>
namespace pg8 {
#define PG8_LAS __attribute__((address_space(3)))
typedef unsigned short bf16_t;
typedef short bf16x8 __attribute__((ext_vector_type(8)));
typedef float f32x4 __attribute__((ext_vector_type(4)));
typedef unsigned u32x4 __attribute__((ext_vector_type(4)));
constexpr int BM = 256, BK = 64, HALF = 128, HTB = HALF * BK * 2  , STAGE_BYTES = 8 * HTB, NXCD = 8, WGM = 8;

__host__ __device__ __forceinline__ int lds_byte(int r, int c) { const int st = (r >> 4) * 2 + (c >> 5), rr = r & 15, cc = c & 31, ob = rr * 64 + cc * 2; return st * 1024 + (ob ^ (((ob >> 9) & 1) << 5)); }
__host__ __device__ __forceinline__ void stage_rc(int b, int& R, int& C) { const int st = b / 1024, sb = b % 1024, swz = sb ^ (((sb >> 9) & 1) << 5); R = (st >> 1) * 16 + swz / 64; C = (st & 1) * 32 + (swz % 64) / 2; }
__host__ __device__ __forceinline__ int perm32(int rho) { const int n = rho >> 4, i = rho & 15; return 8 * (i >> 2) + 4 * n + (i & 3); }
template <bool PERM> __host__ __device__ __forceinline__ size_t bl_off(int row, int k, int nt) {
    const int r128 = row & 127, w = r128 & 31;
    const int R = PERM ? ((r128 & 96) + ((w >> 2) & 1) * 16 + (w >> 3) * 4 + (w & 3)) : r128;
    return (((size_t)(row >> 8) * nt + (k >> 6)) * 2 + ((row >> 7) & 1)) * 16384 + (size_t)lds_byte(R, k & 63);
}

struct Unit { int pm, pn; };
struct Gemm { const bf16_t* A; const bf16_t* Bt; int K, lda, ashift; size_t astride; };

struct StaticOrder {
    int nM, nN, nwg, G, c;
    __host__ __device__ void init(int M, int N, int G_, int c_) { nM = M / BM; nN = N / BM; nwg = nM * nN; G = G_; c = c_; }
    __host__ __device__ bool next(int i, Unit& u) const {
        const long L = (long)i * G + c; if (L >= nwg) return false;
        int wgid = (int)L; { const int q = nwg / NXCD, r = nwg % NXCD, xcd = wgid % NXCD, off = wgid / NXCD; wgid = (xcd < r ? xcd * (q + 1) : r * (q + 1) + (xcd - r) * q) + off; }
        const int nig = WGM * nN, gid = wgid / nig, fm = gid * WGM, gsz = (nM - fm) < WGM ? (nM - fm) : WGM;
        u.pm = fm + ((wgid % nig) % gsz); u.pn = (wgid % nig) / gsz; return true;
    }
    __device__ __forceinline__ void a_ready(const Unit&) const {}
    __device__ __forceinline__ void done(const Unit&) const {}
};

typedef float f32x2_cv __attribute__((ext_vector_type(2))); typedef __bf16 bf16x2_cv __attribute__((ext_vector_type(2)));
__device__ __forceinline__ unsigned cvt_pk_bf16(float lo, float hi) { const f32x2_cv v = {lo, hi}; const bf16x2_cv b = __builtin_convertvector(v, bf16x2_cv); return __builtin_bit_cast(unsigned, b); }
typedef float f32x2 __attribute__((ext_vector_type(2)));

struct NoBg { __device__ __forceinline__ void step() {} __device__ __forceinline__ void flush() {} };
template <class Epi, class Sched, bool ALIGN_EPI = false, bool SP2 = false, class Bg = NoBg>
__device__ __forceinline__ void gemm_phase(PG8_LAS unsigned char* lds, const Gemm g, const Sched& S, const Epi& E, Bg& bg) {
    const int tid = threadIdx.x, wid = __builtin_amdgcn_readfirstlane(tid >> 6), lane = tid & 63, wr = wid >> 2, wc = wid & 3, fr = lane & 15, fq = lane >> 4;
    const int K = g.K, nt = K / BK, lda = g.lda;
    unsigned voffA[2], voffB[2];
#pragma unroll
    for (int i = 0; i < 2; ++i) { int R, C; stage_rc(tid * 16 + i * 8192, R, C); const int Rb = Epi::PERM ? ((R & ~31) + perm32(R & 31)) : R;
        voffA[i] = (unsigned)(R * lda + C) * 2u; voffB[i] = (unsigned)(tid * 16 + i * 8192); (void)Rb; }
    const size_t kstep = (size_t)(BK * 2);
    const size_t kstepB = (size_t)(2 * HTB);
    const size_t hsB = (size_t)HTB, hsA = (size_t)HALF * lda * 2;
    const size_t tsB = (size_t)nt * kstepB, tsA = 2 * hsA;
    const unsigned ldsw = (unsigned)wid * 1024u;
    const int aoff = lds_byte(wr * 64 + fr, fq * 8), boff = lds_byte(wc * 32 + fr, fq * 8);
#define PG8_SA(b, h) (((b) * 2 + (h)) * HTB)
#define PG8_SB(b, h) ((4 + (b) * 2 + (h)) * HTB)
#define PG8_STAGE(bufoff, gbase, voff) do { _Pragma("unroll") for (int _i = 0; _i < 2; ++_i) \
        __builtin_amdgcn_global_load_lds((const unsigned*)((const char*)(gbase) + (voff)[_i]), (PG8_LAS unsigned*)(lds + (bufoff) + ldsw + _i * 8192), 16, 0, 0); } while (0)
#define PG8_LDA(dst, b, h) do { _Pragma("unroll") for (int m = 0; m < 4; ++m) _Pragma("unroll") for (int k = 0; k < 2; ++k) dst[m][k] = *(const PG8_LAS bf16x8*)(lds + PG8_SA(b, h) + aoff + m * 2048 + k * 1024); } while (0)
#define PG8_LDB(dst, b, h) do { _Pragma("unroll") for (int n = 0; n < 2; ++n) _Pragma("unroll") for (int k = 0; k < 2; ++k) dst[n][k] = *(const PG8_LAS bf16x8*)(lds + PG8_SB(b, h) + boff + n * 2048 + k * 1024); } while (0)
#define PG8_MMA(ai, bj, At, Bt) do { __builtin_amdgcn_s_setprio(1); _Pragma("unroll") for (int m = 0; m < 4; ++m) _Pragma("unroll") for (int n = 0; n < 2; ++n) _Pragma("unroll") for (int k = 0; k < 2; ++k) \
        acc[ai][bj][m][n] = __builtin_amdgcn_mfma_f32_16x16x32_bf16(Bt[n][k], At[m][k], acc[ai][bj][m][n], 0, 0, 0); __builtin_amdgcn_s_setprio(0); } while (0)
#define PG8_WAIT_V(n) asm volatile("s_waitcnt vmcnt(" #n ")" ::: "memory")
#define PG8_WAIT_L(n) asm volatile("s_waitcnt lgkmcnt(" #n ")" ::: "memory")
#define PG8_BAR __builtin_amdgcn_s_barrier()
#define PG8_SCHED __builtin_amdgcn_sched_barrier(0)
    Unit cur, nxt; int ui = 0;
    if (!S.next(0, cur)) return;
    f32x4 acc[2][2][4][2];
#pragma unroll
    for (int a = 0; a < 2; ++a)
#pragma unroll
        for (int b = 0; b < 2; ++b)
#pragma unroll
            for (int m = 0; m < 4; ++m)
#pragma unroll
                for (int n = 0; n < 2; ++n) acc[a][b][m][n] = (f32x4){0.f, 0.f, 0.f, 0.f};
    bf16x8 At[4][2], B0[2][2], B1[2][2];
    const char* cA = (const char*)g.A + (size_t)cur.pm * tsA + (size_t)(cur.pn >> g.ashift) * g.astride; const char* cB = (const char*)g.Bt + (size_t)cur.pn * tsB;
    S.a_ready(cur);
    if constexpr (SP2) {
        PG8_STAGE(PG8_SB(0, 0), cB, voffB); PG8_STAGE(PG8_SB(0, 1), cB + hsB, voffB); PG8_STAGE(PG8_SA(0, 0), cA, voffA); PG8_STAGE(PG8_SA(0, 1), cA + hsA, voffA);
        if (wr == 1) PG8_BAR;
        PG8_WAIT_V(2); PG8_BAR;
        PG8_STAGE(PG8_SB(1, 0), cB + kstepB, voffB); PG8_STAGE(PG8_SA(1, 0), cA + kstep, voffA); PG8_STAGE(PG8_SB(1, 1), cB + hsB + kstepB, voffB);
        PG8_WAIT_V(6); PG8_BAR;
    } else {
        PG8_STAGE(PG8_SB(0, 0), cB, voffB); PG8_STAGE(PG8_SA(0, 0), cA, voffA); PG8_STAGE(PG8_SB(0, 1), cB + hsB, voffB); PG8_STAGE(PG8_SA(0, 1), cA + hsA, voffA);
        if (wr == 1) PG8_BAR;
        PG8_WAIT_V(4); PG8_BAR;
        PG8_STAGE(PG8_SB(1, 0), cB + kstepB, voffB); PG8_STAGE(PG8_SA(1, 0), cA + kstep, voffA); PG8_STAGE(PG8_SB(1, 1), cB + hsB + kstepB, voffB);
        PG8_WAIT_V(6); PG8_BAR;
    }
    for (;;) {
        const bool has_next = S.next(ui + 1, nxt);
        const char* nA = has_next ? (const char*)g.A + (size_t)nxt.pm * tsA + (size_t)(nxt.pn >> g.ashift) * g.astride : cA; const char* nB = has_next ? (const char*)g.Bt + (size_t)nxt.pn * tsB : cB;
        for (int t = 0; t < nt; t += 2) {
            const bool last = (t == nt - 2);
            const char* a1 = cA + (size_t)(t + 1) * kstep;
            const char* a2 = last ? nA : cA + (size_t)(t + 2) * kstep; const char* b2 = last ? nB : cB + (size_t)(t + 2) * kstepB;
            const char* a3 = a2 + kstep; const char* b3 = b2 + kstepB;
            if (last && has_next) S.a_ready(nxt);
            bg.step();
            if constexpr (SP2) {
            PG8_LDB(B0, 0, 0); PG8_LDB(B1, 0, 1); PG8_SCHED; PG8_LDA(At, 0, 0); PG8_STAGE(PG8_SA(1, 1), a1 + hsA, voffA);
            PG8_WAIT_V(8); PG8_WAIT_L(0); PG8_BAR; PG8_MMA(0, 0, At, B0); PG8_MMA(0, 1, At, B1); PG8_BAR; PG8_SCHED;
            PG8_LDA(At, 0, 1); PG8_STAGE(PG8_SB(0, 0), b2, voffB); PG8_STAGE(PG8_SB(0, 1), b2 + hsB, voffB); PG8_STAGE(PG8_SA(0, 0), a2, voffA);
            PG8_WAIT_V(8); PG8_WAIT_L(0); PG8_BAR; PG8_MMA(1, 0, At, B0); PG8_MMA(1, 1, At, B1); PG8_BAR; PG8_SCHED;
            PG8_LDB(B0, 1, 0); PG8_LDB(B1, 1, 1); PG8_SCHED; PG8_LDA(At, 1, 0); PG8_STAGE(PG8_SA(0, 1), a2 + hsA, voffA);
            PG8_WAIT_V(8); PG8_WAIT_L(0); PG8_BAR; PG8_MMA(0, 0, At, B0); PG8_MMA(0, 1, At, B1); PG8_BAR; PG8_SCHED;
            PG8_LDA(At, 1, 1); PG8_STAGE(PG8_SB(1, 0), b3, voffB); PG8_STAGE(PG8_SB(1, 1), b3 + hsB, voffB); PG8_STAGE(PG8_SA(1, 0), a3, voffA);
            PG8_WAIT_V(8); PG8_WAIT_L(0); PG8_BAR; PG8_MMA(1, 0, At, B0); PG8_MMA(1, 1, At, B1); PG8_BAR; PG8_SCHED;
            } else {
            PG8_LDB(B0, 0, 0); PG8_SCHED; PG8_LDA(At, 0, 0); PG8_STAGE(PG8_SA(1, 1), a1 + hsA, voffA);
            PG8_WAIT_L(8); PG8_BAR; PG8_WAIT_L(0); PG8_MMA(0, 0, At, B0); PG8_BAR; PG8_SCHED;
            PG8_LDB(B1, 0, 1); PG8_STAGE(PG8_SB(0, 0), b2, voffB);
            PG8_BAR; PG8_WAIT_L(0); PG8_MMA(0, 1, At, B1); PG8_BAR;
            PG8_LDA(At, 0, 1); PG8_STAGE(PG8_SA(0, 0), a2, voffA);
            PG8_BAR; PG8_WAIT_L(0); PG8_MMA(1, 0, At, B0); PG8_BAR; PG8_SCHED;
            PG8_STAGE(PG8_SB(0, 1), b2 + hsB, voffB);
            PG8_WAIT_V(6); PG8_BAR; PG8_MMA(1, 1, At, B1); PG8_BAR;
            PG8_LDB(B0, 1, 0); PG8_SCHED; PG8_LDA(At, 1, 0); PG8_STAGE(PG8_SA(0, 1), a2 + hsA, voffA);
            PG8_WAIT_L(8); PG8_BAR; PG8_WAIT_L(0); PG8_MMA(0, 0, At, B0); PG8_BAR; PG8_SCHED;
            PG8_LDB(B1, 1, 1); PG8_STAGE(PG8_SB(1, 0), b3, voffB);
            PG8_BAR; PG8_WAIT_L(0); PG8_MMA(0, 1, At, B1); PG8_BAR;
            PG8_LDA(At, 1, 1); PG8_STAGE(PG8_SA(1, 0), a3, voffA);
            PG8_BAR; PG8_WAIT_L(0); PG8_MMA(1, 0, At, B0); PG8_BAR; PG8_SCHED;
            PG8_STAGE(PG8_SB(1, 1), b3 + hsB, voffB);
            PG8_WAIT_V(6); PG8_BAR; PG8_MMA(1, 1, At, B1); PG8_BAR;
            }
        }
        if constexpr (ALIGN_EPI) { if (wr == 0) PG8_BAR; }
        if constexpr (!Epi::AFTER_DRAIN) { E(acc, cur, wr, wc, fr, fq); S.done(cur); }
        if (!has_next) break;
#pragma unroll
        for (int a = 0; a < 2; ++a)
#pragma unroll
            for (int b = 0; b < 2; ++b)
#pragma unroll
                for (int m = 0; m < 4; ++m)
#pragma unroll
                    for (int n = 0; n < 2; ++n) acc[a][b][m][n] = (f32x4){0.f, 0.f, 0.f, 0.f};
        cur = nxt; cA = nA; cB = nB; ++ui;
        if constexpr (ALIGN_EPI) { if (wr == 1) PG8_BAR; }
    }
    bg.flush();
    PG8_WAIT_V(0);
    if constexpr (!ALIGN_EPI) { if (wr == 0) PG8_BAR; }
    PG8_BAR;
    if constexpr (Epi::AFTER_DRAIN) { E.fused(acc, cur, wr, wc, fr, fq, lds, wid, lane); S.done(cur); }
#undef PG8_SA
#undef PG8_SB
#undef PG8_STAGE
#undef PG8_LDA
#undef PG8_LDB
#undef PG8_MMA
#undef PG8_WAIT_V
#undef PG8_WAIT_L
#undef PG8_BAR
#undef PG8_SCHED
}
}

constexpr int D = 4096, NB = 4, SEQ = 2048, MPR = NB * SEQ  , NSMP = 32, MREAL = MPR + NSMP  , MP = 8448  ;
constexpr int HD = 128, NH = 8, GW = NH * HD  , QKVW = 3 * GW  , PW = 2048, INW = 3 * QKVW + PW + 2 * D  , FF = 11008;
constexpr int PHIST = 15;
constexpr float RMS_EPS = 1e-6f;
constexpr size_t O_Y = 0;
constexpr size_t O_KP0 = (size_t)MREAL * D;
constexpr size_t O_VP0 = O_KP0 + (size_t)NB * 128 * GW;
constexpr size_t O_KP1 = O_VP0 + (size_t)NB * 128 * GW;
constexpr size_t O_VP1 = O_KP1 + (size_t)NB * 512 * GW;
constexpr size_t O_KP2 = O_VP1 + (size_t)NB * 512 * GW;
constexpr size_t O_VP2 = O_KP2 + (size_t)NB * 2048 * GW;
constexpr size_t O_PP  = O_VP2 + (size_t)NB * 2048 * GW;
constexpr size_t O_KS0 = O_PP + (size_t)NB * PHIST * PW;
constexpr size_t O_VS0 = O_KS0 + (size_t)NSMP * 128 * GW;
constexpr size_t O_KS1 = O_VS0 + (size_t)NSMP * 128 * GW;
constexpr size_t O_VS1 = O_KS1 + (size_t)NSMP * 512 * GW;
constexpr size_t O_KS2 = O_VS1 + (size_t)NSMP * 512 * GW;
constexpr size_t O_VS2 = O_KS2 + (size_t)NSMP * 2048 * GW;
constexpr size_t O_PS  = O_VS2 + (size_t)NSMP * 2048 * GW;
constexpr size_t O_END = O_PS + (size_t)NSMP * PHIST * PW;

namespace pg8 {
__device__ __forceinline__ float bf_lo(unsigned w) { return __uint_as_float(w << 16); }
__device__ __forceinline__ float bf_hi(unsigned w) { return __uint_as_float(w & 0xffff0000u); }
__device__ __forceinline__ float sigmoidf_(float x) { return __builtin_amdgcn_rcpf(1.0f + __builtin_amdgcn_exp2f(-1.4426950408889634f * x)); }

struct EpiIn {
    static constexpr bool PERM = true, AFTER_DRAIN = false;
    bf16_t *QB; size_t qkv_stride  ; bf16_t* GB; float* UB; float* out; float qscale;
    __device__ __forceinline__ void operator()(const f32x4 (&acc)[2][2][4][2], const Unit& u, int wr, int wc, int fr, int fq) const {
        const int colt = u.pn * BM, cl = wc * 32 + 8 * fq, rbase = u.pm * BM + wr * 64 + fr;
        if (colt < 3 * QKVW) {
            const int which = colt / QKVW, c3 = colt - which * QKVW;
            bf16_t* B = QB + (size_t)which * qkv_stride; const float sc = which == 0 ? qscale : 1.0f;
#pragma unroll
            for (int ai = 0; ai < 2; ++ai)
#pragma unroll
                for (int m = 0; m < 4; ++m) { bf16_t* rowp = B + (size_t)(rbase + ai * HALF + m * 16) * QKVW + c3 + cl;
#pragma unroll
                    for (int bj = 0; bj < 2; ++bj) { const f32x4 v0 = acc[ai][bj][m][0] * sc, v1 = acc[ai][bj][m][1] * sc; u32x4 w;
                        w.x = cvt_pk_bf16(v0[0], v0[1]); w.y = cvt_pk_bf16(v0[2], v0[3]); w.z = cvt_pk_bf16(v1[0], v1[1]); w.w = cvt_pk_bf16(v1[2], v1[3]);
                        *(u32x4*)(rowp + bj * HALF) = w; } }
            if (which != 0) {
                const int g = c3 / GW, cg = c3 - g * GW + cl, W = g == 0 ? 128 : (g == 1 ? 512 : 2048);
                float* op = out + (g == 0 ? (which == 1 ? O_KP0 : O_VP0) : g == 1 ? (which == 1 ? O_KP1 : O_VP1) : (which == 1 ? O_KP2 : O_VP2));
                float* os = out + (g == 0 ? (which == 1 ? O_KS0 : O_VS0) : g == 1 ? (which == 1 ? O_KS1 : O_VS1) : (which == 1 ? O_KS2 : O_VS2));
#pragma unroll
                for (int ai = 0; ai < 2; ++ai)
#pragma unroll
                    for (int m = 0; m < 4; ++m) { const int row = rbase + ai * HALF + m * 16; float* dst = nullptr;
                        if (row < MPR) { const int b = row >> 11, tt = (row & (SEQ - 1)) - (SEQ - W); if (tt >= 0) dst = op + ((size_t)(b * W + tt)) * GW + cg; }
                        else if (row < MREAL) { dst = os + ((size_t)((row - MPR) * W + (W - 1))) * GW + cg; }
                        if (dst) {
#pragma unroll
                            for (int bj = 0; bj < 2; ++bj)
#pragma unroll
                                for (int n = 0; n < 2; ++n) *(f32x4*)(dst + bj * HALF + 4 * n) = acc[ai][bj][m][n]; } }
            }
        } else if (colt < 3 * QKVW + PW) {
            const int c = colt - 3 * QKVW + cl;
#pragma unroll
            for (int ai = 0; ai < 2; ++ai)
#pragma unroll
                for (int m = 0; m < 4; ++m) { const int row = rbase + ai * HALF + m * 16; float* up = UB + (size_t)row * PW + c; float* dst = nullptr;
                    if (row < MPR) { const int b = row >> 11, tt = (row & (SEQ - 1)) - (SEQ - PHIST); if (tt >= 0) dst = out + O_PP + ((size_t)(b * PHIST + tt)) * PW + c; }
                    else if (row < MREAL) { dst = out + O_PS + ((size_t)((row - MPR) * PHIST + (PHIST - 1))) * PW + c; }
#pragma unroll
                    for (int bj = 0; bj < 2; ++bj)
#pragma unroll
                        for (int n = 0; n < 2; ++n) { *(f32x4*)(up + bj * HALF + 4 * n) = acc[ai][bj][m][n]; if (dst) *(f32x4*)(dst + bj * HALF + 4 * n) = acc[ai][bj][m][n]; } }
        } else {
            const int c = colt - (3 * QKVW + PW) + cl;
#pragma unroll
            for (int ai = 0; ai < 2; ++ai)
#pragma unroll
                for (int m = 0; m < 4; ++m) { bf16_t* rowp = GB + (size_t)(rbase + ai * HALF + m * 16) * (2 * D) + c;
#pragma unroll
                    for (int bj = 0; bj < 2; ++bj) { const f32x4 v0 = acc[ai][bj][m][0], v1 = acc[ai][bj][m][1]; u32x4 w;
                        w.x = cvt_pk_bf16(sigmoidf_(v0[0]), sigmoidf_(v0[1])); w.y = cvt_pk_bf16(sigmoidf_(v0[2]), sigmoidf_(v0[3]));
                        w.z = cvt_pk_bf16(sigmoidf_(v1[0]), sigmoidf_(v1[1])); w.w = cvt_pk_bf16(sigmoidf_(v1[2]), sigmoidf_(v1[3]));
                        *(u32x4*)(rowp + bj * HALF) = w; } }
        }
    }
};

#define EPI_FENCE() asm volatile("" ::: "memory")
struct EpiPool {
    static constexpr bool PERM = true, AFTER_DRAIN = false;
    const bf16_t* GB; const float* pscale; bf16_t* T;
    __device__ __forceinline__ void operator()(const f32x4 (&acc)[2][2][4][2], const Unit& u, int wr, int wc, int fr, int fq) const {
        const int col0 = u.pn * BM + wc * 32 + 8 * fq, rbase = u.pm * BM + wr * 64 + fr;
        f32x4 sv[2][2];
#pragma unroll
        for (int bj = 0; bj < 2; ++bj)
#pragma unroll
            for (int n = 0; n < 2; ++n) sv[bj][n] = *(const f32x4*)(pscale + col0 + bj * HALF + 4 * n);
#pragma unroll
        for (int ai = 0; ai < 2; ++ai) {
            u32x4 gq[4][2];
#pragma unroll
            for (int m = 0; m < 4; ++m)
#pragma unroll
                for (int bj = 0; bj < 2; ++bj) gq[m][bj] = *(const u32x4*)(GB + (size_t)(rbase + ai * HALF + m * 16) * (2 * D) + D + col0 + bj * HALF);
            EPI_FENCE();
#pragma unroll
            for (int m = 0; m < 4; ++m) { const size_t row = (size_t)(rbase + ai * HALF + m * 16);
#pragma unroll
                for (int bj = 0; bj < 2; ++bj) { const u32x4 g = gq[m][bj];
                    const f32x4 v0 = acc[ai][bj][m][0] * sv[bj][0], v1 = acc[ai][bj][m][1] * sv[bj][1]; u32x4 w;
                    w.x = cvt_pk_bf16(v0[0] * bf_lo(g.x), v0[1] * bf_hi(g.x)); w.y = cvt_pk_bf16(v0[2] * bf_lo(g.y), v0[3] * bf_hi(g.y));
                    w.z = cvt_pk_bf16(v1[0] * bf_lo(g.z), v1[1] * bf_hi(g.z)); w.w = cvt_pk_bf16(v1[2] * bf_lo(g.w), v1[3] * bf_hi(g.w));
                    *(u32x4*)(T + row * D + col0 + bj * HALF) = w; } }
            EPI_FENCE();
        }
    }
};
struct EpiUp {
    static constexpr bool PERM = true, AFTER_DRAIN = false;
    const bf16_t* GB; const bf16_t* T; bf16_t* MIX;
    __device__ __forceinline__ void operator()(const f32x4 (&acc)[2][2][4][2], const Unit& u, int wr, int wc, int fr, int fq) const {
        const int col0 = u.pn * BM + wc * 32 + 8 * fq, rbase = u.pm * BM + wr * 64 + fr;
#pragma unroll
        for (int ai = 0; ai < 2; ++ai) {
            u32x4 gq[4][2], tq[4][2];
#pragma unroll
            for (int m = 0; m < 4; ++m)
#pragma unroll
                for (int bj = 0; bj < 2; ++bj) { const size_t row = (size_t)(rbase + ai * HALF + m * 16);
                    gq[m][bj] = *(const u32x4*)(GB + row * (2 * D) + col0 + bj * HALF); tq[m][bj] = *(const u32x4*)(T + row * D + col0 + bj * HALF); }
            EPI_FENCE();
#pragma unroll
            for (int m = 0; m < 4; ++m) { const size_t row = (size_t)(rbase + ai * HALF + m * 16);
#pragma unroll
                for (int bj = 0; bj < 2; ++bj) { const u32x4 g = gq[m][bj], t = tq[m][bj];
                    const f32x4 v0 = acc[ai][bj][m][0], v1 = acc[ai][bj][m][1]; u32x4 w;
                    w.x = cvt_pk_bf16(v0[0] * bf_lo(g.x) + bf_lo(t.x), v0[1] * bf_hi(g.x) + bf_hi(t.x)); w.y = cvt_pk_bf16(v0[2] * bf_lo(g.y) + bf_lo(t.y), v0[3] * bf_hi(g.y) + bf_hi(t.y));
                    w.z = cvt_pk_bf16(v1[0] * bf_lo(g.z) + bf_lo(t.z), v1[1] * bf_hi(g.z) + bf_hi(t.z)); w.w = cvt_pk_bf16(v1[2] * bf_lo(g.w) + bf_lo(t.w), v1[3] * bf_hi(g.w) + bf_hi(t.w));
                    *(u32x4*)(MIX + row * D + col0 + bj * HALF) = w; } }
            EPI_FENCE();
        }
    }
};
struct EpiOut {
    static constexpr bool PERM = false, AFTER_DRAIN = false;
    const float* xp; const float* xs; float* y; bf16_t* X1B; float* rowss;
    __device__ __forceinline__ void operator()(const f32x4 (&acc)[2][2][4][2], const Unit& u, int wr, int wc, int fr, int fq) const {
        const int col0 = u.pn * BM + wc * 32 + 4 * fq, rbase = u.pm * BM + wr * 64 + fr;
        typedef unsigned u32x2v __attribute__((ext_vector_type(2)));
#pragma unroll
        for (int ai = 0; ai < 2; ++ai) {
            f32x4 xin[4][2][2];
#pragma unroll
            for (int m = 0; m < 4; ++m) { const int row = rbase + ai * HALF + m * 16; const int rc = row < MREAL ? row : MREAL - 1;
                const float* xr = (rc < MPR ? xp + (size_t)rc * D : xs + (size_t)(rc - MPR) * D) + col0;
#pragma unroll
                for (int bj = 0; bj < 2; ++bj)
#pragma unroll
                    for (int n = 0; n < 2; ++n) xin[m][bj][n] = *(const f32x4*)(xr + bj * HALF + n * 16); }
            EPI_FENCE();
#pragma unroll
            for (int m = 0; m < 4; ++m) { const int row = rbase + ai * HALF + m * 16; const bool real = row < MREAL; float ss = 0.f;
#pragma unroll
                for (int bj = 0; bj < 2; ++bj)
#pragma unroll
                    for (int n = 0; n < 2; ++n) { const f32x4 o = acc[ai][bj][m][n] + xin[m][bj][n];
                        if (real) *(f32x4*)(y + (size_t)row * D + col0 + bj * HALF + n * 16) = o;
                        u32x2v w; w.x = cvt_pk_bf16(o[0], o[1]); w.y = cvt_pk_bf16(o[2], o[3]); *(u32x2v*)(X1B + (size_t)row * D + col0 + bj * HALF + n * 16) = w;
                        ss += (o[0] * o[0] + o[1] * o[1]) + (o[2] * o[2] + o[3] * o[3]); }
                ss += __shfl_xor(ss, 16); ss += __shfl_xor(ss, 32);
                if (fq == 0 && real) atomicAdd(rowss + row, ss); }
            EPI_FENCE();
        }
    }
};
struct EpiFF {
    static constexpr bool PERM = true, AFTER_DRAIN = false;
    const float* rowss; bf16_t* FFB;
    __device__ __forceinline__ void operator()(const f32x4 (&acc)[2][2][4][2], const Unit& u, int wr, int wc, int fr, int fq) const {
        const int col0 = u.pn * HALF + wc * 32 + 8 * fq, rbase = u.pm * BM + wr * 64 + fr;
        float rs[2][4];
#pragma unroll
        for (int ai = 0; ai < 2; ++ai)
#pragma unroll
            for (int m = 0; m < 4; ++m) rs[ai][m] = rowss[rbase + ai * HALF + m * 16];
        EPI_FENCE();
#pragma unroll
        for (int ai = 0; ai < 2; ++ai)
#pragma unroll
            for (int m = 0; m < 4; ++m) { const int row = rbase + ai * HALF + m * 16; const float r = 1.0f / sqrtf(rs[ai][m] * (1.0f / D) + RMS_EPS);
                u32x4 w; float o[8];
#pragma unroll
                for (int n = 0; n < 2; ++n)
#pragma unroll
                    for (int j = 0; j < 4; ++j) { const float gv = acc[ai][0][m][n][j] * r, uv = acc[ai][1][m][n][j] * r; o[4 * n + j] = gv * sigmoidf_(gv) * uv; }
                w.x = cvt_pk_bf16(o[0], o[1]); w.y = cvt_pk_bf16(o[2], o[3]); w.z = cvt_pk_bf16(o[4], o[5]); w.w = cvt_pk_bf16(o[6], o[7]);
                *(u32x4*)(FFB + (size_t)row * FF + col0) = w; }
    }
};
struct EpiDown {
    static constexpr bool PERM = false, AFTER_DRAIN = false;
    float* y;
    __device__ __forceinline__ void operator()(const f32x4 (&acc)[2][2][4][2], const Unit& u, int wr, int wc, int fr, int fq) const {
        const int col0 = u.pn * BM + wc * 32 + 4 * fq, rbase = u.pm * BM + wr * 64 + fr;
#pragma unroll
        for (int ai = 0; ai < 2; ++ai) {
            f32x4 yin[4][2][2];
#pragma unroll
            for (int m = 0; m < 4; ++m) { const int row = rbase + ai * HALF + m * 16; const int rc = row < MREAL ? row : MREAL - 1; const float* yr = y + (size_t)rc * D + col0;
#pragma unroll
                for (int bj = 0; bj < 2; ++bj)
#pragma unroll
                    for (int n = 0; n < 2; ++n) yin[m][bj][n] = *(const f32x4*)(yr + bj * HALF + n * 16); }
            EPI_FENCE();
#pragma unroll
            for (int m = 0; m < 4; ++m) { const int row = rbase + ai * HALF + m * 16;
                if (row < MREAL) { float* yr = y + (size_t)row * D + col0;
#pragma unroll
                    for (int bj = 0; bj < 2; ++bj)
#pragma unroll
                        for (int n = 0; n < 2; ++n) *(f32x4*)(yr + bj * HALF + n * 16) = yin[m][bj][n] + acc[ai][bj][m][n]; } }
            EPI_FENCE();
        }
    }
};
}

constexpr int NWAVES = 8;
#ifndef MK_N_LAUNCHES
#define MK_N_LAUNCHES 1
#endif
constexpr int PER_PHASE = 9;
constexpr int N_LAUNCHES = MK_N_LAUNCHES;

constexpr size_t MiB = 1u << 20;
constexpr size_t al256(size_t x) { return (x + 255) & ~(size_t)255; }
constexpr size_t WS_CTL = 0, CTL_ZERO_BYTES = 1 * MiB;
constexpr size_t WS_WIN  = 1 * MiB;
constexpr size_t WS_WUP  = WS_WIN  + al256((size_t)INW * D * 2);
constexpr size_t WS_WPL  = WS_WUP  + al256((size_t)D * GW * 2);
constexpr size_t WS_WOUT = WS_WPL  + al256((size_t)D * 512 * 2);
constexpr size_t WS_WGU  = WS_WOUT + al256((size_t)D * D * 2);
constexpr size_t WS_WDN  = WS_WGU  + al256((size_t)2 * FF * D * 2);
constexpr size_t WS_HN   = WS_WDN  + al256((size_t)D * FF * 2);
constexpr size_t WS_QB   = WS_HN   + al256((size_t)MP * D * 2);
constexpr size_t WS_KB   = WS_QB   + al256((size_t)MP * QKVW * 2);
constexpr size_t WS_VB   = WS_KB   + al256((size_t)MP * QKVW * 2);
constexpr size_t WS_UB   = WS_VB   + al256((size_t)MP * QKVW * 2);
constexpr size_t WS_GB   = WS_UB   + al256((size_t)MP * PW * 4);
constexpr size_t WS_ATT  = WS_GB   + al256((size_t)MP * 2 * D * 2);
constexpr size_t WS_PL   = WS_ATT  + al256((size_t)MP * GW * 2);
constexpr size_t WS_T    = WS_PL   + al256((size_t)MP * PW * 2);
constexpr size_t WS_MIX  = WS_T    + al256((size_t)MP * D * 2);
constexpr size_t WS_X1B  = WS_MIX  + al256((size_t)MP * D * 2);
constexpr size_t WS_FFB  = WS_X1B  + al256((size_t)MP * D * 2);
constexpr size_t WS_DUMP = WS_FFB  + al256((size_t)MP * FF * 2);
constexpr size_t WS_END  = WS_DUMP + 2 * MiB;
constexpr int CW_BAR = 4096;
constexpr int CW_RSS = 16384;
static_assert((CW_RSS + MP) * 4 <= (int)CTL_ZERO_BYTES && CW_BAR + 3456 <= CW_RSS, "CTL map");

constexpr int RING_OFF = 0, RING_BYTES = 131072;
constexpr int LDSCTL_OFF = RING_BYTES, MISC_OFF = LDSCTL_OFF + 320;
constexpr int LDS_BYTES = 147456;
static_assert(MISC_OFF + 128 <= LDS_BYTES, "LDS map");

#define GAS __attribute__((address_space(1)))
#define LAS __attribute__((address_space(3)))
typedef unsigned short bf16;
typedef unsigned v4u __attribute__((ext_vector_type(4)));
typedef unsigned v2u __attribute__((ext_vector_type(2)));
typedef float f32x4 __attribute__((ext_vector_type(4)));
typedef GAS unsigned gu32;
#define RLX_AGENT __ATOMIC_RELAXED, __HIP_MEMORY_SCOPE_AGENT
#define LDS_WAIT() asm volatile("s_waitcnt lgkmcnt(0)" ::: "memory")
#define VM_WAIT() asm volatile("s_waitcnt vmcnt(0)" ::: "memory")
__device__ __forceinline__ unsigned f2bf(float f) { unsigned u = __builtin_bit_cast(unsigned, f); return (u + 0x7fffu + ((u >> 16) & 1u)) >> 16; }
__device__ __forceinline__ unsigned pk2(float lo, float hi) { return f2bf(lo) | (f2bf(hi) << 16); }
__device__ __forceinline__ float bflo(unsigned w) { return __uint_as_float(w << 16); }
__device__ __forceinline__ float bfhi(unsigned w) { return __uint_as_float(w & 0xffff0000u); }

#define XB_TMO      128
#define XB_XCNT(j)  (256  + 64 * (j))
#define XB_XSUB(j)  (1280 + 64 * (j))
#define XB_XGEN(j)  (2304 + 64 * (j))
#define XB_TOP      3328
#define XB_TOPGEN   3392
#define XCD_BAR_WORDS 3456
#define XB_SPIN_CAP (1u << 18)

__device__ __forceinline__ unsigned xb_ld(unsigned* p)              { return __hip_atomic_load(p, __ATOMIC_RELAXED, __HIP_MEMORY_SCOPE_AGENT); }
__device__ __forceinline__ unsigned xb_add(unsigned* p, unsigned v) { return __hip_atomic_fetch_add(p, v, __ATOMIC_RELAXED, __HIP_MEMORY_SCOPE_AGENT); }
__device__ __forceinline__ unsigned xb_xcc_id() { return (unsigned)__builtin_amdgcn_s_getreg((3 << 11) | 20) & 0xFu; }
#define XB_SPIN(cond, bar) do { unsigned _sp = 0; while (cond) { __builtin_amdgcn_s_sleep(1); \
    if ((++_sp & 255u) == 0u) { if (xb_ld(&(bar)[XB_TMO])) break; if (_sp > XB_SPIN_CAP) { atomicAdd(&(bar)[XB_TMO], 1u); break; } } } } while (0)

struct XcdBarrier {
    unsigned* bar; unsigned x;
    volatile LAS unsigned* st;
};

__device__ __forceinline__ XcdBarrier xcd_barrier_post(unsigned* bar, volatile LAS unsigned* st) {
    XcdBarrier b; b.bar = bar; b.x = xb_xcc_id(); b.st = st;
    if (threadIdx.x == 0) (void)xb_add(&bar[XB_XCNT(b.x)], 1u);
    return b;
}
__device__ __forceinline__ void xcd_barrier_complete(unsigned* bar, unsigned x, unsigned& nloc, unsigned& nx) {
    const unsigned G = gridDim.x * gridDim.y * gridDim.z;
    unsigned sum, cnt, mine, sp = 0u;
    for (;;) {
        sum = 0u; cnt = 0u; mine = 0u;
#pragma unroll
        for (unsigned j = 0; j < 16; ++j) { const unsigned c = xb_ld(&bar[XB_XCNT(j)]); sum += c; cnt += (c > 0u) ? 1u : 0u; mine = (j == x) ? c : mine; }
        if (sum == G) break;
        __builtin_amdgcn_s_sleep(1);
        if ((++sp & 255u) == 0u) { if (xb_ld(&bar[XB_TMO])) break; if (sp > XB_SPIN_CAP) { atomicAdd(&bar[XB_TMO], 1u); break; } }
    }
    nloc = mine > 0u ? mine : 1u; nx = cnt > 0u ? cnt : 1u;
}

__device__ __forceinline__ void xcd_barrier(const XcdBarrier& b) {
    asm volatile("s_waitcnt vmcnt(0)" ::: "memory");
    __syncthreads();
    if (threadIdx.x == 0) {
        unsigned* bar = b.bar;
        __builtin_amdgcn_s_waitcnt(0);
        unsigned nloc = b.st[0], nx = b.st[1];
        if (nloc == 0u) { xcd_barrier_complete(bar, b.x, nloc, nx); b.st[0] = nloc; b.st[1] = nx; }
        const unsigned old = xb_add(&bar[XB_XSUB(b.x)], 1u);
        const unsigned gen = old / nloc;
        if (old + 1u == (gen + 1u) * nloc) {
            __builtin_amdgcn_fence(__ATOMIC_RELEASE, "agent");
            asm volatile("s_waitcnt vmcnt(0)" ::: "memory");
            const unsigned og = xb_add(&bar[XB_TOP], 1u);
            const unsigned tg = og / nx;
            if (og + 1u == (tg + 1u) * nx) xb_add(&bar[XB_TOPGEN], 1u);
            else XB_SPIN(xb_ld(&bar[XB_TOPGEN]) == tg, bar);
            __builtin_amdgcn_fence(__ATOMIC_ACQUIRE, "agent");
            xb_add(&bar[XB_XGEN(b.x)], 1u);
            asm volatile("s_waitcnt vmcnt(0)" ::: "memory");
        } else {
            XB_SPIN(xb_ld(&bar[XB_XGEN(b.x)]) == gen, bar);
            __builtin_amdgcn_fence(__ATOMIC_ACQUIRE, "agent");
            asm volatile("s_waitcnt vmcnt(0)" ::: "memory");
        }
    }
    __syncthreads();
}


struct Frame {
    LAS unsigned char* lds;
    volatile LAS unsigned* MISC;
    gu32* ctl;
    int tid, lane, wave;
    int vcu, G;
    const float *p_XP, *p_XS, *p_CK0, *p_CV0, *p_CK1, *p_CV1, *p_CK2, *p_CV2, *p_SP, *p_NMIX, *p_WIN, *p_WUP, *p_WPOOL, *p_PSCALE, *p_WOUT, *p_NFFN, *p_WG, *p_WU, *p_WD, *p_NFIN;
    float* out; unsigned char* ws;
};
enum { I_XP = 0, I_XS, I_CK0, I_CV0, I_CK1, I_CV1, I_CK2, I_CV2, I_SP, I_NMIX, I_WIN, I_WUP, I_WPOOL, I_PSCALE, I_WOUT, I_NFFN, I_WG, I_WU, I_WD, I_NFIN };

__device__ __forceinline__ float wave_sum(float v) {
#pragma unroll
    for (int o = 1; o < 64; o <<= 1) v += __shfl_xor(v, o);
    return v;
}
__device__ __forceinline__ float wave_max(float v) {
#pragma unroll
    for (int o = 1; o < 64; o <<= 1) v = fmaxf(v, __shfl_xor(v, o));
    return v;
}
template <bool PERM>
__device__ __forceinline__ void p0_transpose_item(const float* W, int K, int N, bf16* WT, int k0, int n0, int out_row0, const float* kscale, LAS float* scr, int lane) {
    float wv[32];
#pragma unroll
    for (int i = 0; i < 32; ++i) wv[i] = W[(size_t)(k0 + 2 * i + (lane >> 5)) * N + n0 + (lane & 31)];
    if (kscale) {
#pragma unroll
        for (int i = 0; i < 32; ++i) wv[i] *= kscale[k0 + 2 * i + (lane >> 5)]; }
#pragma unroll
    for (int i = 0; i < 32; ++i) scr[(2 * i + (lane >> 5)) * 33 + (lane & 31)] = wv[i];
    LDS_WAIT(); asm volatile("" ::: "memory");
    const int c = lane & 7;
#pragma unroll
    for (int j = 0; j < 4; ++j) { const int n = (lane >> 3) + 8 * j; const LAS float* s = scr + (8 * c) * 33 + n;
        v4u o; o.x = pk2(s[0 * 33], s[1 * 33]); o.y = pk2(s[2 * 33], s[3 * 33]); o.z = pk2(s[4 * 33], s[5 * 33]); o.w = pk2(s[6 * 33], s[7 * 33]);
        *(GAS v4u*)((GAS char*)WT + pg8::bl_off<PERM>(out_row0 + n, k0 + 8 * c, K >> 6)) = o; }
    LDS_WAIT(); asm volatile("" ::: "memory");
}
__device__ __forceinline__ void rms_row_to_bf16(const float* xrow, const float* gain, bf16* orow, int lane) {
    const GAS f32x4* xr = (const GAS f32x4*)xrow + lane; const GAS f32x4* gr = (const GAS f32x4*)gain + lane;
    f32x4 v[16]; float s = 0.f;
#pragma unroll
    for (int j = 0; j < 16; ++j) { v[j] = xr[64 * j]; s += (v[j].x * v[j].x + v[j].y * v[j].y) + (v[j].z * v[j].z + v[j].w * v[j].w); }
    const float rstd = 1.0f / sqrtf(wave_sum(s) * (1.0f / D) + RMS_EPS);
    GAS v2u* o8 = (GAS v2u*)orow + lane;
#pragma unroll
    for (int j = 0; j < 16; ++j) { const f32x4 g = gr[64 * j]; v2u w; w.x = pk2(v[j].x * rstd * g.x, v[j].y * rstd * g.y); w.y = pk2(v[j].z * rstd * g.z, v[j].w * rstd * g.w); o8[64 * j] = w; }
}
__device__ __forceinline__ void p0_cache_copy(const float* src, float* dst, int W, int gt, int NT) {
    const int per = (W - 1) * 256; const int total = NSMP * per;
    const GAS f32x4* s4 = (const GAS f32x4*)src; GAS f32x4* d4 = (GAS f32x4*)dst;
    for (int i0 = gt; i0 < total; i0 += 4 * NT) {
        f32x4 v[4]; int di[4];
#pragma unroll
        for (int k = 0; k < 4; ++k) { const int i = i0 + k * NT; const int n = i / per, rem = i - n * per; di[k] = n * W * 256 + rem; if (i < total) v[k] = s4[(size_t)di[k] + 256]; }
#pragma unroll
        for (int k = 0; k < 4; ++k) { const int i = i0 + k * NT; if (i < total) d4[(size_t)di[k]] = v[k]; }
    }
}
__device__ __forceinline__ void p0_prologue(Frame& F) {
    LAS float* scr = (LAS float*)(F.lds + RING_OFF + F.wave * 16384);
    const int gw = F.vcu * NWAVES + F.wave, NGW = F.G * NWAVES;
    bf16* WIN = (bf16*)(F.ws + WS_WIN); bf16* WUP = (bf16*)(F.ws + WS_WUP); bf16* WPL = (bf16*)(F.ws + WS_WPL); bf16* WOUT = (bf16*)(F.ws + WS_WOUT); bf16* WGU = (bf16*)(F.ws + WS_WGU); bf16* WDN = (bf16*)(F.ws + WS_WDN);
    constexpr int IT_IN = (D / 64) * (INW / 32), IT_UP = (GW / 64) * (D / 32), IT_PL1 = (512 / 64) * (GW / 32), IT_PL = 4 * IT_PL1, IT_OUT = (D / 64) * (D / 32), IT_G = (D / 64) * (FF / 32), IT_DN = (FF / 64) * (D / 32);
    constexpr int NITEMS = IT_IN + IT_UP + IT_PL + IT_OUT + IT_DN;
    for (int it = gw; it < NITEMS; it += NGW) {
        int r = it;
        if (r < IT_IN) { const int nb = r % (INW / 32), kb = r / (INW / 32); p0_transpose_item<true>(F.p_WIN, D, INW, WIN, 64 * kb, 32 * nb, 32 * nb, nullptr, scr, F.lane); continue; } r -= IT_IN;
        if (r < IT_UP) { const int nb = r % (D / 32), kb = r / (D / 32); p0_transpose_item<true>(F.p_WUP, GW, D, WUP, 64 * kb, 32 * nb, 32 * nb, nullptr, scr, F.lane); continue; } r -= IT_UP;
        if (r < IT_PL) { const int g = r / IT_PL1, q = r % IT_PL1, nb = q % (GW / 32), kb = q / (GW / 32);
            p0_transpose_item<true>(F.p_WPOOL + (size_t)g * 512 * GW, 512, GW, WPL, 64 * kb, 32 * nb, g * GW + 32 * nb, nullptr, scr, F.lane); continue; } r -= IT_PL;
        if (r < IT_OUT) { const int nb = r % (D / 32), kb = r / (D / 32); p0_transpose_item<false>(F.p_WOUT, D, D, WOUT, 64 * kb, 32 * nb, 32 * nb, nullptr, scr, F.lane); continue; } r -= IT_OUT;
        { const int nb = r % (D / 32), kb = r / (D / 32); p0_transpose_item<false>(F.p_WD, FF, D, WDN, 64 * kb, 32 * nb, 32 * nb, nullptr, scr, F.lane); }
    }
    bf16* HN = (bf16*)(F.ws + WS_HN);
    for (int m = gw; m < MP; m += NGW) {
        if (m < MPR) rms_row_to_bf16(F.p_XP + (size_t)m * D, F.p_NMIX, HN + (size_t)m * D, F.lane);
        else if (m < MREAL) rms_row_to_bf16(F.p_XS + (size_t)(m - MPR) * D, F.p_NMIX, HN + (size_t)m * D, F.lane);
        else { GAS v4u* o = (GAS v4u*)(HN + (size_t)m * D) + F.lane;
#pragma unroll
            for (int j = 0; j < 8; ++j) o[64 * j] = (v4u){0u, 0u, 0u, 0u}; }
    }
    const int gt = F.vcu * (NWAVES * 64) + F.tid, NT = F.G * NWAVES * 64;
    { float* rs = (float*)(F.ws + WS_CTL) + CW_RSS; for (int i = gt; i < MP; i += NT) rs[i] = 0.f; }
    { const GAS f32x4* s4 = (const GAS f32x4*)F.p_SP; GAS f32x4* d4 = (GAS f32x4*)(F.out + O_PS); constexpr int per = (PHIST - 1) * (PW / 4), tot = NSMP * per;
      for (int i = gt; i < tot; i += NT) { const int n = i / per, rem = i - n * per; d4[(size_t)n * PHIST * (PW / 4) + rem] = s4[(size_t)n * PHIST * (PW / 4) + (PW / 4) + rem]; } }
}

__device__ __forceinline__ void p2_convert_wgu(Frame& F, LAS float* scr, int gwave, int ngw) {
    bf16* WGU = (bf16*)(F.ws + WS_WGU); constexpr int IT_G = (D / 64) * (FF / 32);
    for (int r = gwave; r < 2 * IT_G; r += ngw) { const int up = r >= IT_G ? 1 : 0, q = r - up * IT_G, nb = q % (FF / 32), kb = q / (FF / 32), n0 = 32 * nb;
        if (up) p0_transpose_item<true>(F.p_WU, D, FF, WGU, 64 * kb, n0, (n0 >> 7) * 256 + (n0 & 127) + 128, F.p_NFFN, scr, F.lane);
        else    p0_transpose_item<true>(F.p_WG, D, FF, WGU, 64 * kb, n0, (n0 >> 7) * 256 + (n0 & 127), F.p_NFFN, scr, F.lane); }
}
__device__ __forceinline__ float alibi_slope_log2e(int g, int h) { return exp2f(-8.0f * (float)(g * 8 + h + 1) / 24.0f) * 1.4426950408889634f; }
__device__ __forceinline__ float dot8(v4u a, v4u b) {
    return (bflo(a.x) * bflo(b.x) + bfhi(a.x) * bfhi(b.x)) + (bflo(a.y) * bflo(b.y) + bfhi(a.y) * bfhi(b.y)) + (bflo(a.z) * bflo(b.z) + bfhi(a.z) * bfhi(b.z)) + (bflo(a.w) * bflo(b.w) + bfhi(a.w) * bfhi(b.w));
}
__device__ __forceinline__ void attn_naive_prompt(const bf16* QB, const bf16* KB, const bf16* VB, bf16* ATT, int m, int j, LAS float* pl, int lane) {
    const int t = m & (SEQ - 1);
    float Mx = -INFINITY, den = 0.f, a0 = 0.f, a1 = 0.f;
#pragma unroll 1
    for (int g = 0; g < 3; ++g) {
        const int d = g == 0 ? 1 : (g == 1 ? 4 : 16); const int tq = t / d; const int nk = (tq < 128 ? tq : 128) + 1;
        const float sl = alibi_slope_log2e(g, j) * (float)d;
        const size_t hoff = (size_t)g * GW + j * HD;
        const GAS v4u* qp = (const GAS v4u*)(QB + (size_t)m * QKVW + hoff);
        float s[3];
#pragma unroll
        for (int i = 0; i < 3; ++i) { const int jj = lane + 64 * i; s[i] = -INFINITY;
            if (jj < nk) { const GAS v4u* kp = (const GAS v4u*)(KB + (size_t)(m - d * jj) * QKVW + hoff); float acc = 0.f;
#pragma unroll
                for (int c = 0; c < 16; ++c) acc += dot8(qp[c], kp[c]);
                s[i] = acc - sl * (float)jj; } }
        const float mg = wave_max(fmaxf(fmaxf(s[0], s[1]), s[2])); const float nM = fmaxf(Mx, mg); const float so = __builtin_amdgcn_exp2f(Mx - nM);
        float ps = 0.f;
#pragma unroll
        for (int i = 0; i < 3; ++i) { const int jj = lane + 64 * i; const float p = (jj < nk) ? __builtin_amdgcn_exp2f(s[i] - nM) : 0.f; ps += p; if (jj < 129) pl[jj] = p; }
        den = den * so + wave_sum(ps); a0 *= so; a1 *= so; Mx = nM;
        LDS_WAIT(); asm volatile("" ::: "memory");
        const GAS unsigned* vp = (const GAS unsigned*)(VB + (size_t)m * QKVW + hoff) + lane;
        for (int jj = 0; jj < nk; ++jj) { const float p = pl[jj]; const unsigned w = vp[-(long)(d * jj) * (QKVW / 2)]; a0 += p * bflo(w); a1 += p * bfhi(w); }
        LDS_WAIT(); asm volatile("" ::: "memory");
    }
    const float inv = 1.0f / den;
    ((GAS unsigned*)(ATT + (size_t)m * GW + j * HD))[lane] = pk2(a0 * inv, a1 * inv);
}
typedef float f32x16 __attribute__((ext_vector_type(16)));
typedef short bf16x8_t __attribute__((ext_vector_type(8)));
typedef short s16x4_t __attribute__((ext_vector_type(4)));
constexpr int VPITCH = 272;
__device__ __forceinline__ int crow16(int i, int h) { return (i & 3) + 8 * (i >> 2) + 4 * h; }
__device__ __forceinline__ unsigned cvtpk(float lo, float hi) { typedef float f2 __attribute__((ext_vector_type(2))); typedef __bf16 b2 __attribute__((ext_vector_type(2))); const f2 v = {lo, hi}; const b2 b = __builtin_convertvector(v, b2); return __builtin_bit_cast(unsigned, b); }
__device__ __forceinline__ s16x4_t vtr(LAS const unsigned char* p) { typedef short v4i16_t __attribute__((ext_vector_type(4))); return __builtin_bit_cast(s16x4_t, __builtin_amdgcn_ds_read_tr16_b64_v4i16((LAS v4i16_t*)p)); }
__device__ __forceinline__ void attn_mfma_tile(const bf16* QB, const bf16* KB, const bf16* VB, bf16* NUM, float* ML, int item, LAS unsigned char* vlds, int lane) {
    const int blk = ((item & 63) + 21 * (item >> 11)) & 63, h = (item >> 6) & 7, bg = item >> 9, g = bg % 3, b = bg / 3;
    const int ds = 2 * g, d = 1 << ds, nbs = 6 - ds, r = blk >> nbs, ib = blk & ((1 << nbs) - 1), i0 = 32 * ib;
    const int r32 = lane & 31, hh = lane >> 5;
    const size_t colbase = (size_t)g * GW + h * HD;
    const int rowb = b * SEQ + r;
    const float sl = alibi_slope_log2e(g, h) * (float)d;
    const int rq = r32 - 4 * hh; const float slrq = sl * (float)rq;
    bf16x8_t qf[8];
    { const bf16* qrow = QB + (size_t)(rowb + d * (i0 + r32)) * QKVW + colbase + 8 * hh;
#pragma unroll
      for (int s_ = 0; s_ < 8; ++s_) qf[s_] = *(const GAS bf16x8_t*)(qrow + 16 * s_); }
    f32x16 S[5];
#pragma unroll
    for (int kb = 0; kb < 5; ++kb) {
        if (ib + kb >= 4) {
            const int kk0 = 32 * (ib + kb - 4);
            const bf16* krow = KB + (size_t)(rowb + d * (kk0 + r32)) * QKVW + colbase + 8 * hh;
            f32x16 acc;
#pragma unroll
            for (int i = 0; i < 16; ++i) acc[i] = 0.f;
#pragma unroll
            for (int s_ = 0; s_ < 8; ++s_) { const bf16x8_t kf = *(const GAS bf16x8_t*)(krow + 16 * s_); acc = __builtin_amdgcn_mfma_f32_32x32x16_bf16(kf, qf[s_], acc, 0, 0, 0); }
#pragma unroll
            for (int i = 0; i < 16; ++i) { const int ci = (i & 3) + 8 * (i >> 2);
                float v = fmaf(-sl, (float)(32 * (4 - kb) - ci), acc[i]) - slrq;
                if (kb == 0 && rq > ci) v = -INFINITY;
                if (kb == 4 && rq < ci) v = -INFINITY;
                acc[i] = v; }
            S[kb] = acc;
        } else {
#pragma unroll
            for (int i = 0; i < 16; ++i) S[kb][i] = -INFINITY;
        }
    }
    float mx = -INFINITY;
#pragma unroll
    for (int kb = 0; kb < 5; ++kb)
#pragma unroll
        for (int i = 0; i < 16; ++i) mx = fmaxf(mx, S[kb][i]);
    mx = fmaxf(mx, __shfl_xor(mx, 32));
    float den = 0.f;
#pragma unroll
    for (int kb = 0; kb < 5; ++kb)
#pragma unroll
        for (int i = 0; i < 16; ++i) { const float p = __builtin_amdgcn_exp2f(S[kb][i] - mx); S[kb][i] = p; den += p; }
    den += __shfl_xor(den, 32);
    f32x16 y[4];
#pragma unroll
    for (int c = 0; c < 4; ++c)
#pragma unroll
        for (int i = 0; i < 16; ++i) y[c][i] = 0.f;
    const int q4 = (lane & 15) >> 2, p4 = lane & 3, bk = (lane >> 4) & 1;
    LAS const unsigned char* vrd = vlds + (4 * hh + q4) * VPITCH + 32 * bk + 8 * p4;
#pragma unroll
    for (int kb = 0; kb < 5; ++kb) {
        if (ib + kb >= 4) {
            const int kk0 = 32 * (ib + kb - 4);
#pragma unroll
            for (int k = 0; k < 8; ++k) { const int id = lane + 64 * k, key = id >> 4, ch = id & 15;
                const v4u v = *(const GAS v4u*)(VB + (size_t)(rowb + d * (kk0 + key)) * QKVW + colbase + 8 * ch);
                *(LAS v4u*)(vlds + key * VPITCH + ch * 16) = v; }
#pragma unroll
            for (int s_ = 0; s_ < 2; ++s_) {
                v4u pk; pk.x = cvtpk(S[kb][8 * s_ + 0], S[kb][8 * s_ + 1]); pk.y = cvtpk(S[kb][8 * s_ + 2], S[kb][8 * s_ + 3]); pk.z = cvtpk(S[kb][8 * s_ + 4], S[kb][8 * s_ + 5]); pk.w = cvtpk(S[kb][8 * s_ + 6], S[kb][8 * s_ + 7]);
                const bf16x8_t xs = __builtin_bit_cast(bf16x8_t, pk);
#pragma unroll
                for (int c = 0; c < 4; ++c) { const s16x4_t lo = vtr(vrd + (16 * s_) * VPITCH + 64 * c), hi = vtr(vrd + (16 * s_ + 8) * VPITCH + 64 * c);
                    const bf16x8_t vf = __builtin_shufflevector(lo, hi, 0, 1, 2, 3, 4, 5, 6, 7);
                    y[c] = __builtin_amdgcn_mfma_f32_32x32x16_bf16(vf, xs, y[c], 0, 0, 0); }
            }
        }
    }
    const int m = rowb + d * (i0 + r32);
    bf16* np = NUM + ((size_t)g * MREAL + m) * GW + h * HD + 4 * hh;
#pragma unroll
    for (int c = 0; c < 4; ++c)
#pragma unroll
        for (int k = 0; k < 4; ++k) { v2u w; w.x = cvtpk(y[c][4 * k + 0], y[c][4 * k + 1]); w.y = cvtpk(y[c][4 * k + 2], y[c][4 * k + 3]); *(GAS v2u*)(np + 32 * c + 8 * k) = w; }
    if (hh == 0) { typedef float f2 __attribute__((ext_vector_type(2))); *(GAS f2*)(ML + (((size_t)g * MREAL + m) * NH + h) * 2) = (f2){mx, den}; }
}
__device__ __forceinline__ void attn_combine(const bf16* NUM, const float* ML, bf16* ATT, int gt, int NT) {
    typedef float f2 __attribute__((ext_vector_type(2)));
    for (int i = gt; i < MREAL * (GW / 8); i += NT) {
        const int m = i >> 7, c8 = i & 127, h = c8 >> 4;
        f2 st[3]; float M = -INFINITY;
#pragma unroll
        for (int g = 0; g < 3; ++g) { st[g] = *(const GAS f2*)(ML + (((size_t)g * MREAL + m) * NH + h) * 2); M = fmaxf(M, st[g].x); }
        float o[8] = {0.f, 0.f, 0.f, 0.f, 0.f, 0.f, 0.f, 0.f}; float dn = 0.f;
#pragma unroll
        for (int g = 0; g < 3; ++g) { const float e = __builtin_amdgcn_exp2f(st[g].x - M); dn += e * st[g].y;
            const v4u w = *(const GAS v4u*)(NUM + ((size_t)g * MREAL + m) * GW + 8 * c8);
            o[0] += e * bflo(w.x); o[1] += e * bfhi(w.x); o[2] += e * bflo(w.y); o[3] += e * bfhi(w.y); o[4] += e * bflo(w.z); o[5] += e * bfhi(w.z); o[6] += e * bflo(w.w); o[7] += e * bfhi(w.w); }
        const float inv = 1.0f / dn; v4u r; r.x = cvtpk(o[0] * inv, o[1] * inv); r.y = cvtpk(o[2] * inv, o[3] * inv); r.z = cvtpk(o[4] * inv, o[5] * inv); r.w = cvtpk(o[6] * inv, o[7] * inv);
        *(GAS v4u*)(ATT + (size_t)m * GW + 8 * c8) = r;
    }
}
template <int G_>
__device__ __forceinline__ void attn_sample_partial(const float* ck, const float* cv, const float* out, const bf16* QB, bf16* NUM, float* ML, int n, int j, LAS float* pl, int lane) {
    constexpr int d = G_ == 0 ? 1 : (G_ == 1 ? 4 : 16), W = G_ == 0 ? 128 : (G_ == 1 ? 512 : 2048);
    constexpr size_t OK_ = G_ == 0 ? O_KS0 : (G_ == 1 ? O_KS1 : O_KS2), OV_ = G_ == 0 ? O_VS0 : (G_ == 1 ? O_VS1 : O_VS2);
    const int m = MPR + n, g4 = lane >> 4, i16 = lane & 15;
    const float* nk_ = out + OK_ + ((size_t)n * W + (W - 1)) * GW + j * HD; const float* nv_ = out + OV_ + ((size_t)n * W + (W - 1)) * GW + j * HD;
    const float* kb = ck + (size_t)n * W * GW + j * HD; const float* vb = cv + (size_t)n * W * GW + j * HD;
    const float sl = alibi_slope_log2e(G_, j) * (float)d;
    float q[8];
    { const v4u w = *(const GAS v4u*)(QB + (size_t)m * QKVW + (size_t)G_ * GW + j * HD + 8 * i16);
      q[0] = bflo(w.x); q[1] = bfhi(w.x); q[2] = bflo(w.y); q[3] = bfhi(w.y); q[4] = bflo(w.z); q[5] = bfhi(w.z); q[6] = bflo(w.w); q[7] = bfhi(w.w); }
    float sc[3] = {-INFINITY, -INFINITY, -INFINITY};
#pragma unroll
    for (int c0 = 0; c0 < 33; c0 += 11) {
        f32x4 ka[11], kc[11];
#pragma unroll
        for (int u = 0; u < 11; ++u) { const int jj = 4 * (c0 + u) + g4; const int jc = jj <= 128 ? jj : 128;
            const float* kp = (jc == 0 ? nk_ : kb + (size_t)(W - d * jc) * GW) + 8 * i16; ka[u] = *(const GAS f32x4*)kp; kc[u] = *(const GAS f32x4*)(kp + 4); }
#pragma unroll
        for (int u = 0; u < 11; ++u) { const int c = c0 + u, jj = 4 * c + g4;
            float sdot = (ka[u].x * q[0] + ka[u].y * q[1]) + (ka[u].z * q[2] + ka[u].w * q[3]) + (kc[u].x * q[4] + kc[u].y * q[5]) + (kc[u].z * q[6] + kc[u].w * q[7]);
            sdot += __shfl_xor(sdot, 1); sdot += __shfl_xor(sdot, 2); sdot += __shfl_xor(sdot, 4); sdot += __shfl_xor(sdot, 8);
            const float sv = jj <= 128 ? sdot - sl * (float)jj : -INFINITY;
            if ((c & 15) == i16) sc[c >> 4] = sv; }
    }
    const float mx = wave_max(fmaxf(fmaxf(sc[0], sc[1]), sc[2]));
    float ps = 0.f;
#pragma unroll
    for (int k = 0; k < 3; ++k) { const int jj = 4 * (i16 + 16 * k) + g4; const float p = __builtin_amdgcn_exp2f(sc[k] - mx); ps += p; if (jj <= 128) pl[jj] = p; }
    const float den = wave_sum(ps);
    LDS_WAIT(); asm volatile("" ::: "memory");
    typedef float f32x2g __attribute__((ext_vector_type(2)));
    float a0 = 0.f, a1 = 0.f;
#pragma unroll 1
    for (int j0 = 0; j0 < 128; j0 += 16) { f32x2g vv[16];
#pragma unroll
        for (int u = 0; u < 16; ++u) { const int jj = j0 + u; const float* vp = jj == 0 ? nv_ : vb + (size_t)(W - d * jj) * GW; vv[u] = ((const GAS f32x2g*)vp)[lane]; }
#pragma unroll
        for (int u = 0; u < 16; ++u) { const float p = pl[j0 + u]; a0 += p * vv[u].x; a1 += p * vv[u].y; } }
    { const f32x2g v128 = ((const GAS f32x2g*)vb)[lane]; const float p = pl[128]; a0 += p * v128.x; a1 += p * v128.y; }
    LDS_WAIT(); asm volatile("" ::: "memory");
    ((GAS unsigned*)(NUM + ((size_t)G_ * MREAL + m) * GW + j * HD))[lane] = cvtpk(a0, a1);
    if (lane == 0) { *(GAS f32x2g*)(ML + (((size_t)G_ * MREAL + m) * NH + j) * 2) = (f32x2g){mx, den}; }
}
template <int WN>
__device__ __forceinline__ void pool_task(const float* UB, const float* sp, bf16* PL, int m, int c) {
    const f32x4 u0 = *(const GAS f32x4*)(UB + (size_t)m * PW + c); f32x4 r[WN - 1]; float wgt[WN - 1]; float cnt;
    if (m < MPR) { const int t = m & (SEQ - 1); cnt = (float)((t < WN - 1 ? t : WN - 1) + 1);
#pragma unroll
        for (int q = 1; q < WN; ++q) { const int qq = q <= t ? q : t; wgt[q - 1] = q <= t ? 1.f : 0.f; r[q - 1] = *(const GAS f32x4*)(UB + (size_t)(m - qq) * PW + c); } }
    else { const int n = m - MPR; cnt = (float)WN;
#pragma unroll
        for (int q = 1; q < WN; ++q) { wgt[q - 1] = 1.f; r[q - 1] = *(const GAS f32x4*)(sp + ((size_t)n * PHIST + (PHIST - q)) * PW + c); } }
    f32x4 tot = u0;
#pragma unroll
    for (int q = 1; q < WN; ++q) tot = tot + r[q - 1] * wgt[q - 1];
    const float ic = 1.0f / cnt; v2u o; o.x = pk2(tot.x * ic - u0.x, tot.y * ic - u0.y); o.y = pk2(tot.z * ic - u0.z, tot.w * ic - u0.w);
    *(GAS v2u*)(PL + (size_t)m * PW + c) = o;
}
template <int WN>
__device__ __forceinline__ void pool_chunk(const float* UB, bf16* PL, int b, int t0, int c) {
    const float* ub = UB + (size_t)b * SEQ * PW + c; bf16* pb = PL + (size_t)b * SEQ * PW + c;
    f32x4 ring[WN]; f32x4 tot = (f32x4){0.f, 0.f, 0.f, 0.f};
    if (t0 != 0) {
#pragma unroll
        for (int j = 0; j < WN; ++j) ring[j] = *(const GAS f32x4*)(ub + (size_t)(t0 - WN + j) * PW);
#pragma unroll
        for (int j = 0; j < WN; ++j) tot = tot + ring[j];
    } else {
#pragma unroll
        for (int j = 0; j < WN; ++j) ring[j] = (f32x4){0.f, 0.f, 0.f, 0.f};
    }
#pragma unroll
    for (int s0 = 0; s0 < 32; s0 += 16) {
        f32x4 nw[16];
#pragma unroll
        for (int u = 0; u < 16; ++u) nw[u] = *(const GAS f32x4*)(ub + (size_t)(t0 + s0 + u) * PW);
#pragma unroll
        for (int u = 0; u < 16; ++u) { const int s_ = s0 + u, t = t0 + s_; const f32x4 x = nw[u];
            tot = tot + (x - ring[s_ % WN]); ring[s_ % WN] = x;
            const int cn = t + 1 < WN ? t + 1 : WN; const float ic = 1.0f / (float)cn;
            v2u o; o.x = pk2(tot.x * ic - x.x, tot.y * ic - x.y); o.y = pk2(tot.z * ic - x.z, tot.w * ic - x.w);
            *(GAS v2u*)(pb + (size_t)t * PW) = o; }
    }
}
__device__ __forceinline__ void pool_naive(const Frame& F, const float* UB, bf16* PL, int gt, int NT) {
    constexpr int C4 = PW / 4, NCH = SEQ / 32;
    for (int i = gt; i < NB * NCH * C4; i += NT) {
        const int c4 = i % C4, rc = (i / C4) % NCH, b = i / (C4 * NCH), c = 4 * c4; const int grp = __builtin_amdgcn_readfirstlane(c >> 9);
        if (grp == 0) pool_chunk<2>(UB, PL, b, 32 * rc, c); else if (grp == 1) pool_chunk<4>(UB, PL, b, 32 * rc, c); else if (grp == 2) pool_chunk<8>(UB, PL, b, 32 * rc, c); else pool_chunk<16>(UB, PL, b, 32 * rc, c);
    }
    for (int i = gt; i < NSMP * C4; i += NT) {
        const int n = i / C4, c = 4 * (i - n * C4); const int grp = __builtin_amdgcn_readfirstlane(c >> 9);
        if (grp == 0) pool_task<2>(UB, F.p_SP, PL, MPR + n, c); else if (grp == 1) pool_task<4>(UB, F.p_SP, PL, MPR + n, c); else if (grp == 2) pool_task<8>(UB, F.p_SP, PL, MPR + n, c); else pool_task<16>(UB, F.p_SP, PL, MPR + n, c);
    }
}
constexpr int SK_RED_PITCH = 33;
template <int NACC, bool PERM>
__device__ __forceinline__ void skinny_partial(const bf16* A, int lda, const bf16* B, int brow0, int K, LAS float* red, int wave, int lane) {
    const int r32 = lane & 31, hh = lane >> 5, ks = K >> 3, nst = ks >> 4, nt = K >> 6; const unsigned ku0 = (unsigned)(__builtin_amdgcn_readfirstlane(wave) * ks);
    const bf16* ap = A + (size_t)r32 * lda + wave * ks + 8 * hh;
    const GAS char* bb = (const GAS char*)B;
    const unsigned rb0 = (unsigned)pg8::bl_off<PERM>(brow0 + r32, 0, nt), x5 = rb0 & 32u, rbase = (rb0 ^ x5) + 16u * (unsigned)hh;
    const unsigned loE = rbase + (x5 ^ ((ku0 & 16u) << 1)), loO = loE ^ 32u;
    f32x16 acc0, acc1;
#pragma unroll
    for (int i = 0; i < 16; ++i) { acc0[i] = 0.f; acc1[i] = 0.f; }
#pragma unroll 16
    for (int s_ = 0; s_ < nst; ++s_) {
        const bf16x8_t af = *(const GAS bf16x8_t*)(ap + 16 * s_);
        const unsigned ku = ku0 + 16u * (unsigned)s_; const GAS char* sb = bb + (size_t)((ku >> 6) * 32768u + ((ku >> 5) & 1u) * 1024u); const unsigned bo = (s_ & 1) ? loO : loE;
        const bf16x8_t bf0 = *(const GAS bf16x8_t*)(sb + bo);
        acc0 = __builtin_amdgcn_mfma_f32_32x32x16_bf16(af, bf0, acc0, 0, 0, 0);
        if (NACC == 2) { const bf16x8_t bf1 = *(const GAS bf16x8_t*)(sb + bo + 16384); acc1 = __builtin_amdgcn_mfma_f32_32x32x16_bf16(af, bf1, acc1, 0, 0, 0); }
    }
    LAS float* rw = red + wave * (NACC * 32 * SK_RED_PITCH);
#pragma unroll
    for (int i = 0; i < 16; ++i) { rw[crow16(i, hh) * SK_RED_PITCH + r32] = acc0[i]; if (NACC == 2) rw[(32 + crow16(i, hh)) * SK_RED_PITCH + r32] = acc1[i]; }
}
template <int NACC>
__device__ __forceinline__ void skinny_reduce(LAS const float* red, int tid, float (&v)[NACC][2]) {
    const int row = tid >> 4, c = (tid & 15) * 2;
#pragma unroll
    for (int a = 0; a < NACC; ++a) { float s0 = 0.f, s1 = 0.f;
#pragma unroll
        for (int w = 0; w < NWAVES; ++w) { const LAS float* p = red + w * (NACC * 32 * SK_RED_PITCH) + (a * 32 + row) * SK_RED_PITCH + c; s0 += p[0]; s1 += p[1]; }
        v[a][0] = s0; v[a][1] = s1; }
}
__device__ __forceinline__ void skinny_share(int nmain, int G, int c, int& idx, int& share) { const int first = nmain % G; if (first == 0) { idx = c; share = G; } else { idx = c - first; share = G - first; } }

__device__ __forceinline__ void final_norm_row(float* yrow, const float* gain, int lane) {
    GAS f32x4* xr = (GAS f32x4*)yrow + lane; const GAS f32x4* gr = (const GAS f32x4*)gain + lane;
    f32x4 v[16]; float s = 0.f;
#pragma unroll
    for (int j = 0; j < 16; ++j) { v[j] = xr[64 * j]; s += (v[j].x * v[j].x + v[j].y * v[j].y) + (v[j].z * v[j].z + v[j].w * v[j].w); }
    const float rstd = 1.0f / sqrtf(wave_sum(s) * (1.0f / D) + RMS_EPS);
#pragma unroll
    for (int j = 0; j < 16; ++j) { const f32x4 g = gr[64 * j]; xr[64 * j] = v[j] * rstd * g; }
}

typedef float f32x2e __attribute__((ext_vector_type(2)));
__device__ __forceinline__ float sigm(float x) { return __builtin_amdgcn_rcpf(1.0f + __builtin_amdgcn_exp2f(-1.4426950408889634f * x)); }
__device__ __forceinline__ void sk_emit_in(bf16* QB, size_t qkv_stride, bf16* GB, float* UB, float* out, float qscale, int n, int col, float v0, float v1) {
    const size_t m = (size_t)(MPR + n);
    if (col < 3 * QKVW) {
        const int which = col / QKVW, c3 = col - which * QKVW; const float sc = which == 0 ? qscale : 1.0f;
        *(GAS unsigned*)(QB + (size_t)which * qkv_stride + m * QKVW + c3) = cvtpk(v0 * sc, v1 * sc);
        if (which != 0) { const int g = c3 / GW, cg = c3 - g * GW, W = g == 0 ? 128 : (g == 1 ? 512 : 2048);
            float* os = out + (g == 0 ? (which == 1 ? O_KS0 : O_VS0) : g == 1 ? (which == 1 ? O_KS1 : O_VS1) : (which == 1 ? O_KS2 : O_VS2)) + ((size_t)n * W + (W - 1)) * GW + cg;
            *(GAS f32x2e*)os = (f32x2e){v0, v1}; }
    } else if (col < 3 * QKVW + PW) {
        const int c = col - 3 * QKVW; *(GAS f32x2e*)(UB + m * PW + c) = (f32x2e){v0, v1}; *(GAS f32x2e*)(out + O_PS + ((size_t)n * PHIST + (PHIST - 1)) * PW + c) = (f32x2e){v0, v1};
    } else { const int c = col - (3 * QKVW + PW); *(GAS unsigned*)(GB + m * (2 * D) + c) = cvtpk(sigm(v0), sigm(v1)); }
}
__device__ __forceinline__ void sk_emit_pool(const bf16* GB, const float* pscale, bf16* T, int n, int col, float v0, float v1) {
    const size_t m = (size_t)(MPR + n); const unsigned g = *(const GAS unsigned*)(GB + m * (2 * D) + D + col); const f32x2e ps = *(const GAS f32x2e*)(pscale + col);
    *(GAS unsigned*)(T + m * D + col) = cvtpk(v0 * ps.x * bflo(g), v1 * ps.y * bfhi(g));
}
__device__ __forceinline__ void sk_emit_up(const bf16* GB, const bf16* T, bf16* MIX, int n, int col, float v0, float v1) {
    const size_t m = (size_t)(MPR + n); const unsigned g = *(const GAS unsigned*)(GB + m * (2 * D) + col), t = *(const GAS unsigned*)(T + m * D + col);
    *(GAS unsigned*)(MIX + m * D + col) = cvtpk(v0 * bflo(g) + bflo(t), v1 * bfhi(g) + bfhi(t));
}
__device__ __forceinline__ void sk_emit_out(const float* xs, float* y, bf16* X1B, float* rowss, int n, int col, float v0, float v1, int tid) {
    const size_t m = (size_t)(MPR + n); const f32x2e x = *(const GAS f32x2e*)(xs + (size_t)n * D + col); const float o0 = x.x + v0, o1 = x.y + v1;
    *(GAS f32x2e*)(y + m * D + col) = (f32x2e){o0, o1}; *(GAS unsigned*)(X1B + m * D + col) = cvtpk(o0, o1);
    float ss = o0 * o0 + o1 * o1; ss += __shfl_xor(ss, 1); ss += __shfl_xor(ss, 2); ss += __shfl_xor(ss, 4); ss += __shfl_xor(ss, 8);
    if ((tid & 15) == 0) atomicAdd(rowss + m, ss);
}
__device__ __forceinline__ void sk_emit_ff(const float* rowss, bf16* FFB, int n, int f, float g0, float g1, float u0, float u1) {
    const size_t m = (size_t)(MPR + n); const float r = 1.0f / sqrtf(rowss[m] * (1.0f / D) + RMS_EPS); g0 *= r; g1 *= r; u0 *= r; u1 *= r;
    *(GAS unsigned*)(FFB + m * FF + f) = cvtpk(g0 * sigm(g0) * u0, g1 * sigm(g1) * u1);
}
__device__ __forceinline__ void sk_emit_down(float* y, int n, int col, float v0, float v1) {
    GAS f32x2e* p = (GAS f32x2e*)(y + (size_t)(MPR + n) * D + col); const f32x2e b = *p; *p = (f32x2e){b.x + v0, b.y + v1};
}

__device__ __forceinline__ int lane_now() { int l; asm volatile("v_mbcnt_lo_u32_b32 %0, -1, 0\n\tv_mbcnt_hi_u32_b32 %0, -1, %0" : "=v"(l)); return l; }
struct BgStream {
    unsigned long long src, dst, pdst, dump;
    unsigned left;
    f32x4 data; unsigned voff;
    __device__ __forceinline__ void init(const float* k0, const float* v0, const float* k1, const float* v1, const float* k2, const float* v2, float* out, unsigned char* dump_, int gwave) {
        dump = (unsigned long long)(uintptr_t)dump_; pdst = dump; src = (unsigned long long)(uintptr_t)k0; dst = dump; left = 0u;
        const int slot = gwave & 31; if (slot >= 24) return;
        const int w = (gwave >> 5) * 24 + slot; const float* sb; size_t db; int W, n, start, count;
        if (w < 1088) { const int t = w / 544, rem = w - t * 544, piece = rem % 17; n = rem / 17; W = 2048; start = piece * 482; count = (start + 482 <= 8188) ? 482 : 8188 - start; if (t == 0) { sb = k2; db = O_KS2; } else { sb = v2; db = O_VS2; } }
        else if (w < 1408) { const int rem0 = w - 1088, t = rem0 / 160, r2 = rem0 - t * 160, piece = r2 % 5; n = r2 / 5; W = 512; start = piece * 409; count = (start + 409 <= 2044) ? 409 : 2044 - start; if (t == 0) { sb = k1; db = O_KS1; } else { sb = v1; db = O_VS1; } }
        else { const int rem0 = w - 1408, t = rem0 >> 6, r2 = rem0 & 63; n = r2 >> 1; W = 128; start = (r2 & 1) * 254; count = 254; if (t == 0) { sb = k0; db = O_KS0; } else { sb = v0; db = O_VS0; } }
        src = (unsigned long long)(uintptr_t)sb + ((size_t)n * W + 1) * 4096 + (size_t)start * 1024; dst = (unsigned long long)(uintptr_t)out + db * 4 + (size_t)n * W * 4096 + (size_t)start * 1024; left = (unsigned)count;
    }
    __device__ __forceinline__ void begin(int lane) { voff = (unsigned)lane * 16u; data = (f32x4){0.f, 0.f, 0.f, 0.f}; pdst = dump; }
    __device__ __forceinline__ void step() {
        if (left) {
            asm volatile("global_store_dwordx4 %1, %0, %2\n\tglobal_load_dwordx4 %0, %1, %3" : "+v"(data) : "v"(voff), "s"(pdst), "s"(src) : "memory");
            pdst = dst; src += 1024; dst += 1024; --left;
        }
    }
    __device__ __forceinline__ void flush() {
        asm volatile("s_waitcnt vmcnt(0)\n\tglobal_store_dwordx4 %1, %0, %2" : : "v"(data), "v"(voff), "s"(pdst) : "memory");
        pdst = dump;
    }
};

struct Args { const float* in[20]; float* out; unsigned char* ws; int ph_lo, ph_hi; };
__global__ void __launch_bounds__(NWAVES * 64, 2) mega_fwd(Args args) {
    extern __shared__ __attribute__((aligned(16))) unsigned char lds[];
    Frame F;
    F.lds = (LAS unsigned char*)lds;
    F.MISC = (volatile LAS unsigned*)(F.lds + MISC_OFF);
    F.tid = threadIdx.x; F.lane = F.tid & 63; F.wave = __builtin_amdgcn_readfirstlane(F.tid >> 6);
    F.G = gridDim.x; { const int bx = blockIdx.x; F.vcu = (F.G % 8 == 0) ? (bx % 8) * (F.G / 8) + bx / 8 : bx; }
    F.ws = args.ws; F.out = args.out; F.ctl = (gu32*)(args.ws + WS_CTL);
    F.p_XP = args.in[I_XP]; F.p_XS = args.in[I_XS]; F.p_CK0 = args.in[I_CK0]; F.p_CV0 = args.in[I_CV0]; F.p_CK1 = args.in[I_CK1]; F.p_CV1 = args.in[I_CV1]; F.p_CK2 = args.in[I_CK2]; F.p_CV2 = args.in[I_CV2]; F.p_SP = args.in[I_SP]; F.p_NMIX = args.in[I_NMIX]; F.p_WIN = args.in[I_WIN]; F.p_WUP = args.in[I_WUP]; F.p_WPOOL = args.in[I_WPOOL]; F.p_PSCALE = args.in[I_PSCALE]; F.p_WOUT = args.in[I_WOUT]; F.p_NFFN = args.in[I_NFFN]; F.p_WG = args.in[I_WG]; F.p_WU = args.in[I_WU]; F.p_WD = args.in[I_WD]; F.p_NFIN = args.in[I_NFIN];
    for (int u = F.tid; u < (LDS_BYTES - LDSCTL_OFF) / 4; u += NWAVES * 64) ((LAS unsigned*)(F.lds + LDSCTL_OFF))[u] = 0u;
    __syncthreads();
    XcdBarrier bar; bar.bar = (unsigned*)(F.ctl + CW_BAR); bar.x = 0; bar.st = nullptr;
    if (N_LAUNCHES != PER_PHASE) bar = xcd_barrier_post((unsigned*)(F.ctl + CW_BAR), F.MISC + 8);
#define GRID_BAR() do { if (N_LAUNCHES != PER_PHASE) xcd_barrier(bar); } while (0)
    const int lo = args.ph_lo, hi = args.ph_hi;
#define IN(k) (lo <= (k) && (k) < hi)
#define BOTH(k) (IN(k) && IN((k) + 1))
    bf16* WIN = (bf16*)(F.ws + WS_WIN); bf16* WUP = (bf16*)(F.ws + WS_WUP); bf16* WPL = (bf16*)(F.ws + WS_WPL); bf16* WOUT = (bf16*)(F.ws + WS_WOUT); bf16* WGU = (bf16*)(F.ws + WS_WGU); bf16* WDN = (bf16*)(F.ws + WS_WDN);
    bf16* HN = (bf16*)(F.ws + WS_HN); bf16* QB = (bf16*)(F.ws + WS_QB); bf16* KB = (bf16*)(F.ws + WS_KB); bf16* VB = (bf16*)(F.ws + WS_VB); float* UB = (float*)(F.ws + WS_UB); bf16* GB = (bf16*)(F.ws + WS_GB);
    bf16* ATT = (bf16*)(F.ws + WS_ATT); bf16* PL = (bf16*)(F.ws + WS_PL); bf16* TB = (bf16*)(F.ws + WS_T); bf16* MIX = (bf16*)(F.ws + WS_MIX); bf16* X1B = (bf16*)(F.ws + WS_X1B); bf16* FFB = (bf16*)(F.ws + WS_FFB);
    float* rowss = (float*)(args.ws + WS_CTL) + CW_RSS;
    bf16* NUMB = (bf16*)(F.ws + WS_FFB); float* MLB = (float*)(F.ws + WS_FFB + 64 * MiB);
    const int gw = F.vcu * NWAVES + F.wave, NGW = F.G * NWAVES;
    pg8::NoBg nobg;
    BgStream bgs; bgs.init(F.p_CK0, F.p_CV0, F.p_CK1, F.p_CV1, F.p_CK2, F.p_CV2, F.out, F.ws + WS_DUMP + (size_t)(F.vcu * NWAVES + F.wave) * 1024, F.vcu * NWAVES + F.wave); bgs.begin(lane_now());
    LAS float* SKRED = (LAS float*)(F.lds + RING_OFF);

    if (IN(0)) { p0_prologue(F); if (BOTH(0)) GRID_BAR(); }

    if (IN(1)) {
        pg8::Gemm g{HN, WIN, D, D, 30, 0}; pg8::StaticOrder S; S.init(MPR, INW, F.G, (int)blockIdx.x);
        static_assert(WS_KB - WS_QB == WS_VB - WS_KB, "q/k/v buffers equally spaced");
        pg8::EpiIn E{QB, (WS_KB - WS_QB) / 2, GB, UB, F.out, 0.08838834764831845f * 1.4426950408889634f};
        pg8::gemm_phase<pg8::EpiIn, pg8::StaticOrder, true, true>(F.lds + RING_OFF, g, S, E, nobg);
        { int idx, share; skinny_share((MPR / 256) * (INW / 256), F.G, (int)blockIdx.x, idx, share);
          if (idx >= 0) for (int t = idx; t < INW / 32; t += share) {
              skinny_partial<1, true>(HN + (size_t)MPR * D, D, WIN, 32 * t, D, SKRED, F.wave, F.lane); LDS_WAIT(); __syncthreads();
              float v[1][2]; skinny_reduce<1>(SKRED, F.tid, v);
              sk_emit_in(QB, (WS_KB - WS_QB) / 2, GB, UB, F.out, 0.08838834764831845f * 1.4426950408889634f, F.tid >> 4, 32 * t + 2 * (F.tid & 15), v[0][0], v[0][1]); __syncthreads(); } }
        if (BOTH(1)) GRID_BAR();
    }

    if (IN(2)) {
        LAS unsigned char* wb = F.lds + RING_OFF + F.wave * 16384;
        LAS float* pl = (LAS float*)(wb + 9216);
        _Pragma("unroll 1") for (int ph = 0; ph < 2; ++ph) {
            if ((ph == 0) == (F.wave < 4)) p2_convert_wgu(F, (LAS float*)wb, gw, NGW);
            else { for (int it = gw; it < NB * 3 * NH * 64; it += NGW) attn_mfma_tile(QB, KB, VB, NUMB, MLB, it, wb, F.lane); }
        }
        if (F.wave < 3) { const int t = F.vcu * 3 + F.wave;
            if (t < NSMP * NH * 3) { const int gq = t % 3, nj = t / 3, n = nj >> 3, j = nj & 7;
                if (gq == 0) attn_sample_partial<0>(F.p_CK0, F.p_CV0, F.out, QB, NUMB, MLB, n, j, pl, F.lane);
                else if (gq == 1) attn_sample_partial<1>(F.p_CK1, F.p_CV1, F.out, QB, NUMB, MLB, n, j, pl, F.lane);
                else attn_sample_partial<2>(F.p_CK2, F.p_CV2, F.out, QB, NUMB, MLB, n, j, pl, F.lane); } }
        pool_naive(F, UB, PL, F.vcu * (NWAVES * 64) + F.tid, F.G * NWAVES * 64);
        if (BOTH(2)) GRID_BAR();
    }

    if (IN(3)) {
        attn_combine(NUMB, MLB, ATT, F.vcu * (NWAVES * 64) + F.tid, F.G * NWAVES * 64);
        pg8::Gemm g{PL, WPL, 512, PW, 2, 512 * 2}; pg8::StaticOrder S; S.init(MPR, D, F.G, (int)blockIdx.x);
        pg8::EpiPool E{GB, F.p_PSCALE, TB};
        pg8::gemm_phase<pg8::EpiPool, pg8::StaticOrder, true, true>(F.lds + RING_OFF, g, S, E, nobg);
        { int idx, share; skinny_share((MPR / 256) * (D / 256), F.G, (int)blockIdx.x, idx, share);
          if (idx >= 0) for (int t = idx; t < D / 32; t += share) {
              skinny_partial<1, true>(PL + (size_t)MPR * PW + (t >> 5) * 512, PW, WPL, 32 * t, 512, SKRED, F.wave, F.lane); LDS_WAIT(); __syncthreads();
              float v[1][2]; skinny_reduce<1>(SKRED, F.tid, v);
              sk_emit_pool(GB, F.p_PSCALE, TB, F.tid >> 4, 32 * t + 2 * (F.tid & 15), v[0][0], v[0][1]); __syncthreads(); } }
        if (BOTH(3)) GRID_BAR();
    }
    if (IN(4)) {
        pg8::Gemm g{ATT, WUP, GW, GW, 30, 0}; pg8::StaticOrder S; S.init(MPR, D, F.G, (int)blockIdx.x);
        pg8::EpiUp E{GB, TB, MIX};
        pg8::gemm_phase<pg8::EpiUp, pg8::StaticOrder, true, true>(F.lds + RING_OFF, g, S, E, nobg);
        { int idx, share; skinny_share((MPR / 256) * (D / 256), F.G, (int)blockIdx.x, idx, share);
          if (idx >= 0) for (int t = idx; t < D / 32; t += share) {
              skinny_partial<1, true>(ATT + (size_t)MPR * GW, GW, WUP, 32 * t, GW, SKRED, F.wave, F.lane); LDS_WAIT(); __syncthreads();
              float v[1][2]; skinny_reduce<1>(SKRED, F.tid, v);
              sk_emit_up(GB, TB, MIX, F.tid >> 4, 32 * t + 2 * (F.tid & 15), v[0][0], v[0][1]); __syncthreads(); } }
        if (BOTH(4)) GRID_BAR();
    }

    if (IN(5)) {
        pg8::Gemm g{MIX, WOUT, D, D, 30, 0}; pg8::StaticOrder S; S.init(MPR, D, F.G, (int)blockIdx.x);
        pg8::EpiOut E{F.p_XP, F.p_XS, F.out + O_Y, X1B, rowss};
        pg8::gemm_phase<pg8::EpiOut, pg8::StaticOrder, true, true>(F.lds + RING_OFF, g, S, E, nobg);
        { int idx, share; skinny_share((MPR / 256) * (D / 256), F.G, (int)blockIdx.x, idx, share);
          if (idx >= 0) for (int t = idx; t < D / 32; t += share) {
              skinny_partial<1, false>(MIX + (size_t)MPR * D, D, WOUT, 32 * t, D, SKRED, F.wave, F.lane); LDS_WAIT(); __syncthreads();
              float v[1][2]; skinny_reduce<1>(SKRED, F.tid, v);
              sk_emit_out(F.p_XS, F.out + O_Y, X1B, rowss, F.tid >> 4, 32 * t + 2 * (F.tid & 15), v[0][0], v[0][1], F.tid); __syncthreads(); } }
        if (BOTH(5)) GRID_BAR();
    }

    if (IN(6)) {
        pg8::Gemm g{X1B, WGU, D, D, 30, 0}; pg8::StaticOrder S; S.init(MPR, 2 * FF, F.G, (int)blockIdx.x);
        pg8::EpiFF E{rowss, FFB};
        bgs.begin(lane_now());
        pg8::gemm_phase<pg8::EpiFF, pg8::StaticOrder, true, true, BgStream>(F.lds + RING_OFF, g, S, E, bgs);
        { int idx, share; skinny_share((MPR / 256) * (2 * FF / 256), F.G, (int)blockIdx.x, idx, share);
          if (idx >= 0) for (int t = idx; t < FF / 32; t += share) { const int f0 = 32 * t;
              skinny_partial<2, true>(X1B + (size_t)MPR * D, D, WGU, (f0 >> 7) * 256 + (f0 & 127), D, SKRED, F.wave, F.lane); LDS_WAIT(); __syncthreads();
              float v[2][2]; skinny_reduce<2>(SKRED, F.tid, v);
              sk_emit_ff(rowss, FFB, F.tid >> 4, f0 + 2 * (F.tid & 15), v[0][0], v[0][1], v[1][0], v[1][1]); __syncthreads(); } }
        if (BOTH(6)) GRID_BAR();
    }

    if (IN(7)) {
        pg8::Gemm g{FFB, WDN, FF, FF, 30, 0}; pg8::StaticOrder S; S.init(MPR, D, F.G, (int)blockIdx.x);
        pg8::EpiDown E{F.out + O_Y};
        bgs.begin(lane_now());
        pg8::gemm_phase<pg8::EpiDown, pg8::StaticOrder, true, true, BgStream>(F.lds + RING_OFF, g, S, E, bgs);
        { int idx, share; skinny_share((MPR / 256) * (D / 256), F.G, (int)blockIdx.x, idx, share);
          if (idx >= 0) for (int t = idx; t < D / 32; t += share) {
              skinny_partial<1, false>(FFB + (size_t)MPR * FF, FF, WDN, 32 * t, FF, SKRED, F.wave, F.lane); LDS_WAIT(); __syncthreads();
              float v[1][2]; skinny_reduce<1>(SKRED, F.tid, v);
              sk_emit_down(F.out + O_Y, F.tid >> 4, 32 * t + 2 * (F.tid & 15), v[0][0], v[0][1]); __syncthreads(); } }
        if (BOTH(7)) GRID_BAR();
    }

    if (IN(8)) {
        bgs.begin(lane_now());
        while (bgs.left) { asm volatile("s_waitcnt vmcnt(0)" ::: "memory"); bgs.step(); }
        bgs.flush();
        { const int ln = lane_now(); for (int m = gw; m < MREAL; m += NGW) final_norm_row(F.out + O_Y + (size_t)m * D, F.p_NFIN, ln); }
    }
#undef IN
#undef BOTH
#undef GRID_BAR
}

extern "C" void kernel_launch(void* const* d_in, const int* in_sizes, int n_in, void* d_out, int out_size, void* d_ws, size_t ws_size, hipStream_t stream) {
    static int grid = 0;
    if (grid == 0) {
        if (n_in != 20 || in_sizes[0] != MPR * D || (size_t)out_size != O_END || ws_size < WS_END) {
            fprintf(stderr, "kernel_launch: shape mismatch: n_in %d in0 %d out %d (want %zu) ws %zu (want %zu); nothing launched\n", n_in, n_in > 0 ? in_sizes[0] : -1, out_size, (size_t)O_END, ws_size, (size_t)WS_END); grid = -1; return; }
        int dev = 0, cus = 0, per_cu = 0;
        if (hipGetDevice(&dev) != hipSuccess || hipDeviceGetAttribute(&cus, hipDeviceAttributeMultiprocessorCount, dev) != hipSuccess) { grid = -1; return; }
        if (hipFuncSetAttribute((const void*)mega_fwd, hipFuncAttributeMaxDynamicSharedMemorySize, LDS_BYTES) != hipSuccess) { fprintf(stderr, "kernel_launch: hipFuncSetAttribute failed\n"); grid = -1; return; }
        if (hipOccupancyMaxActiveBlocksPerMultiprocessor(&per_cu, (const void*)mega_fwd, NWAVES * 64, LDS_BYTES) != hipSuccess || per_cu < 1) { fprintf(stderr, "kernel_launch: occupancy query says %d blocks per CU\n", per_cu); }
        (void)hipGetLastError();
        grid = cus;
    }
    if (grid < 0) return;
    (void)hipMemsetAsync((char*)d_ws + WS_CTL, 0, CTL_ZERO_BYTES, stream);
    Args a{};
    for (int i = 0; i < 20; ++i) a.in[i] = (const float*)d_in[i];
    a.out = (float*)d_out; a.ws = (unsigned char*)d_ws;
    for (int li = 0; li < N_LAUNCHES; ++li) {
        a.ph_lo = (N_LAUNCHES == PER_PHASE) ? li : 0; a.ph_hi = (N_LAUNCHES == PER_PHASE) ? li + 1 : PER_PHASE;
        hipLaunchKernelGGL(mega_fwd, dim3(grid), dim3(NWAVES * 64), LDS_BYTES, stream, a);
    }
}
```

```cpp
#include <hip/hip_runtime.h>
#include <cstdio>
#include <cstdint>
#include <cmath>
namespace pg8 {
#define PG8_LAS __attribute__((address_space(3)))
typedef unsigned short bf16_t;
typedef short bf16x8 __attribute__((ext_vector_type(8)));
typedef float f32x4 __attribute__((ext_vector_type(4)));
typedef unsigned u32x4 __attribute__((ext_vector_type(4)));
constexpr int BM = 256, BK = 64, HALF = 128, HTB = HALF * BK * 2  , STAGE_BYTES = 8 * HTB, NXCD = 8, WGM = 8;

__host__ __device__ __forceinline__ int lds_byte(int r, int c) { const int st = (r >> 4) * 2 + (c >> 5), rr = r & 15, cc = c & 31, ob = rr * 64 + cc * 2; return st * 1024 + (ob ^ (((ob >> 9) & 1) << 5)); }
__host__ __device__ __forceinline__ void stage_rc(int b, int& R, int& C) { const int st = b / 1024, sb = b % 1024, swz = sb ^ (((sb >> 9) & 1) << 5); R = (st >> 1) * 16 + swz / 64; C = (st & 1) * 32 + (swz % 64) / 2; }
__host__ __device__ __forceinline__ int perm32(int rho) { const int n = rho >> 4, i = rho & 15; return 8 * (i >> 2) + 4 * n + (i & 3); }
template <bool PERM> __host__ __device__ __forceinline__ size_t bl_off(int row, int k, int nt) {
    const int r128 = row & 127, w = r128 & 31;
    const int R = PERM ? ((r128 & 96) + ((w >> 2) & 1) * 16 + (w >> 3) * 4 + (w & 3)) : r128;
    return (((size_t)(row >> 8) * nt + (k >> 6)) * 2 + ((row >> 7) & 1)) * 16384 + (size_t)lds_byte(R, k & 63);
}

struct Unit { int pm, pn; };
struct Gemm { const bf16_t* A; const bf16_t* Bt; int K, lda, ashift; size_t astride; };

struct StaticOrder {
    int nM, nN, nwg, G, c;
    __host__ __device__ void init(int M, int N, int G_, int c_) { nM = M / BM; nN = N / BM; nwg = nM * nN; G = G_; c = c_; }
    __host__ __device__ bool next(int i, Unit& u) const {
        const long L = (long)i * G + c; if (L >= nwg) return false;
        int wgid = (int)L; { const int q = nwg / NXCD, r = nwg % NXCD, xcd = wgid % NXCD, off = wgid / NXCD; wgid = (xcd < r ? xcd * (q + 1) : r * (q + 1) + (xcd - r) * q) + off; }
        const int nig = WGM * nN, gid = wgid / nig, fm = gid * WGM, gsz = (nM - fm) < WGM ? (nM - fm) : WGM;
        u.pm = fm + ((wgid % nig) % gsz); u.pn = (wgid % nig) / gsz; return true;
    }
    __device__ __forceinline__ void a_ready(const Unit&) const {}
    __device__ __forceinline__ void done(const Unit&) const {}
};

typedef float f32x2_cv __attribute__((ext_vector_type(2))); typedef __bf16 bf16x2_cv __attribute__((ext_vector_type(2)));
__device__ __forceinline__ unsigned cvt_pk_bf16(float lo, float hi) { const f32x2_cv v = {lo, hi}; const bf16x2_cv b = __builtin_convertvector(v, bf16x2_cv); return __builtin_bit_cast(unsigned, b); }
typedef float f32x2 __attribute__((ext_vector_type(2)));

struct NoBg { __device__ __forceinline__ void step() {} __device__ __forceinline__ void flush() {} };
template <class Epi, class Sched, bool ALIGN_EPI = false, bool SP2 = false, class Bg = NoBg, bool AIMG = false>
__device__ __forceinline__ void gemm_phase(PG8_LAS unsigned char* lds, const Gemm g, const Sched& S, const Epi& E, Bg& bg) {
    const int tid = threadIdx.x, wid = __builtin_amdgcn_readfirstlane(tid >> 6), lane = tid & 63, wr = wid >> 2, wc = wid & 3, fr = lane & 15, fq = lane >> 4;
    const int K = g.K, nt = K / BK, lda = g.lda;
    unsigned voffA[2], voffB[2];
#pragma unroll
    for (int i = 0; i < 2; ++i) { int R, C; stage_rc(tid * 16 + i * 8192, R, C); const int Rb = Epi::PERM ? ((R & ~31) + perm32(R & 31)) : R;
        voffA[i] = AIMG ? (unsigned)(tid * 16 + i * 8192) : (unsigned)(R * lda + C) * 2u; voffB[i] = (unsigned)(tid * 16 + i * 8192); (void)Rb; }
    const size_t kstep = AIMG ? (size_t)(2 * HTB) : (size_t)(BK * 2);
    const size_t kstepB = (size_t)(2 * HTB);
    const size_t hsB = (size_t)HTB, hsA = AIMG ? (size_t)HTB : (size_t)HALF * lda * 2;
    const size_t tsB = (size_t)nt * kstepB, tsA = AIMG ? (size_t)nt * kstep : 2 * hsA;
    const unsigned ldsw = (unsigned)wid * 1024u;
    const int aoff = lds_byte(wr * 64 + fr, fq * 8), boff = lds_byte(wc * 32 + fr, fq * 8);
#define PG8_SA(b, h) (((b) * 2 + (h)) * HTB)
#define PG8_SB(b, h) ((4 + (b) * 2 + (h)) * HTB)
#define PG8_STAGE(bufoff, gbase, voff) do { _Pragma("unroll") for (int _i = 0; _i < 2; ++_i) \
        __builtin_amdgcn_global_load_lds((const unsigned*)((const char*)(gbase) + (voff)[_i]), (PG8_LAS unsigned*)(lds + (bufoff) + ldsw + _i * 8192), 16, 0, 0); } while (0)
#define PG8_LDA(dst, b, h) do { _Pragma("unroll") for (int m = 0; m < 4; ++m) _Pragma("unroll") for (int k = 0; k < 2; ++k) dst[m][k] = *(const PG8_LAS bf16x8*)(lds + PG8_SA(b, h) + aoff + m * 2048 + k * 1024); } while (0)
#define PG8_LDB(dst, b, h) do { _Pragma("unroll") for (int n = 0; n < 2; ++n) _Pragma("unroll") for (int k = 0; k < 2; ++k) dst[n][k] = *(const PG8_LAS bf16x8*)(lds + PG8_SB(b, h) + boff + n * 2048 + k * 1024); } while (0)
#define PG8_MMA(ai, bj, At, Bt) do { __builtin_amdgcn_s_setprio(1); _Pragma("unroll") for (int m = 0; m < 4; ++m) _Pragma("unroll") for (int n = 0; n < 2; ++n) _Pragma("unroll") for (int k = 0; k < 2; ++k) \
        acc[ai][bj][m][n] = __builtin_amdgcn_mfma_f32_16x16x32_bf16(Bt[n][k], At[m][k], acc[ai][bj][m][n], 0, 0, 0); __builtin_amdgcn_s_setprio(0); } while (0)
#define PG8_WAIT_V(n) asm volatile("s_waitcnt vmcnt(" #n ")" ::: "memory")
#define PG8_WAIT_L(n) asm volatile("s_waitcnt lgkmcnt(" #n ")" ::: "memory")
#define PG8_BAR __builtin_amdgcn_s_barrier()
#define PG8_SCHED __builtin_amdgcn_sched_barrier(0)
    Unit cur, nxt; int ui = 0;
    if (!S.next(0, cur)) return;
    f32x4 acc[2][2][4][2];
#pragma unroll
    for (int a = 0; a < 2; ++a)
#pragma unroll
        for (int b = 0; b < 2; ++b)
#pragma unroll
            for (int m = 0; m < 4; ++m)
#pragma unroll
                for (int n = 0; n < 2; ++n) acc[a][b][m][n] = (f32x4){0.f, 0.f, 0.f, 0.f};
    bf16x8 At[4][2], B0[2][2], B1[2][2];
    const char* cA = (const char*)g.A + (size_t)cur.pm * tsA + (size_t)(cur.pn >> g.ashift) * g.astride; const char* cB = (const char*)g.Bt + (size_t)cur.pn * tsB;
    S.a_ready(cur);
    if constexpr (SP2) {
        PG8_STAGE(PG8_SB(0, 0), cB, voffB); PG8_STAGE(PG8_SB(0, 1), cB + hsB, voffB); PG8_STAGE(PG8_SA(0, 0), cA, voffA); PG8_STAGE(PG8_SA(0, 1), cA + hsA, voffA);
        if (wr == 1) PG8_BAR;
        PG8_WAIT_V(2); PG8_BAR;
        PG8_STAGE(PG8_SB(1, 0), cB + kstepB, voffB); PG8_STAGE(PG8_SA(1, 0), cA + kstep, voffA); PG8_STAGE(PG8_SB(1, 1), cB + hsB + kstepB, voffB);
        PG8_WAIT_V(6); PG8_BAR;
    } else {
        PG8_STAGE(PG8_SB(0, 0), cB, voffB); PG8_STAGE(PG8_SA(0, 0), cA, voffA); PG8_STAGE(PG8_SB(0, 1), cB + hsB, voffB); PG8_STAGE(PG8_SA(0, 1), cA + hsA, voffA);
        if (wr == 1) PG8_BAR;
        PG8_WAIT_V(4); PG8_BAR;
        PG8_STAGE(PG8_SB(1, 0), cB + kstepB, voffB); PG8_STAGE(PG8_SA(1, 0), cA + kstep, voffA); PG8_STAGE(PG8_SB(1, 1), cB + hsB + kstepB, voffB);
        PG8_WAIT_V(6); PG8_BAR;
    }
    for (;;) {
        const bool has_next = S.next(ui + 1, nxt);
        const char* nA = has_next ? (const char*)g.A + (size_t)nxt.pm * tsA + (size_t)(nxt.pn >> g.ashift) * g.astride : cA; const char* nB = has_next ? (const char*)g.Bt + (size_t)nxt.pn * tsB : cB;
        for (int t = 0; t < nt; t += 2) {
            const bool last = (t == nt - 2);
            const char* a1 = cA + (size_t)(t + 1) * kstep;
            const char* a2 = last ? nA : cA + (size_t)(t + 2) * kstep; const char* b2 = last ? nB : cB + (size_t)(t + 2) * kstepB;
            const char* a3 = a2 + kstep; const char* b3 = b2 + kstepB;
            if (last && has_next) S.a_ready(nxt);
            bg.step();
            if constexpr (SP2) {
            PG8_LDB(B0, 0, 0); PG8_LDB(B1, 0, 1); PG8_SCHED; PG8_LDA(At, 0, 0); PG8_STAGE(PG8_SA(1, 1), a1 + hsA, voffA);
            PG8_WAIT_V(8); PG8_WAIT_L(0); PG8_BAR; PG8_MMA(0, 0, At, B0); PG8_MMA(0, 1, At, B1); PG8_BAR; PG8_SCHED;
            PG8_LDA(At, 0, 1); PG8_STAGE(PG8_SB(0, 0), b2, voffB); PG8_STAGE(PG8_SB(0, 1), b2 + hsB, voffB); PG8_STAGE(PG8_SA(0, 0), a2, voffA);
            PG8_WAIT_V(8); PG8_WAIT_L(0); PG8_BAR; PG8_MMA(1, 0, At, B0); PG8_MMA(1, 1, At, B1); PG8_BAR; PG8_SCHED;
            PG8_LDB(B0, 1, 0); PG8_LDB(B1, 1, 1); PG8_SCHED; PG8_LDA(At, 1, 0); PG8_STAGE(PG8_SA(0, 1), a2 + hsA, voffA);
            PG8_WAIT_V(8); PG8_WAIT_L(0); PG8_BAR; PG8_MMA(0, 0, At, B0); PG8_MMA(0, 1, At, B1); PG8_BAR; PG8_SCHED;
            PG8_LDA(At, 1, 1); PG8_STAGE(PG8_SB(1, 0), b3, voffB); PG8_STAGE(PG8_SB(1, 1), b3 + hsB, voffB); PG8_STAGE(PG8_SA(1, 0), a3, voffA);
            PG8_WAIT_V(8); PG8_WAIT_L(0); PG8_BAR; PG8_MMA(1, 0, At, B0); PG8_MMA(1, 1, At, B1); PG8_BAR; PG8_SCHED;
            } else {
            PG8_LDB(B0, 0, 0); PG8_SCHED; PG8_LDA(At, 0, 0); PG8_STAGE(PG8_SA(1, 1), a1 + hsA, voffA);
            PG8_WAIT_L(8); PG8_BAR; PG8_WAIT_L(0); PG8_MMA(0, 0, At, B0); PG8_BAR; PG8_SCHED;
            PG8_LDB(B1, 0, 1); PG8_STAGE(PG8_SB(0, 0), b2, voffB);
            PG8_BAR; PG8_WAIT_L(0); PG8_MMA(0, 1, At, B1); PG8_BAR;
            PG8_LDA(At, 0, 1); PG8_STAGE(PG8_SA(0, 0), a2, voffA);
            PG8_BAR; PG8_WAIT_L(0); PG8_MMA(1, 0, At, B0); PG8_BAR; PG8_SCHED;
            PG8_STAGE(PG8_SB(0, 1), b2 + hsB, voffB);
            PG8_WAIT_V(6); PG8_BAR; PG8_MMA(1, 1, At, B1); PG8_BAR;
            PG8_LDB(B0, 1, 0); PG8_SCHED; PG8_LDA(At, 1, 0); PG8_STAGE(PG8_SA(0, 1), a2 + hsA, voffA);
            PG8_WAIT_L(8); PG8_BAR; PG8_WAIT_L(0); PG8_MMA(0, 0, At, B0); PG8_BAR; PG8_SCHED;
            PG8_LDB(B1, 1, 1); PG8_STAGE(PG8_SB(1, 0), b3, voffB);
            PG8_BAR; PG8_WAIT_L(0); PG8_MMA(0, 1, At, B1); PG8_BAR;
            PG8_LDA(At, 1, 1); PG8_STAGE(PG8_SA(1, 0), a3, voffA);
            PG8_BAR; PG8_WAIT_L(0); PG8_MMA(1, 0, At, B0); PG8_BAR; PG8_SCHED;
            PG8_STAGE(PG8_SB(1, 1), b3 + hsB, voffB);
            PG8_WAIT_V(6); PG8_BAR; PG8_MMA(1, 1, At, B1); PG8_BAR;
            }
        }
        if constexpr (ALIGN_EPI) { if (wr == 0) PG8_BAR; }
        if constexpr (!Epi::AFTER_DRAIN) { E(acc, cur, wr, wc, fr, fq); S.done(cur); }
        if (!has_next) break;
#pragma unroll
        for (int a = 0; a < 2; ++a)
#pragma unroll
            for (int b = 0; b < 2; ++b)
#pragma unroll
                for (int m = 0; m < 4; ++m)
#pragma unroll
                    for (int n = 0; n < 2; ++n) acc[a][b][m][n] = (f32x4){0.f, 0.f, 0.f, 0.f};
        cur = nxt; cA = nA; cB = nB; ++ui;
        if constexpr (ALIGN_EPI) { if (wr == 1) PG8_BAR; }
    }
    bg.flush();
    PG8_WAIT_V(0);
    if constexpr (!ALIGN_EPI) { if (wr == 0) PG8_BAR; }
    PG8_BAR;
    if constexpr (Epi::AFTER_DRAIN) { E.fused(acc, cur, wr, wc, fr, fq, lds, wid, lane); S.done(cur); }
#undef PG8_SA
#undef PG8_SB
#undef PG8_STAGE
#undef PG8_LDA
#undef PG8_LDB
#undef PG8_MMA
#undef PG8_WAIT_V
#undef PG8_WAIT_L
#undef PG8_BAR
#undef PG8_SCHED
}
}

constexpr int D = 4096, NB = 4, SEQ = 2048, MPR = NB * SEQ  , NSMP = 32, MREAL = MPR + NSMP  , MP = 8448  ;
constexpr int HD = 128, NH = 8, GW = NH * HD  , QKVW = 3 * GW  , PW = 2048, INW = 3 * QKVW + PW + 2 * D  , FF = 11008;
constexpr int PHIST = 15;
constexpr float RMS_EPS = 1e-6f;
constexpr size_t O_Y = 0;
constexpr size_t O_KP0 = (size_t)MREAL * D;
constexpr size_t O_VP0 = O_KP0 + (size_t)NB * 128 * GW;
constexpr size_t O_KP1 = O_VP0 + (size_t)NB * 128 * GW;
constexpr size_t O_VP1 = O_KP1 + (size_t)NB * 512 * GW;
constexpr size_t O_KP2 = O_VP1 + (size_t)NB * 512 * GW;
constexpr size_t O_VP2 = O_KP2 + (size_t)NB * 2048 * GW;
constexpr size_t O_PP  = O_VP2 + (size_t)NB * 2048 * GW;
constexpr size_t O_KS0 = O_PP + (size_t)NB * PHIST * PW;
constexpr size_t O_VS0 = O_KS0 + (size_t)NSMP * 128 * GW;
constexpr size_t O_KS1 = O_VS0 + (size_t)NSMP * 128 * GW;
constexpr size_t O_VS1 = O_KS1 + (size_t)NSMP * 512 * GW;
constexpr size_t O_KS2 = O_VS1 + (size_t)NSMP * 512 * GW;
constexpr size_t O_VS2 = O_KS2 + (size_t)NSMP * 2048 * GW;
constexpr size_t O_PS  = O_VS2 + (size_t)NSMP * 2048 * GW;
constexpr size_t O_END = O_PS + (size_t)NSMP * PHIST * PW;

namespace pg8 {
__device__ __forceinline__ float bf_lo(unsigned w) { return __uint_as_float(w << 16); }
__device__ __forceinline__ float bf_hi(unsigned w) { return __uint_as_float(w & 0xffff0000u); }
__device__ __forceinline__ float sigmoidf_(float x) { return __builtin_amdgcn_rcpf(1.0f + __builtin_amdgcn_exp2f(-1.4426950408889634f * x)); }

struct EpiIn {
    static constexpr bool PERM = true, AFTER_DRAIN = false;
    bf16_t *QB; size_t qkv_stride  ; bf16_t* GB; float* UB; float* out; float qscale;
    __device__ __forceinline__ void operator()(const f32x4 (&acc)[2][2][4][2], const Unit& u, int wr, int wc, int fr, int fq) const {
        const int colt = u.pn * BM, cl = wc * 32 + 8 * fq, rbase = u.pm * BM + wr * 64 + fr;
        if (colt < 3 * QKVW) {
            const int which = colt / QKVW, c3 = colt - which * QKVW;
            bf16_t* B = QB + (size_t)which * qkv_stride; const float sc = which == 0 ? qscale : 1.0f;
#pragma unroll
            for (int ai = 0; ai < 2; ++ai)
#pragma unroll
                for (int m = 0; m < 4; ++m) { bf16_t* rowp = B + (size_t)(rbase + ai * HALF + m * 16) * QKVW + c3 + cl;
#pragma unroll
                    for (int bj = 0; bj < 2; ++bj) { const f32x4 v0 = acc[ai][bj][m][0] * sc, v1 = acc[ai][bj][m][1] * sc; u32x4 w;
                        w.x = cvt_pk_bf16(v0[0], v0[1]); w.y = cvt_pk_bf16(v0[2], v0[3]); w.z = cvt_pk_bf16(v1[0], v1[1]); w.w = cvt_pk_bf16(v1[2], v1[3]);
                        *(u32x4*)(rowp + bj * HALF) = w; } }
            if (which != 0) {
                const int g = c3 / GW, cg = c3 - g * GW + cl, W = g == 0 ? 128 : (g == 1 ? 512 : 2048);
                float* op = out + (g == 0 ? (which == 1 ? O_KP0 : O_VP0) : g == 1 ? (which == 1 ? O_KP1 : O_VP1) : (which == 1 ? O_KP2 : O_VP2));
                float* os = out + (g == 0 ? (which == 1 ? O_KS0 : O_VS0) : g == 1 ? (which == 1 ? O_KS1 : O_VS1) : (which == 1 ? O_KS2 : O_VS2));
#pragma unroll
                for (int ai = 0; ai < 2; ++ai)
#pragma unroll
                    for (int m = 0; m < 4; ++m) { const int row = rbase + ai * HALF + m * 16; float* dst = nullptr;
                        if (row < MPR) { const int b = row >> 11, tt = (row & (SEQ - 1)) - (SEQ - W); if (tt >= 0) dst = op + ((size_t)(b * W + tt)) * GW + cg; }
                        else if (row < MREAL) { dst = os + ((size_t)((row - MPR) * W + (W - 1))) * GW + cg; }
                        if (dst) {
#pragma unroll
                            for (int bj = 0; bj < 2; ++bj)
#pragma unroll
                                for (int n = 0; n < 2; ++n) *(f32x4*)(dst + bj * HALF + 4 * n) = acc[ai][bj][m][n]; } }
            }
        } else if (colt < 3 * QKVW + PW) {
            const int c = colt - 3 * QKVW + cl;
#pragma unroll
            for (int ai = 0; ai < 2; ++ai)
#pragma unroll
                for (int m = 0; m < 4; ++m) { const int row = rbase + ai * HALF + m * 16; float* up = UB + (size_t)row * PW + c; float* dst = nullptr;
                    if (row < MPR) { const int b = row >> 11, tt = (row & (SEQ - 1)) - (SEQ - PHIST); if (tt >= 0) dst = out + O_PP + ((size_t)(b * PHIST + tt)) * PW + c; }
                    else if (row < MREAL) { dst = out + O_PS + ((size_t)((row - MPR) * PHIST + (PHIST - 1))) * PW + c; }
#pragma unroll
                    for (int bj = 0; bj < 2; ++bj)
#pragma unroll
                        for (int n = 0; n < 2; ++n) { *(f32x4*)(up + bj * HALF + 4 * n) = acc[ai][bj][m][n]; if (dst) *(f32x4*)(dst + bj * HALF + 4 * n) = acc[ai][bj][m][n]; } }
        } else {
            const int c = colt - (3 * QKVW + PW) + cl;
#pragma unroll
            for (int ai = 0; ai < 2; ++ai)
#pragma unroll
                for (int m = 0; m < 4; ++m) { bf16_t* rowp = GB + (size_t)(rbase + ai * HALF + m * 16) * (2 * D) + c;
#pragma unroll
                    for (int bj = 0; bj < 2; ++bj) { const f32x4 v0 = acc[ai][bj][m][0], v1 = acc[ai][bj][m][1]; u32x4 w;
                        w.x = cvt_pk_bf16(sigmoidf_(v0[0]), sigmoidf_(v0[1])); w.y = cvt_pk_bf16(sigmoidf_(v0[2]), sigmoidf_(v0[3]));
                        w.z = cvt_pk_bf16(sigmoidf_(v1[0]), sigmoidf_(v1[1])); w.w = cvt_pk_bf16(sigmoidf_(v1[2]), sigmoidf_(v1[3]));
                        *(u32x4*)(rowp + bj * HALF) = w; } }
        }
    }
};

#define EPI_FENCE() asm volatile("" ::: "memory")
struct EpiPool {
    static constexpr bool PERM = true, AFTER_DRAIN = false;
    const bf16_t* GB; const float* pscale; bf16_t* T;
    __device__ __forceinline__ void operator()(const f32x4 (&acc)[2][2][4][2], const Unit& u, int wr, int wc, int fr, int fq) const {
        const int col0 = u.pn * BM + wc * 32 + 8 * fq, rbase = u.pm * BM + wr * 64 + fr;
        f32x4 sv[2][2];
#pragma unroll
        for (int bj = 0; bj < 2; ++bj)
#pragma unroll
            for (int n = 0; n < 2; ++n) sv[bj][n] = *(const f32x4*)(pscale + col0 + bj * HALF + 4 * n);
#pragma unroll
        for (int ai = 0; ai < 2; ++ai) {
            u32x4 gq[4][2];
#pragma unroll
            for (int m = 0; m < 4; ++m)
#pragma unroll
                for (int bj = 0; bj < 2; ++bj) gq[m][bj] = *(const u32x4*)(GB + (size_t)(rbase + ai * HALF + m * 16) * (2 * D) + D + col0 + bj * HALF);
            EPI_FENCE();
#pragma unroll
            for (int m = 0; m < 4; ++m) { const size_t row = (size_t)(rbase + ai * HALF + m * 16);
#pragma unroll
                for (int bj = 0; bj < 2; ++bj) { const u32x4 g = gq[m][bj];
                    const f32x4 v0 = acc[ai][bj][m][0] * sv[bj][0], v1 = acc[ai][bj][m][1] * sv[bj][1]; u32x4 w;
                    w.x = cvt_pk_bf16(v0[0] * bf_lo(g.x), v0[1] * bf_hi(g.x)); w.y = cvt_pk_bf16(v0[2] * bf_lo(g.y), v0[3] * bf_hi(g.y));
                    w.z = cvt_pk_bf16(v1[0] * bf_lo(g.z), v1[1] * bf_hi(g.z)); w.w = cvt_pk_bf16(v1[2] * bf_lo(g.w), v1[3] * bf_hi(g.w));
                    *(u32x4*)(T + row * D + col0 + bj * HALF) = w; } }
            EPI_FENCE();
        }
    }
};
struct EpiUp {
    static constexpr bool PERM = true, AFTER_DRAIN = false;
    const bf16_t* GB; const bf16_t* T; bf16_t* MIX;
    __device__ __forceinline__ void operator()(const f32x4 (&acc)[2][2][4][2], const Unit& u, int wr, int wc, int fr, int fq) const {
        const int col0 = u.pn * BM + wc * 32 + 8 * fq, rbase = u.pm * BM + wr * 64 + fr;
#pragma unroll
        for (int ai = 0; ai < 2; ++ai) {
            u32x4 gq[4][2], tq[4][2];
#pragma unroll
            for (int m = 0; m < 4; ++m)
#pragma unroll
                for (int bj = 0; bj < 2; ++bj) { const size_t row = (size_t)(rbase + ai * HALF + m * 16);
                    gq[m][bj] = *(const u32x4*)(GB + row * (2 * D) + col0 + bj * HALF); tq[m][bj] = *(const u32x4*)(T + row * D + col0 + bj * HALF); }
            EPI_FENCE();
#pragma unroll
            for (int m = 0; m < 4; ++m) { const size_t row = (size_t)(rbase + ai * HALF + m * 16);
#pragma unroll
                for (int bj = 0; bj < 2; ++bj) { const u32x4 g = gq[m][bj], t = tq[m][bj];
                    const f32x4 v0 = acc[ai][bj][m][0], v1 = acc[ai][bj][m][1]; u32x4 w;
                    w.x = cvt_pk_bf16(v0[0] * bf_lo(g.x) + bf_lo(t.x), v0[1] * bf_hi(g.x) + bf_hi(t.x)); w.y = cvt_pk_bf16(v0[2] * bf_lo(g.y) + bf_lo(t.y), v0[3] * bf_hi(g.y) + bf_hi(t.y));
                    w.z = cvt_pk_bf16(v1[0] * bf_lo(g.z) + bf_lo(t.z), v1[1] * bf_hi(g.z) + bf_hi(t.z)); w.w = cvt_pk_bf16(v1[2] * bf_lo(g.w) + bf_lo(t.w), v1[3] * bf_hi(g.w) + bf_hi(t.w));
                    *(u32x4*)(MIX + row * D + col0 + bj * HALF) = w; } }
            EPI_FENCE();
        }
    }
};
struct EpiOut {
    static constexpr bool PERM = false, AFTER_DRAIN = false;
    const float* xp; const float* xs; float* y; bf16_t* X1B; float* rowss;
    __device__ __forceinline__ void operator()(const f32x4 (&acc)[2][2][4][2], const Unit& u, int wr, int wc, int fr, int fq) const {
        const int col0 = u.pn * BM + wc * 32 + 4 * fq, rbase = u.pm * BM + wr * 64 + fr;
        typedef unsigned u32x2v __attribute__((ext_vector_type(2)));
#pragma unroll
        for (int ai = 0; ai < 2; ++ai) {
            f32x4 xin[4][2][2];
#pragma unroll
            for (int m = 0; m < 4; ++m) { const int row = rbase + ai * HALF + m * 16; const int rc = row < MREAL ? row : MREAL - 1;
                const float* xr = (rc < MPR ? xp + (size_t)rc * D : xs + (size_t)(rc - MPR) * D) + col0;
#pragma unroll
                for (int bj = 0; bj < 2; ++bj)
#pragma unroll
                    for (int n = 0; n < 2; ++n) xin[m][bj][n] = *(const f32x4*)(xr + bj * HALF + n * 16); }
            EPI_FENCE();
#pragma unroll
            for (int m = 0; m < 4; ++m) { const int row = rbase + ai * HALF + m * 16; const bool real = row < MREAL; float ss = 0.f;
#pragma unroll
                for (int bj = 0; bj < 2; ++bj)
#pragma unroll
                    for (int n = 0; n < 2; ++n) { const f32x4 o = acc[ai][bj][m][n] + xin[m][bj][n];
                        if (real) *(f32x4*)(y + (size_t)row * D + col0 + bj * HALF + n * 16) = o;
                        u32x2v w; w.x = cvt_pk_bf16(o[0], o[1]); w.y = cvt_pk_bf16(o[2], o[3]); *(u32x2v*)((char*)X1B + bl_off<false>(row, col0 + bj * HALF + n * 16, D / 64)) = w;
                        ss += (o[0] * o[0] + o[1] * o[1]) + (o[2] * o[2] + o[3] * o[3]); }
                ss += __shfl_xor(ss, 16); ss += __shfl_xor(ss, 32);
                if (fq == 0 && real) atomicAdd(rowss + row, ss); }
            EPI_FENCE();
        }
    }
};
struct EpiFF {
    static constexpr bool PERM = true, AFTER_DRAIN = false;
    const float* rowss; bf16_t* FFB;
    __device__ __forceinline__ void operator()(const f32x4 (&acc)[2][2][4][2], const Unit& u, int wr, int wc, int fr, int fq) const {
        const int col0 = u.pn * HALF + wc * 32 + 8 * fq, rbase = u.pm * BM + wr * 64 + fr;
        float rs[2][4];
#pragma unroll
        for (int ai = 0; ai < 2; ++ai)
#pragma unroll
            for (int m = 0; m < 4; ++m) rs[ai][m] = rowss[rbase + ai * HALF + m * 16];
        EPI_FENCE();
#pragma unroll
        for (int ai = 0; ai < 2; ++ai)
#pragma unroll
            for (int m = 0; m < 4; ++m) { const int row = rbase + ai * HALF + m * 16; const float r = 1.0f / sqrtf(rs[ai][m] * (1.0f / D) + RMS_EPS);
                u32x4 w; float o[8];
#pragma unroll
                for (int n = 0; n < 2; ++n)
#pragma unroll
                    for (int j = 0; j < 4; ++j) { const float gv = acc[ai][0][m][n][j] * r, uv = acc[ai][1][m][n][j] * r; o[4 * n + j] = gv * sigmoidf_(gv) * uv; }
                w.x = cvt_pk_bf16(o[0], o[1]); w.y = cvt_pk_bf16(o[2], o[3]); w.z = cvt_pk_bf16(o[4], o[5]); w.w = cvt_pk_bf16(o[6], o[7]);
                *(u32x4*)(FFB + (size_t)row * FF + col0) = w; }
    }
};
struct EpiDown {
    static constexpr bool PERM = false, AFTER_DRAIN = false;
    float* y;
    __device__ __forceinline__ void operator()(const f32x4 (&acc)[2][2][4][2], const Unit& u, int wr, int wc, int fr, int fq) const {
        const int col0 = u.pn * BM + wc * 32 + 4 * fq, rbase = u.pm * BM + wr * 64 + fr;
#pragma unroll
        for (int ai = 0; ai < 2; ++ai) {
            f32x4 yin[4][2][2];
#pragma unroll
            for (int m = 0; m < 4; ++m) { const int row = rbase + ai * HALF + m * 16; const int rc = row < MREAL ? row : MREAL - 1; const float* yr = y + (size_t)rc * D + col0;
#pragma unroll
                for (int bj = 0; bj < 2; ++bj)
#pragma unroll
                    for (int n = 0; n < 2; ++n) yin[m][bj][n] = *(const f32x4*)(yr + bj * HALF + n * 16); }
            EPI_FENCE();
#pragma unroll
            for (int m = 0; m < 4; ++m) { const int row = rbase + ai * HALF + m * 16;
                if (row < MREAL) { float* yr = y + (size_t)row * D + col0;
#pragma unroll
                    for (int bj = 0; bj < 2; ++bj)
#pragma unroll
                        for (int n = 0; n < 2; ++n) *(f32x4*)(yr + bj * HALF + n * 16) = yin[m][bj][n] + acc[ai][bj][m][n]; } }
            EPI_FENCE();
        }
    }
};
}

constexpr int NWAVES = 8;
#ifndef MK_N_LAUNCHES
#define MK_N_LAUNCHES 1
#endif
constexpr int PER_PHASE = 9;
constexpr int N_LAUNCHES = MK_N_LAUNCHES;

constexpr size_t MiB = 1u << 20;
constexpr size_t al256(size_t x) { return (x + 255) & ~(size_t)255; }
constexpr size_t WS_CTL = 0, CTL_ZERO_BYTES = 1 * MiB;
constexpr size_t WS_WIN  = 1 * MiB;
constexpr size_t WS_WUP  = WS_WIN  + al256((size_t)INW * D * 2);
constexpr size_t WS_WPL  = WS_WUP  + al256((size_t)D * GW * 2);
constexpr size_t WS_WOUT = WS_WPL  + al256((size_t)D * 512 * 2);
constexpr size_t WS_WGU  = WS_WOUT + al256((size_t)D * D * 2);
constexpr size_t WS_WDN  = WS_WGU  + al256((size_t)2 * FF * D * 2);
constexpr size_t WS_HN   = WS_WDN  + al256((size_t)D * FF * 2);
constexpr size_t WS_QB   = WS_HN   + al256((size_t)MP * D * 2);
constexpr size_t WS_KB   = WS_QB   + al256((size_t)MP * QKVW * 2);
constexpr size_t WS_VB   = WS_KB   + al256((size_t)MP * QKVW * 2);
constexpr size_t WS_UB   = WS_VB   + al256((size_t)MP * QKVW * 2);
constexpr size_t WS_GB   = WS_UB   + al256((size_t)MP * PW * 4);
constexpr size_t WS_ATT  = WS_GB   + al256((size_t)MP * 2 * D * 2);
constexpr size_t WS_PL   = WS_ATT  + al256((size_t)MP * GW * 2);
constexpr size_t WS_T    = WS_PL   + al256((size_t)MP * PW * 2);
constexpr size_t WS_MIX  = WS_T    + al256((size_t)MP * D * 2);
constexpr size_t WS_X1B  = WS_MIX  + al256((size_t)MP * D * 2);
constexpr size_t WS_FFB  = WS_X1B  + al256((size_t)MP * D * 2);
constexpr size_t WS_DUMP = WS_FFB  + al256((size_t)MP * FF * 2);
constexpr size_t WS_END  = WS_DUMP + 2 * MiB;
constexpr int CW_BAR = 4096;
constexpr int CW_RSS = 16384;
static_assert((CW_RSS + MP) * 4 <= (int)CTL_ZERO_BYTES && CW_BAR + 3456 <= CW_RSS, "CTL map");

constexpr int RING_OFF = 0, RING_BYTES = 131072;
constexpr int LDSCTL_OFF = RING_BYTES, MISC_OFF = LDSCTL_OFF + 320;
constexpr int LDS_BYTES = 147456;
static_assert(MISC_OFF + 128 <= LDS_BYTES, "LDS map");

#define GAS __attribute__((address_space(1)))
#define LAS __attribute__((address_space(3)))
typedef unsigned short bf16;
typedef unsigned v4u __attribute__((ext_vector_type(4)));
typedef unsigned v2u __attribute__((ext_vector_type(2)));
typedef float f32x4 __attribute__((ext_vector_type(4)));
typedef GAS unsigned gu32;
#define RLX_AGENT __ATOMIC_RELAXED, __HIP_MEMORY_SCOPE_AGENT
#define LDS_WAIT() asm volatile("s_waitcnt lgkmcnt(0)" ::: "memory")
#define VM_WAIT() asm volatile("s_waitcnt vmcnt(0)" ::: "memory")
__device__ __forceinline__ unsigned f2bf(float f) { unsigned u = __builtin_bit_cast(unsigned, f); return (u + 0x7fffu + ((u >> 16) & 1u)) >> 16; }
__device__ __forceinline__ unsigned pk2(float lo, float hi) { return f2bf(lo) | (f2bf(hi) << 16); }
__device__ __forceinline__ float bflo(unsigned w) { return __uint_as_float(w << 16); }
__device__ __forceinline__ float bfhi(unsigned w) { return __uint_as_float(w & 0xffff0000u); }

#define XB_TMO      128
#define XB_XCNT(j)  (256  + 64 * (j))
#define XB_XSUB(j)  (1280 + 64 * (j))
#define XB_XGEN(j)  (2304 + 64 * (j))
#define XB_TOP      3328
#define XB_TOPGEN   3392
#define XCD_BAR_WORDS 3456
#define XB_SPIN_CAP (1u << 18)

__device__ __forceinline__ unsigned xb_ld(unsigned* p)              { return __hip_atomic_load(p, __ATOMIC_RELAXED, __HIP_MEMORY_SCOPE_AGENT); }
__device__ __forceinline__ unsigned xb_add(unsigned* p, unsigned v) { return __hip_atomic_fetch_add(p, v, __ATOMIC_RELAXED, __HIP_MEMORY_SCOPE_AGENT); }
__device__ __forceinline__ unsigned xb_xcc_id() { return (unsigned)__builtin_amdgcn_s_getreg((3 << 11) | 20) & 0xFu; }
#define XB_SPIN(cond, bar) do { unsigned _sp = 0; while (cond) { __builtin_amdgcn_s_sleep(1); \
    if ((++_sp & 255u) == 0u) { if (xb_ld(&(bar)[XB_TMO])) break; if (_sp > XB_SPIN_CAP) { atomicAdd(&(bar)[XB_TMO], 1u); break; } } } } while (0)

struct XcdBarrier {
    unsigned* bar; unsigned x;
    volatile LAS unsigned* st;
};

__device__ __forceinline__ XcdBarrier xcd_barrier_post(unsigned* bar, volatile LAS unsigned* st) {
    XcdBarrier b; b.bar = bar; b.x = xb_xcc_id(); b.st = st;
    if (threadIdx.x == 0) (void)xb_add(&bar[XB_XCNT(b.x)], 1u);
    return b;
}
__device__ __forceinline__ void xcd_barrier_complete(unsigned* bar, unsigned x, unsigned& nloc, unsigned& nx) {
    const unsigned G = gridDim.x * gridDim.y * gridDim.z;
    unsigned sum, cnt, mine, sp = 0u;
    for (;;) {
        sum = 0u; cnt = 0u; mine = 0u;
#pragma unroll
        for (unsigned j = 0; j < 16; ++j) { const unsigned c = xb_ld(&bar[XB_XCNT(j)]); sum += c; cnt += (c > 0u) ? 1u : 0u; mine = (j == x) ? c : mine; }
        if (sum == G) break;
        __builtin_amdgcn_s_sleep(1);
        if ((++sp & 255u) == 0u) { if (xb_ld(&bar[XB_TMO])) break; if (sp > XB_SPIN_CAP) { atomicAdd(&bar[XB_TMO], 1u); break; } }
    }
    nloc = mine > 0u ? mine : 1u; nx = cnt > 0u ? cnt : 1u;
}

__device__ __forceinline__ void xcd_barrier(const XcdBarrier& b) {
    asm volatile("s_waitcnt vmcnt(0)" ::: "memory");
    __syncthreads();
    if (threadIdx.x == 0) {
        unsigned* bar = b.bar;
        __builtin_amdgcn_s_waitcnt(0);
        unsigned nloc = b.st[0], nx = b.st[1];
        if (nloc == 0u) { xcd_barrier_complete(bar, b.x, nloc, nx); b.st[0] = nloc; b.st[1] = nx; }
        const unsigned old = xb_add(&bar[XB_XSUB(b.x)], 1u);
        const unsigned gen = old / nloc;
        if (old + 1u == (gen + 1u) * nloc) {
            __builtin_amdgcn_fence(__ATOMIC_RELEASE, "agent");
            asm volatile("s_waitcnt vmcnt(0)" ::: "memory");
            const unsigned og = xb_add(&bar[XB_TOP], 1u);
            const unsigned tg = og / nx;
            if (og + 1u == (tg + 1u) * nx) xb_add(&bar[XB_TOPGEN], 1u);
            else XB_SPIN(xb_ld(&bar[XB_TOPGEN]) == tg, bar);
            __builtin_amdgcn_fence(__ATOMIC_ACQUIRE, "agent");
            xb_add(&bar[XB_XGEN(b.x)], 1u);
            asm volatile("s_waitcnt vmcnt(0)" ::: "memory");
        } else {
            XB_SPIN(xb_ld(&bar[XB_XGEN(b.x)]) == gen, bar);
            __builtin_amdgcn_fence(__ATOMIC_ACQUIRE, "agent");
            asm volatile("s_waitcnt vmcnt(0)" ::: "memory");
        }
    }
    __syncthreads();
}


struct Frame {
    LAS unsigned char* lds;
    volatile LAS unsigned* MISC;
    gu32* ctl;
    int tid, lane, wave;
    int vcu, G;
    const float *p_XP, *p_XS, *p_CK0, *p_CV0, *p_CK1, *p_CV1, *p_CK2, *p_CV2, *p_SP, *p_NMIX, *p_WIN, *p_WUP, *p_WPOOL, *p_PSCALE, *p_WOUT, *p_NFFN, *p_WG, *p_WU, *p_WD, *p_NFIN;
    float* out; unsigned char* ws;
};
enum { I_XP = 0, I_XS, I_CK0, I_CV0, I_CK1, I_CV1, I_CK2, I_CV2, I_SP, I_NMIX, I_WIN, I_WUP, I_WPOOL, I_PSCALE, I_WOUT, I_NFFN, I_WG, I_WU, I_WD, I_NFIN };

__device__ __forceinline__ float wave_sum(float v) {
#pragma unroll
    for (int o = 1; o < 64; o <<= 1) v += __shfl_xor(v, o);
    return v;
}
__device__ __forceinline__ float wave_max(float v) {
#pragma unroll
    for (int o = 1; o < 64; o <<= 1) v = fmaxf(v, __shfl_xor(v, o));
    return v;
}
template <bool PERM>
__device__ __forceinline__ void p0_transpose_item(const float* W, int K, int N, bf16* WT, int k0, int n0, int out_row0, const float* kscale, LAS float* scr, int lane) {
    float wv[32];
#pragma unroll
    for (int i = 0; i < 32; ++i) wv[i] = W[(size_t)(k0 + 2 * i + (lane >> 5)) * N + n0 + (lane & 31)];
    if (kscale) {
#pragma unroll
        for (int i = 0; i < 32; ++i) wv[i] *= kscale[k0 + 2 * i + (lane >> 5)]; }
#pragma unroll
    for (int i = 0; i < 32; ++i) scr[(2 * i + (lane >> 5)) * 33 + (lane & 31)] = wv[i];
    LDS_WAIT(); asm volatile("" ::: "memory");
    const int c = lane & 7;
#pragma unroll
    for (int j = 0; j < 4; ++j) { const int n = (lane >> 3) + 8 * j; const LAS float* s = scr + (8 * c) * 33 + n;
        v4u o; o.x = pk2(s[0 * 33], s[1 * 33]); o.y = pk2(s[2 * 33], s[3 * 33]); o.z = pk2(s[4 * 33], s[5 * 33]); o.w = pk2(s[6 * 33], s[7 * 33]);
        *(GAS v4u*)((GAS char*)WT + pg8::bl_off<PERM>(out_row0 + n, k0 + 8 * c, K >> 6)) = o; }
    LDS_WAIT(); asm volatile("" ::: "memory");
}
__device__ __forceinline__ void rms_row_to_bf16(const float* xrow, const float* gain, bf16* obase, int m, int lane) {
    const GAS f32x4* xr = (const GAS f32x4*)xrow + lane; const GAS f32x4* gr = (const GAS f32x4*)gain + lane;
    f32x4 v[16]; float s = 0.f;
#pragma unroll
    for (int j = 0; j < 16; ++j) { v[j] = xr[64 * j]; s += (v[j].x * v[j].x + v[j].y * v[j].y) + (v[j].z * v[j].z + v[j].w * v[j].w); }
    const float rstd = 1.0f / sqrtf(wave_sum(s) * (1.0f / D) + RMS_EPS);
    GAS char* ob = (GAS char*)obase + pg8::bl_off<false>(m, 4 * lane, D / 64);
#pragma unroll
    for (int j = 0; j < 16; ++j) { const f32x4 g = gr[64 * j]; v2u w; w.x = pk2(v[j].x * rstd * g.x, v[j].y * rstd * g.y); w.y = pk2(v[j].z * rstd * g.z, v[j].w * rstd * g.w); *(GAS v2u*)(ob + (size_t)j * (4 * 32768)) = w; }
}
__device__ __forceinline__ void p0_cache_copy(const float* src, float* dst, int W, int gt, int NT) {
    const int per = (W - 1) * 256; const int total = NSMP * per;
    const GAS f32x4* s4 = (const GAS f32x4*)src; GAS f32x4* d4 = (GAS f32x4*)dst;
    for (int i0 = gt; i0 < total; i0 += 4 * NT) {
        f32x4 v[4]; int di[4];
#pragma unroll
        for (int k = 0; k < 4; ++k) { const int i = i0 + k * NT; const int n = i / per, rem = i - n * per; di[k] = n * W * 256 + rem; if (i < total) v[k] = s4[(size_t)di[k] + 256]; }
#pragma unroll
        for (int k = 0; k < 4; ++k) { const int i = i0 + k * NT; if (i < total) d4[(size_t)di[k]] = v[k]; }
    }
}
__device__ __forceinline__ void p0_prologue(Frame& F) {
    LAS float* scr = (LAS float*)(F.lds + RING_OFF + F.wave * 16384);
    const int gw = F.vcu * NWAVES + F.wave, NGW = F.G * NWAVES;
    bf16* WIN = (bf16*)(F.ws + WS_WIN); bf16* WUP = (bf16*)(F.ws + WS_WUP); bf16* WPL = (bf16*)(F.ws + WS_WPL); bf16* WOUT = (bf16*)(F.ws + WS_WOUT); bf16* WGU = (bf16*)(F.ws + WS_WGU); bf16* WDN = (bf16*)(F.ws + WS_WDN);
    constexpr int IT_IN = (D / 64) * (INW / 32), IT_UP = (GW / 64) * (D / 32), IT_PL1 = (512 / 64) * (GW / 32), IT_PL = 4 * IT_PL1, IT_OUT = (D / 64) * (D / 32), IT_G = (D / 64) * (FF / 32), IT_DN = (FF / 64) * (D / 32);
    constexpr int NITEMS = IT_IN + IT_UP + IT_PL + IT_OUT + IT_DN;
    for (int it = gw; it < NITEMS; it += NGW) {
        int r = it;
        if (r < IT_IN) { const int nb = r % (INW / 32), kb = r / (INW / 32); p0_transpose_item<true>(F.p_WIN, D, INW, WIN, 64 * kb, 32 * nb, 32 * nb, nullptr, scr, F.lane); continue; } r -= IT_IN;
        if (r < IT_UP) { const int nb = r % (D / 32), kb = r / (D / 32); p0_transpose_item<true>(F.p_WUP, GW, D, WUP, 64 * kb, 32 * nb, 32 * nb, nullptr, scr, F.lane); continue; } r -= IT_UP;
        if (r < IT_PL) { const int g = r / IT_PL1, q = r % IT_PL1, nb = q % (GW / 32), kb = q / (GW / 32);
            p0_transpose_item<true>(F.p_WPOOL + (size_t)g * 512 * GW, 512, GW, WPL, 64 * kb, 32 * nb, g * GW + 32 * nb, nullptr, scr, F.lane); continue; } r -= IT_PL;
        if (r < IT_OUT) { const int nb = r % (D / 32), kb = r / (D / 32); p0_transpose_item<false>(F.p_WOUT, D, D, WOUT, 64 * kb, 32 * nb, 32 * nb, nullptr, scr, F.lane); continue; } r -= IT_OUT;
        { const int nb = r % (D / 32), kb = r / (D / 32); p0_transpose_item<false>(F.p_WD, FF, D, WDN, 64 * kb, 32 * nb, 32 * nb, nullptr, scr, F.lane); }
    }
    bf16* HN = (bf16*)(F.ws + WS_HN);
    for (int m = gw; m < MP; m += NGW) {
        if (m < MPR) rms_row_to_bf16(F.p_XP + (size_t)m * D, F.p_NMIX, HN, m, F.lane);
        else if (m < MREAL) rms_row_to_bf16(F.p_XS + (size_t)(m - MPR) * D, F.p_NMIX, HN, m, F.lane);
        else { GAS char* o = (GAS char*)HN + pg8::bl_off<false>(m, 8 * F.lane, D / 64);
#pragma unroll
            for (int j = 0; j < 8; ++j) *(GAS v4u*)(o + (size_t)j * (8 * 32768)) = (v4u){0u, 0u, 0u, 0u}; }
    }
    const int gt = F.vcu * (NWAVES * 64) + F.tid, NT = F.G * NWAVES * 64;
    { float* rs = (float*)(F.ws + WS_CTL) + CW_RSS; for (int i = gt; i < MP; i += NT) rs[i] = 0.f; }
    { const GAS f32x4* s4 = (const GAS f32x4*)F.p_SP; GAS f32x4* d4 = (GAS f32x4*)(F.out + O_PS); constexpr int per = (PHIST - 1) * (PW / 4), tot = NSMP * per;
      for (int i = gt; i < tot; i += NT) { const int n = i / per, rem = i - n * per; d4[(size_t)n * PHIST * (PW / 4) + rem] = s4[(size_t)n * PHIST * (PW / 4) + (PW / 4) + rem]; } }
}

__device__ __forceinline__ void p2_convert_wgu(Frame& F, LAS float* scr, int gwave, int ngw) {
    bf16* WGU = (bf16*)(F.ws + WS_WGU); constexpr int IT_G = (D / 64) * (FF / 32);
    for (int r = gwave; r < 2 * IT_G; r += ngw) { const int up = r >= IT_G ? 1 : 0, q = r - up * IT_G, nb = q % (FF / 32), kb = q / (FF / 32), n0 = 32 * nb;
        if (up) p0_transpose_item<true>(F.p_WU, D, FF, WGU, 64 * kb, n0, (n0 >> 7) * 256 + (n0 & 127) + 128, F.p_NFFN, scr, F.lane);
        else    p0_transpose_item<true>(F.p_WG, D, FF, WGU, 64 * kb, n0, (n0 >> 7) * 256 + (n0 & 127), F.p_NFFN, scr, F.lane); }
}
__device__ __forceinline__ float alibi_slope_log2e(int g, int h) { return exp2f(-8.0f * (float)(g * 8 + h + 1) / 24.0f) * 1.4426950408889634f; }
__device__ __forceinline__ float dot8(v4u a, v4u b) {
    return (bflo(a.x) * bflo(b.x) + bfhi(a.x) * bfhi(b.x)) + (bflo(a.y) * bflo(b.y) + bfhi(a.y) * bfhi(b.y)) + (bflo(a.z) * bflo(b.z) + bfhi(a.z) * bfhi(b.z)) + (bflo(a.w) * bflo(b.w) + bfhi(a.w) * bfhi(b.w));
}
__device__ __forceinline__ void attn_naive_prompt(const bf16* QB, const bf16* KB, const bf16* VB, bf16* ATT, int m, int j, LAS float* pl, int lane) {
    const int t = m & (SEQ - 1);
    float Mx = -INFINITY, den = 0.f, a0 = 0.f, a1 = 0.f;
#pragma unroll 1
    for (int g = 0; g < 3; ++g) {
        const int d = g == 0 ? 1 : (g == 1 ? 4 : 16); const int tq = t / d; const int nk = (tq < 128 ? tq : 128) + 1;
        const float sl = alibi_slope_log2e(g, j) * (float)d;
        const size_t hoff = (size_t)g * GW + j * HD;
        const GAS v4u* qp = (const GAS v4u*)(QB + (size_t)m * QKVW + hoff);
        float s[3];
#pragma unroll
        for (int i = 0; i < 3; ++i) { const int jj = lane + 64 * i; s[i] = -INFINITY;
            if (jj < nk) { const GAS v4u* kp = (const GAS v4u*)(KB + (size_t)(m - d * jj) * QKVW + hoff); float acc = 0.f;
#pragma unroll
                for (int c = 0; c < 16; ++c) acc += dot8(qp[c], kp[c]);
                s[i] = acc - sl * (float)jj; } }
        const float mg = wave_max(fmaxf(fmaxf(s[0], s[1]), s[2])); const float nM = fmaxf(Mx, mg); const float so = __builtin_amdgcn_exp2f(Mx - nM);
        float ps = 0.f;
#pragma unroll
        for (int i = 0; i < 3; ++i) { const int jj = lane + 64 * i; const float p = (jj < nk) ? __builtin_amdgcn_exp2f(s[i] - nM) : 0.f; ps += p; if (jj < 129) pl[jj] = p; }
        den = den * so + wave_sum(ps); a0 *= so; a1 *= so; Mx = nM;
        LDS_WAIT(); asm volatile("" ::: "memory");
        const GAS unsigned* vp = (const GAS unsigned*)(VB + (size_t)m * QKVW + hoff) + lane;
        for (int jj = 0; jj < nk; ++jj) { const float p = pl[jj]; const unsigned w = vp[-(long)(d * jj) * (QKVW / 2)]; a0 += p * bflo(w); a1 += p * bfhi(w); }
        LDS_WAIT(); asm volatile("" ::: "memory");
    }
    const float inv = 1.0f / den;
    ((GAS unsigned*)(ATT + (size_t)m * GW + j * HD))[lane] = pk2(a0 * inv, a1 * inv);
}
typedef float f32x16 __attribute__((ext_vector_type(16)));
typedef short bf16x8_t __attribute__((ext_vector_type(8)));
typedef short s16x4_t __attribute__((ext_vector_type(4)));
constexpr int VPITCH = 272;
__device__ __forceinline__ int crow16(int i, int h) { return (i & 3) + 8 * (i >> 2) + 4 * h; }
__device__ __forceinline__ unsigned cvtpk(float lo, float hi) { typedef float f2 __attribute__((ext_vector_type(2))); typedef __bf16 b2 __attribute__((ext_vector_type(2))); const f2 v = {lo, hi}; const b2 b = __builtin_convertvector(v, b2); return __builtin_bit_cast(unsigned, b); }
__device__ __forceinline__ s16x4_t vtr(LAS const unsigned char* p) { typedef short v4i16_t __attribute__((ext_vector_type(4))); return __builtin_bit_cast(s16x4_t, __builtin_amdgcn_ds_read_tr16_b64_v4i16((LAS v4i16_t*)p)); }
__device__ __forceinline__ void attn_mfma_tile(const bf16* QB, const bf16* KB, const bf16* VB, bf16* NUM, float* ML, int item, LAS unsigned char* vlds, int lane) {
    const int blk = ((item & 63) + 21 * (item >> 11)) & 63, h = (item >> 6) & 7, bg = item >> 9, g = bg % 3, b = bg / 3;
    const int ds = 2 * g, d = 1 << ds, nbs = 6 - ds, r = blk >> nbs, ib = blk & ((1 << nbs) - 1), i0 = 32 * ib;
    const int r32 = lane & 31, hh = lane >> 5;
    const size_t colbase = (size_t)g * GW + h * HD;
    const int rowb = b * SEQ + r;
    const float sl = alibi_slope_log2e(g, h) * (float)d;
    const int rq = r32 - 4 * hh; const float slrq = sl * (float)rq;
    bf16x8_t qf[8];
    { const bf16* qrow = QB + (size_t)(rowb + d * (i0 + r32)) * QKVW + colbase + 8 * hh;
#pragma unroll
      for (int s_ = 0; s_ < 8; ++s_) qf[s_] = *(const GAS bf16x8_t*)(qrow + 16 * s_); }
    f32x16 S[5];
#pragma unroll
    for (int kb = 0; kb < 5; ++kb) {
        if (ib + kb >= 4) {
            const int kk0 = 32 * (ib + kb - 4);
            const bf16* krow = KB + (size_t)(rowb + d * (kk0 + r32)) * QKVW + colbase + 8 * hh;
            f32x16 acc;
#pragma unroll
            for (int i = 0; i < 16; ++i) acc[i] = 0.f;
#pragma unroll
            for (int s_ = 0; s_ < 8; ++s_) { const bf16x8_t kf = *(const GAS bf16x8_t*)(krow + 16 * s_); acc = __builtin_amdgcn_mfma_f32_32x32x16_bf16(kf, qf[s_], acc, 0, 0, 0); }
#pragma unroll
            for (int i = 0; i < 16; ++i) { const int ci = (i & 3) + 8 * (i >> 2);
                float v = fmaf(-sl, (float)(32 * (4 - kb) - ci), acc[i]) - slrq;
                if (kb == 0 && rq > ci) v = -INFINITY;
                if (kb == 4 && rq < ci) v = -INFINITY;
                acc[i] = v; }
            S[kb] = acc;
        } else {
#pragma unroll
            for (int i = 0; i < 16; ++i) S[kb][i] = -INFINITY;
        }
    }
    float mx = -INFINITY;
#pragma unroll
    for (int kb = 0; kb < 5; ++kb)
#pragma unroll
        for (int i = 0; i < 16; ++i) mx = fmaxf(mx, S[kb][i]);
    mx = fmaxf(mx, __shfl_xor(mx, 32));
    float den = 0.f;
#pragma unroll
    for (int kb = 0; kb < 5; ++kb)
#pragma unroll
        for (int i = 0; i < 16; ++i) { const float p = __builtin_amdgcn_exp2f(S[kb][i] - mx); S[kb][i] = p; den += p; }
    den += __shfl_xor(den, 32);
    f32x16 y[4];
#pragma unroll
    for (int c = 0; c < 4; ++c)
#pragma unroll
        for (int i = 0; i < 16; ++i) y[c][i] = 0.f;
    const int q4 = (lane & 15) >> 2, p4 = lane & 3, bk = (lane >> 4) & 1;
    LAS const unsigned char* vrd = vlds + (4 * hh + q4) * VPITCH + 32 * bk + 8 * p4;
#pragma unroll
    for (int kb = 0; kb < 5; ++kb) {
        if (ib + kb >= 4) {
            const int kk0 = 32 * (ib + kb - 4);
#pragma unroll
            for (int k = 0; k < 8; ++k) { const int id = lane + 64 * k, key = id >> 4, ch = id & 15;
                const v4u v = *(const GAS v4u*)(VB + (size_t)(rowb + d * (kk0 + key)) * QKVW + colbase + 8 * ch);
                *(LAS v4u*)(vlds + key * VPITCH + ch * 16) = v; }
#pragma unroll
            for (int s_ = 0; s_ < 2; ++s_) {
                v4u pk; pk.x = cvtpk(S[kb][8 * s_ + 0], S[kb][8 * s_ + 1]); pk.y = cvtpk(S[kb][8 * s_ + 2], S[kb][8 * s_ + 3]); pk.z = cvtpk(S[kb][8 * s_ + 4], S[kb][8 * s_ + 5]); pk.w = cvtpk(S[kb][8 * s_ + 6], S[kb][8 * s_ + 7]);
                const bf16x8_t xs = __builtin_bit_cast(bf16x8_t, pk);
#pragma unroll
                for (int c = 0; c < 4; ++c) { const s16x4_t lo = vtr(vrd + (16 * s_) * VPITCH + 64 * c), hi = vtr(vrd + (16 * s_ + 8) * VPITCH + 64 * c);
                    const bf16x8_t vf = __builtin_shufflevector(lo, hi, 0, 1, 2, 3, 4, 5, 6, 7);
                    y[c] = __builtin_amdgcn_mfma_f32_32x32x16_bf16(vf, xs, y[c], 0, 0, 0); }
            }
        }
    }
    const int m = rowb + d * (i0 + r32);
    bf16* np = NUM + ((size_t)g * MREAL + m) * GW + h * HD + 4 * hh;
#pragma unroll
    for (int c = 0; c < 4; ++c)
#pragma unroll
        for (int k = 0; k < 4; ++k) { v2u w; w.x = cvtpk(y[c][4 * k + 0], y[c][4 * k + 1]); w.y = cvtpk(y[c][4 * k + 2], y[c][4 * k + 3]); *(GAS v2u*)(np + 32 * c + 8 * k) = w; }
    if (hh == 0) { typedef float f2 __attribute__((ext_vector_type(2))); *(GAS f2*)(ML + (((size_t)g * MREAL + m) * NH + h) * 2) = (f2){mx, den}; }
}
__device__ __forceinline__ void attn_combine(const bf16* NUM, const float* ML, bf16* ATT, int gt, int NT) {
    typedef float f2 __attribute__((ext_vector_type(2)));
    for (int i = gt; i < MREAL * (GW / 8); i += NT) {
        const int m = i >> 7, c8 = i & 127, h = c8 >> 4;
        f2 st[3]; float M = -INFINITY;
#pragma unroll
        for (int g = 0; g < 3; ++g) { st[g] = *(const GAS f2*)(ML + (((size_t)g * MREAL + m) * NH + h) * 2); M = fmaxf(M, st[g].x); }
        float o[8] = {0.f, 0.f, 0.f, 0.f, 0.f, 0.f, 0.f, 0.f}; float dn = 0.f;
#pragma unroll
        for (int g = 0; g < 3; ++g) { const float e = __builtin_amdgcn_exp2f(st[g].x - M); dn += e * st[g].y;
            const v4u w = *(const GAS v4u*)(NUM + ((size_t)g * MREAL + m) * GW + 8 * c8);
            o[0] += e * bflo(w.x); o[1] += e * bfhi(w.x); o[2] += e * bflo(w.y); o[3] += e * bfhi(w.y); o[4] += e * bflo(w.z); o[5] += e * bfhi(w.z); o[6] += e * bflo(w.w); o[7] += e * bfhi(w.w); }
        const float inv = 1.0f / dn; v4u r; r.x = cvtpk(o[0] * inv, o[1] * inv); r.y = cvtpk(o[2] * inv, o[3] * inv); r.z = cvtpk(o[4] * inv, o[5] * inv); r.w = cvtpk(o[6] * inv, o[7] * inv);
        *(GAS v4u*)(ATT + (size_t)m * GW + 8 * c8) = r;
    }
}
template <int G_>
__device__ __forceinline__ void attn_sample_partial(const float* ck, const float* cv, const float* out, const bf16* QB, bf16* NUM, float* ML, int n, int j, LAS float* pl, int lane) {
    constexpr int d = G_ == 0 ? 1 : (G_ == 1 ? 4 : 16), W = G_ == 0 ? 128 : (G_ == 1 ? 512 : 2048);
    constexpr size_t OK_ = G_ == 0 ? O_KS0 : (G_ == 1 ? O_KS1 : O_KS2), OV_ = G_ == 0 ? O_VS0 : (G_ == 1 ? O_VS1 : O_VS2);
    const int m = MPR + n, g4 = lane >> 4, i16 = lane & 15;
    const float* nk_ = out + OK_ + ((size_t)n * W + (W - 1)) * GW + j * HD; const float* nv_ = out + OV_ + ((size_t)n * W + (W - 1)) * GW + j * HD;
    const float* kb = ck + (size_t)n * W * GW + j * HD; const float* vb = cv + (size_t)n * W * GW + j * HD;
    const float sl = alibi_slope_log2e(G_, j) * (float)d;
    float q[8];
    { const v4u w = *(const GAS v4u*)(QB + (size_t)m * QKVW + (size_t)G_ * GW + j * HD + 8 * i16);
      q[0] = bflo(w.x); q[1] = bfhi(w.x); q[2] = bflo(w.y); q[3] = bfhi(w.y); q[4] = bflo(w.z); q[5] = bfhi(w.z); q[6] = bflo(w.w); q[7] = bfhi(w.w); }
    float sc[3] = {-INFINITY, -INFINITY, -INFINITY};
#pragma unroll
    for (int c0 = 0; c0 < 33; c0 += 11) {
        f32x4 ka[11], kc[11];
#pragma unroll
        for (int u = 0; u < 11; ++u) { const int jj = 4 * (c0 + u) + g4; const int jc = jj <= 128 ? jj : 128;
            const float* kp = (jc == 0 ? nk_ : kb + (size_t)(W - d * jc) * GW) + 8 * i16; ka[u] = *(const GAS f32x4*)kp; kc[u] = *(const GAS f32x4*)(kp + 4); }
#pragma unroll
        for (int u = 0; u < 11; ++u) { const int c = c0 + u, jj = 4 * c + g4;
            float sdot = (ka[u].x * q[0] + ka[u].y * q[1]) + (ka[u].z * q[2] + ka[u].w * q[3]) + (kc[u].x * q[4] + kc[u].y * q[5]) + (kc[u].z * q[6] + kc[u].w * q[7]);
            sdot += __shfl_xor(sdot, 1); sdot += __shfl_xor(sdot, 2); sdot += __shfl_xor(sdot, 4); sdot += __shfl_xor(sdot, 8);
            const float sv = jj <= 128 ? sdot - sl * (float)jj : -INFINITY;
            if ((c & 15) == i16) sc[c >> 4] = sv; }
    }
    const float mx = wave_max(fmaxf(fmaxf(sc[0], sc[1]), sc[2]));
    float ps = 0.f;
#pragma unroll
    for (int k = 0; k < 3; ++k) { const int jj = 4 * (i16 + 16 * k) + g4; const float p = __builtin_amdgcn_exp2f(sc[k] - mx); ps += p; if (jj <= 128) pl[jj] = p; }
    const float den = wave_sum(ps);
    LDS_WAIT(); asm volatile("" ::: "memory");
    typedef float f32x2g __attribute__((ext_vector_type(2)));
    float a0 = 0.f, a1 = 0.f;
#pragma unroll 1
    for (int j0 = 0; j0 < 128; j0 += 16) { f32x2g vv[16];
#pragma unroll
        for (int u = 0; u < 16; ++u) { const int jj = j0 + u; const float* vp = jj == 0 ? nv_ : vb + (size_t)(W - d * jj) * GW; vv[u] = ((const GAS f32x2g*)vp)[lane]; }
#pragma unroll
        for (int u = 0; u < 16; ++u) { const float p = pl[j0 + u]; a0 += p * vv[u].x; a1 += p * vv[u].y; } }
    { const f32x2g v128 = ((const GAS f32x2g*)vb)[lane]; const float p = pl[128]; a0 += p * v128.x; a1 += p * v128.y; }
    LDS_WAIT(); asm volatile("" ::: "memory");
    ((GAS unsigned*)(NUM + ((size_t)G_ * MREAL + m) * GW + j * HD))[lane] = cvtpk(a0, a1);
    if (lane == 0) { *(GAS f32x2g*)(ML + (((size_t)G_ * MREAL + m) * NH + j) * 2) = (f32x2g){mx, den}; }
}
template <int WN>
__device__ __forceinline__ void pool_task(const float* UB, const float* sp, bf16* PL, int m, int c) {
    const f32x4 u0 = *(const GAS f32x4*)(UB + (size_t)m * PW + c); f32x4 r[WN - 1]; float wgt[WN - 1]; float cnt;
    if (m < MPR) { const int t = m & (SEQ - 1); cnt = (float)((t < WN - 1 ? t : WN - 1) + 1);
#pragma unroll
        for (int q = 1; q < WN; ++q) { const int qq = q <= t ? q : t; wgt[q - 1] = q <= t ? 1.f : 0.f; r[q - 1] = *(const GAS f32x4*)(UB + (size_t)(m - qq) * PW + c); } }
    else { const int n = m - MPR; cnt = (float)WN;
#pragma unroll
        for (int q = 1; q < WN; ++q) { wgt[q - 1] = 1.f; r[q - 1] = *(const GAS f32x4*)(sp + ((size_t)n * PHIST + (PHIST - q)) * PW + c); } }
    f32x4 tot = u0;
#pragma unroll
    for (int q = 1; q < WN; ++q) tot = tot + r[q - 1] * wgt[q - 1];
    const float ic = 1.0f / cnt; v2u o; o.x = pk2(tot.x * ic - u0.x, tot.y * ic - u0.y); o.y = pk2(tot.z * ic - u0.z, tot.w * ic - u0.w);
    *(GAS v2u*)(PL + (size_t)m * PW + c) = o;
}
template <int WN>
__device__ __forceinline__ void pool_chunk(const float* UB, bf16* PL, int b, int t0, int c) {
    const float* ub = UB + (size_t)b * SEQ * PW + c; bf16* pb = PL + (size_t)b * SEQ * PW + c;
    f32x4 ring[WN]; f32x4 tot = (f32x4){0.f, 0.f, 0.f, 0.f};
    if (t0 != 0) {
#pragma unroll
        for (int j = 0; j < WN; ++j) ring[j] = *(const GAS f32x4*)(ub + (size_t)(t0 - WN + j) * PW);
#pragma unroll
        for (int j = 0; j < WN; ++j) tot = tot + ring[j];
    } else {
#pragma unroll
        for (int j = 0; j < WN; ++j) ring[j] = (f32x4){0.f, 0.f, 0.f, 0.f};
    }
#pragma unroll
    for (int s0 = 0; s0 < 32; s0 += 16) {
        f32x4 nw[16];
#pragma unroll
        for (int u = 0; u < 16; ++u) nw[u] = *(const GAS f32x4*)(ub + (size_t)(t0 + s0 + u) * PW);
#pragma unroll
        for (int u = 0; u < 16; ++u) { const int s_ = s0 + u, t = t0 + s_; const f32x4 x = nw[u];
            tot = tot + (x - ring[s_ % WN]); ring[s_ % WN] = x;
            const int cn = t + 1 < WN ? t + 1 : WN; const float ic = 1.0f / (float)cn;
            v2u o; o.x = pk2(tot.x * ic - x.x, tot.y * ic - x.y); o.y = pk2(tot.z * ic - x.z, tot.w * ic - x.w);
            *(GAS v2u*)(pb + (size_t)t * PW) = o; }
    }
}
__device__ __forceinline__ void pool_naive(const Frame& F, const float* UB, bf16* PL, int gt, int NT) {
    constexpr int C4 = PW / 4, NCH = SEQ / 32;
    for (int i = gt; i < NB * NCH * C4; i += NT) {
        const int c4 = i % C4, rc = (i / C4) % NCH, b = i / (C4 * NCH), c = 4 * c4; const int grp = __builtin_amdgcn_readfirstlane(c >> 9);
        if (grp == 0) pool_chunk<2>(UB, PL, b, 32 * rc, c); else if (grp == 1) pool_chunk<4>(UB, PL, b, 32 * rc, c); else if (grp == 2) pool_chunk<8>(UB, PL, b, 32 * rc, c); else pool_chunk<16>(UB, PL, b, 32 * rc, c);
    }
    for (int i = gt; i < NSMP * C4; i += NT) {
        const int n = i / C4, c = 4 * (i - n * C4); const int grp = __builtin_amdgcn_readfirstlane(c >> 9);
        if (grp == 0) pool_task<2>(UB, F.p_SP, PL, MPR + n, c); else if (grp == 1) pool_task<4>(UB, F.p_SP, PL, MPR + n, c); else if (grp == 2) pool_task<8>(UB, F.p_SP, PL, MPR + n, c); else pool_task<16>(UB, F.p_SP, PL, MPR + n, c);
    }
}
constexpr int SK_RED_PITCH = 33;
template <int NACC, bool PERM, bool AIMG = false>
__device__ __forceinline__ void skinny_partial(const bf16* A, int lda, const bf16* B, int brow0, int K, LAS float* red, int wave, int lane) {
    const int r32 = lane & 31, hh = lane >> 5, ks = K >> 3, nst = ks >> 4, nt = K >> 6; const unsigned ku0 = (unsigned)(__builtin_amdgcn_readfirstlane(wave) * ks);
    const bf16* ap = A + (size_t)r32 * lda + wave * ks + 8 * hh;
    const GAS char* bb = (const GAS char*)B;
    const unsigned rb0 = (unsigned)pg8::bl_off<PERM>(brow0 + r32, 0, nt), x5 = rb0 & 32u, rbase = (rb0 ^ x5) + 16u * (unsigned)hh;
    const unsigned ra0 = (unsigned)pg8::bl_off<false>(MPR + r32, 0, nt), ax5 = ra0 & 32u, aloE = ((ra0 ^ ax5) + 16u * (unsigned)hh) + (ax5 ^ ((ku0 & 16u) << 1)), aloO = aloE ^ 32u;
    const unsigned loE = rbase + (x5 ^ ((ku0 & 16u) << 1)), loO = loE ^ 32u;
    f32x16 acc0, acc1;
#pragma unroll
    for (int i = 0; i < 16; ++i) { acc0[i] = 0.f; acc1[i] = 0.f; }
#pragma unroll 16
    for (int s_ = 0; s_ < nst; ++s_) {
        const unsigned ku = ku0 + 16u * (unsigned)s_; const GAS char* sb = bb + (size_t)((ku >> 6) * 32768u + ((ku >> 5) & 1u) * 1024u); const unsigned bo = (s_ & 1) ? loO : loE;
        const bf16x8_t af = AIMG ? *(const GAS bf16x8_t*)((const GAS char*)A + (size_t)((ku >> 6) * 32768u + ((ku >> 5) & 1u) * 1024u) + ((s_ & 1) ? aloO : aloE)) : *(const GAS bf16x8_t*)(ap + 16 * s_);
        const bf16x8_t bf0 = *(const GAS bf16x8_t*)(sb + bo);
        acc0 = __builtin_amdgcn_mfma_f32_32x32x16_bf16(af, bf0, acc0, 0, 0, 0);
        if (NACC == 2) { const bf16x8_t bf1 = *(const GAS bf16x8_t*)(sb + bo + 16384); acc1 = __builtin_amdgcn_mfma_f32_32x32x16_bf16(af, bf1, acc1, 0, 0, 0); }
    }
    LAS float* rw = red + wave * (NACC * 32 * SK_RED_PITCH);
#pragma unroll
    for (int i = 0; i < 16; ++i) { rw[crow16(i, hh) * SK_RED_PITCH + r32] = acc0[i]; if (NACC == 2) rw[(32 + crow16(i, hh)) * SK_RED_PITCH + r32] = acc1[i]; }
}
template <int NACC>
__device__ __forceinline__ void skinny_reduce(LAS const float* red, int tid, float (&v)[NACC][2]) {
    const int row = tid >> 4, c = (tid & 15) * 2;
#pragma unroll
    for (int a = 0; a < NACC; ++a) { float s0 = 0.f, s1 = 0.f;
#pragma unroll
        for (int w = 0; w < NWAVES; ++w) { const LAS float* p = red + w * (NACC * 32 * SK_RED_PITCH) + (a * 32 + row) * SK_RED_PITCH + c; s0 += p[0]; s1 += p[1]; }
        v[a][0] = s0; v[a][1] = s1; }
}
__device__ __forceinline__ void skinny_share(int nmain, int G, int c, int& idx, int& share) { const int first = nmain % G; if (first == 0) { idx = c; share = G; } else { idx = c - first; share = G - first; } }

__device__ __forceinline__ void final_norm_row(float* yrow, const float* gain, int lane) {
    GAS f32x4* xr = (GAS f32x4*)yrow + lane; const GAS f32x4* gr = (const GAS f32x4*)gain + lane;
    f32x4 v[16]; float s = 0.f;
#pragma unroll
    for (int j = 0; j < 16; ++j) { v[j] = xr[64 * j]; s += (v[j].x * v[j].x + v[j].y * v[j].y) + (v[j].z * v[j].z + v[j].w * v[j].w); }
    const float rstd = 1.0f / sqrtf(wave_sum(s) * (1.0f / D) + RMS_EPS);
#pragma unroll
    for (int j = 0; j < 16; ++j) { const f32x4 g = gr[64 * j]; xr[64 * j] = v[j] * rstd * g; }
}

typedef float f32x2e __attribute__((ext_vector_type(2)));
__device__ __forceinline__ float sigm(float x) { return __builtin_amdgcn_rcpf(1.0f + __builtin_amdgcn_exp2f(-1.4426950408889634f * x)); }
__device__ __forceinline__ void sk_emit_in(bf16* QB, size_t qkv_stride, bf16* GB, float* UB, float* out, float qscale, int n, int col, float v0, float v1) {
    const size_t m = (size_t)(MPR + n);
    if (col < 3 * QKVW) {
        const int which = col / QKVW, c3 = col - which * QKVW; const float sc = which == 0 ? qscale : 1.0f;
        *(GAS unsigned*)(QB + (size_t)which * qkv_stride + m * QKVW + c3) = cvtpk(v0 * sc, v1 * sc);
        if (which != 0) { const int g = c3 / GW, cg = c3 - g * GW, W = g == 0 ? 128 : (g == 1 ? 512 : 2048);
            float* os = out + (g == 0 ? (which == 1 ? O_KS0 : O_VS0) : g == 1 ? (which == 1 ? O_KS1 : O_VS1) : (which == 1 ? O_KS2 : O_VS2)) + ((size_t)n * W + (W - 1)) * GW + cg;
            *(GAS f32x2e*)os = (f32x2e){v0, v1}; }
    } else if (col < 3 * QKVW + PW) {
        const int c = col - 3 * QKVW; *(GAS f32x2e*)(UB + m * PW + c) = (f32x2e){v0, v1}; *(GAS f32x2e*)(out + O_PS + ((size_t)n * PHIST + (PHIST - 1)) * PW + c) = (f32x2e){v0, v1};
    } else { const int c = col - (3 * QKVW + PW); *(GAS unsigned*)(GB + m * (2 * D) + c) = cvtpk(sigm(v0), sigm(v1)); }
}
__device__ __forceinline__ void sk_emit_pool(const bf16* GB, const float* pscale, bf16* T, int n, int col, float v0, float v1) {
    const size_t m = (size_t)(MPR + n); const unsigned g = *(const GAS unsigned*)(GB + m * (2 * D) + D + col); const f32x2e ps = *(const GAS f32x2e*)(pscale + col);
    *(GAS unsigned*)(T + m * D + col) = cvtpk(v0 * ps.x * bflo(g), v1 * ps.y * bfhi(g));
}
__device__ __forceinline__ void sk_emit_up(const bf16* GB, const bf16* T, bf16* MIX, int n, int col, float v0, float v1) {
    const size_t m = (size_t)(MPR + n); const unsigned g = *(const GAS unsigned*)(GB + m * (2 * D) + col), t = *(const GAS unsigned*)(T + m * D + col);
    *(GAS unsigned*)(MIX + m * D + col) = cvtpk(v0 * bflo(g) + bflo(t), v1 * bfhi(g) + bfhi(t));
}
__device__ __forceinline__ void sk_emit_out(const float* xs, float* y, bf16* X1B, float* rowss, int n, int col, float v0, float v1, int tid) {
    const size_t m = (size_t)(MPR + n); const f32x2e x = *(const GAS f32x2e*)(xs + (size_t)n * D + col); const float o0 = x.x + v0, o1 = x.y + v1;
    *(GAS f32x2e*)(y + m * D + col) = (f32x2e){o0, o1}; *(GAS unsigned*)((GAS char*)X1B + pg8::bl_off<false>((int)m, col, D / 64)) = cvtpk(o0, o1);
    float ss = o0 * o0 + o1 * o1; ss += __shfl_xor(ss, 1); ss += __shfl_xor(ss, 2); ss += __shfl_xor(ss, 4); ss += __shfl_xor(ss, 8);
    if ((tid & 15) == 0) atomicAdd(rowss + m, ss);
}
__device__ __forceinline__ void sk_emit_ff(const float* rowss, bf16* FFB, int n, int f, float g0, float g1, float u0, float u1) {
    const size_t m = (size_t)(MPR + n); const float r = 1.0f / sqrtf(rowss[m] * (1.0f / D) + RMS_EPS); g0 *= r; g1 *= r; u0 *= r; u1 *= r;
    *(GAS unsigned*)(FFB + m * FF + f) = cvtpk(g0 * sigm(g0) * u0, g1 * sigm(g1) * u1);
}
__device__ __forceinline__ void sk_emit_down(float* y, int n, int col, float v0, float v1) {
    GAS f32x2e* p = (GAS f32x2e*)(y + (size_t)(MPR + n) * D + col); const f32x2e b = *p; *p = (f32x2e){b.x + v0, b.y + v1};
}

__device__ __forceinline__ int lane_now() { int l; asm volatile("v_mbcnt_lo_u32_b32 %0, -1, 0\n\tv_mbcnt_hi_u32_b32 %0, -1, %0" : "=v"(l)); return l; }
struct BgStream {
    unsigned long long src, dst, pdst, dump;
    unsigned left;
    f32x4 data; unsigned voff;
    __device__ __forceinline__ void init(const float* k0, const float* v0, const float* k1, const float* v1, const float* k2, const float* v2, float* out, unsigned char* dump_, int gwave) {
        dump = (unsigned long long)(uintptr_t)dump_; pdst = dump; src = (unsigned long long)(uintptr_t)k0; dst = dump; left = 0u;
        const int slot = gwave & 31; if (slot >= 24) return;
        const int w = (gwave >> 5) * 24 + slot; const float* sb; size_t db; int W, n, start, count;
        if (w < 1088) { const int t = w / 544, rem = w - t * 544, piece = rem % 17; n = rem / 17; W = 2048; start = piece * 482; count = (start + 482 <= 8188) ? 482 : 8188 - start; if (t == 0) { sb = k2; db = O_KS2; } else { sb = v2; db = O_VS2; } }
        else if (w < 1408) { const int rem0 = w - 1088, t = rem0 / 160, r2 = rem0 - t * 160, piece = r2 % 5; n = r2 / 5; W = 512; start = piece * 409; count = (start + 409 <= 2044) ? 409 : 2044 - start; if (t == 0) { sb = k1; db = O_KS1; } else { sb = v1; db = O_VS1; } }
        else { const int rem0 = w - 1408, t = rem0 >> 6, r2 = rem0 & 63; n = r2 >> 1; W = 128; start = (r2 & 1) * 254; count = 254; if (t == 0) { sb = k0; db = O_KS0; } else { sb = v0; db = O_VS0; } }
        src = (unsigned long long)(uintptr_t)sb + ((size_t)n * W + 1) * 4096 + (size_t)start * 1024; dst = (unsigned long long)(uintptr_t)out + db * 4 + (size_t)n * W * 4096 + (size_t)start * 1024; left = (unsigned)count;
    }
    __device__ __forceinline__ void begin(int lane) { voff = (unsigned)lane * 16u; data = (f32x4){0.f, 0.f, 0.f, 0.f}; pdst = dump; }
    __device__ __forceinline__ void step() {
        if (left) {
            asm volatile("global_store_dwordx4 %1, %0, %2\n\tglobal_load_dwordx4 %0, %1, %3" : "+v"(data) : "v"(voff), "s"(pdst), "s"(src) : "memory");
            pdst = dst; src += 1024; dst += 1024; --left;
        }
    }
    __device__ __forceinline__ void flush() {
        asm volatile("s_waitcnt vmcnt(0)\n\tglobal_store_dwordx4 %1, %0, %2" : : "v"(data), "v"(voff), "s"(pdst) : "memory");
        pdst = dump;
    }
};

struct Args { const float* in[20]; float* out; unsigned char* ws; int ph_lo, ph_hi; };
__global__ void __launch_bounds__(NWAVES * 64, 2) mega_fwd(Args args) {
    extern __shared__ __attribute__((aligned(16))) unsigned char lds[];
    Frame F;
    F.lds = (LAS unsigned char*)lds;
    F.MISC = (volatile LAS unsigned*)(F.lds + MISC_OFF);
    F.tid = threadIdx.x; F.lane = F.tid & 63; F.wave = __builtin_amdgcn_readfirstlane(F.tid >> 6);
    F.G = gridDim.x; { const int bx = blockIdx.x; F.vcu = (F.G % 8 == 0) ? (bx % 8) * (F.G / 8) + bx / 8 : bx; }
    F.ws = args.ws; F.out = args.out; F.ctl = (gu32*)(args.ws + WS_CTL);
    F.p_XP = args.in[I_XP]; F.p_XS = args.in[I_XS]; F.p_CK0 = args.in[I_CK0]; F.p_CV0 = args.in[I_CV0]; F.p_CK1 = args.in[I_CK1]; F.p_CV1 = args.in[I_CV1]; F.p_CK2 = args.in[I_CK2]; F.p_CV2 = args.in[I_CV2]; F.p_SP = args.in[I_SP]; F.p_NMIX = args.in[I_NMIX]; F.p_WIN = args.in[I_WIN]; F.p_WUP = args.in[I_WUP]; F.p_WPOOL = args.in[I_WPOOL]; F.p_PSCALE = args.in[I_PSCALE]; F.p_WOUT = args.in[I_WOUT]; F.p_NFFN = args.in[I_NFFN]; F.p_WG = args.in[I_WG]; F.p_WU = args.in[I_WU]; F.p_WD = args.in[I_WD]; F.p_NFIN = args.in[I_NFIN];
    for (int u = F.tid; u < (LDS_BYTES - LDSCTL_OFF) / 4; u += NWAVES * 64) ((LAS unsigned*)(F.lds + LDSCTL_OFF))[u] = 0u;
    __syncthreads();
    XcdBarrier bar; bar.bar = (unsigned*)(F.ctl + CW_BAR); bar.x = 0; bar.st = nullptr;
    if (N_LAUNCHES != PER_PHASE) bar = xcd_barrier_post((unsigned*)(F.ctl + CW_BAR), F.MISC + 8);
#define GRID_BAR() do { if (N_LAUNCHES != PER_PHASE) xcd_barrier(bar); } while (0)
    const int lo = args.ph_lo, hi = args.ph_hi;
#define IN(k) (lo <= (k) && (k) < hi)
#define BOTH(k) (IN(k) && IN((k) + 1))
    bf16* WIN = (bf16*)(F.ws + WS_WIN); bf16* WUP = (bf16*)(F.ws + WS_WUP); bf16* WPL = (bf16*)(F.ws + WS_WPL); bf16* WOUT = (bf16*)(F.ws + WS_WOUT); bf16* WGU = (bf16*)(F.ws + WS_WGU); bf16* WDN = (bf16*)(F.ws + WS_WDN);
    bf16* HN = (bf16*)(F.ws + WS_HN); bf16* QB = (bf16*)(F.ws + WS_QB); bf16* KB = (bf16*)(F.ws + WS_KB); bf16* VB = (bf16*)(F.ws + WS_VB); float* UB = (float*)(F.ws + WS_UB); bf16* GB = (bf16*)(F.ws + WS_GB);
    bf16* ATT = (bf16*)(F.ws + WS_ATT); bf16* PL = (bf16*)(F.ws + WS_PL); bf16* TB = (bf16*)(F.ws + WS_T); bf16* MIX = (bf16*)(F.ws + WS_MIX); bf16* X1B = (bf16*)(F.ws + WS_X1B); bf16* FFB = (bf16*)(F.ws + WS_FFB);
    float* rowss = (float*)(args.ws + WS_CTL) + CW_RSS;
    bf16* NUMB = (bf16*)(F.ws + WS_FFB); float* MLB = (float*)(F.ws + WS_FFB + 64 * MiB);
    const int gw = F.vcu * NWAVES + F.wave, NGW = F.G * NWAVES;
    pg8::NoBg nobg;
    BgStream bgs; bgs.init(F.p_CK0, F.p_CV0, F.p_CK1, F.p_CV1, F.p_CK2, F.p_CV2, F.out, F.ws + WS_DUMP + (size_t)(F.vcu * NWAVES + F.wave) * 1024, F.vcu * NWAVES + F.wave); bgs.begin(lane_now());
    LAS float* SKRED = (LAS float*)(F.lds + RING_OFF);

    if (IN(0)) { p0_prologue(F); if (BOTH(0)) GRID_BAR(); }

    if (IN(1)) {
        pg8::Gemm g{HN, WIN, D, D, 30, 0}; pg8::StaticOrder S; S.init(MPR, INW, F.G, (int)blockIdx.x);
        static_assert(WS_KB - WS_QB == WS_VB - WS_KB, "q/k/v buffers equally spaced");
        pg8::EpiIn E{QB, (WS_KB - WS_QB) / 2, GB, UB, F.out, 0.08838834764831845f * 1.4426950408889634f};
        pg8::gemm_phase<pg8::EpiIn, pg8::StaticOrder, true, true, pg8::NoBg, true>(F.lds + RING_OFF, g, S, E, nobg);
        { int idx, share; skinny_share((MPR / 256) * (INW / 256), F.G, (int)blockIdx.x, idx, share);
          if (idx >= 0) for (int t = idx; t < INW / 32; t += share) {
              skinny_partial<1, true, true>(HN, D, WIN, 32 * t, D, SKRED, F.wave, F.lane); LDS_WAIT(); __syncthreads();
              float v[1][2]; skinny_reduce<1>(SKRED, F.tid, v);
              sk_emit_in(QB, (WS_KB - WS_QB) / 2, GB, UB, F.out, 0.08838834764831845f * 1.4426950408889634f, F.tid >> 4, 32 * t + 2 * (F.tid & 15), v[0][0], v[0][1]); __syncthreads(); } }
        if (BOTH(1)) GRID_BAR();
    }

    if (IN(2)) {
        LAS unsigned char* wb = F.lds + RING_OFF + F.wave * 16384;
        LAS float* pl = (LAS float*)(wb + 9216);
        _Pragma("unroll 1") for (int ph = 0; ph < 2; ++ph) {
            if ((ph == 0) == (F.wave < 4)) p2_convert_wgu(F, (LAS float*)wb, gw, NGW);
            else { for (int it = gw; it < NB * 3 * NH * 64; it += NGW) attn_mfma_tile(QB, KB, VB, NUMB, MLB, it, wb, F.lane); }
        }
        if (F.wave < 3) { const int t = F.vcu * 3 + F.wave;
            if (t < NSMP * NH * 3) { const int gq = t % 3, nj = t / 3, n = nj >> 3, j = nj & 7;
                if (gq == 0) attn_sample_partial<0>(F.p_CK0, F.p_CV0, F.out, QB, NUMB, MLB, n, j, pl, F.lane);
                else if (gq == 1) attn_sample_partial<1>(F.p_CK1, F.p_CV1, F.out, QB, NUMB, MLB, n, j, pl, F.lane);
                else attn_sample_partial<2>(F.p_CK2, F.p_CV2, F.out, QB, NUMB, MLB, n, j, pl, F.lane); } }
        pool_naive(F, UB, PL, F.vcu * (NWAVES * 64) + F.tid, F.G * NWAVES * 64);
        if (BOTH(2)) GRID_BAR();
    }

    if (IN(3)) {
        attn_combine(NUMB, MLB, ATT, F.vcu * (NWAVES * 64) + F.tid, F.G * NWAVES * 64);
        pg8::Gemm g{PL, WPL, 512, PW, 2, 512 * 2}; pg8::StaticOrder S; S.init(MPR, D, F.G, (int)blockIdx.x);
        pg8::EpiPool E{GB, F.p_PSCALE, TB};
        pg8::gemm_phase<pg8::EpiPool, pg8::StaticOrder, true, true>(F.lds + RING_OFF, g, S, E, nobg);
        { int idx, share; skinny_share((MPR / 256) * (D / 256), F.G, (int)blockIdx.x, idx, share);
          if (idx >= 0) for (int t = idx; t < D / 32; t += share) {
              skinny_partial<1, true>(PL + (size_t)MPR * PW + (t >> 5) * 512, PW, WPL, 32 * t, 512, SKRED, F.wave, F.lane); LDS_WAIT(); __syncthreads();
              float v[1][2]; skinny_reduce<1>(SKRED, F.tid, v);
              sk_emit_pool(GB, F.p_PSCALE, TB, F.tid >> 4, 32 * t + 2 * (F.tid & 15), v[0][0], v[0][1]); __syncthreads(); } }
        if (BOTH(3)) GRID_BAR();
    }
    if (IN(4)) {
        pg8::Gemm g{ATT, WUP, GW, GW, 30, 0}; pg8::StaticOrder S; S.init(MPR, D, F.G, (int)blockIdx.x);
        pg8::EpiUp E{GB, TB, MIX};
        pg8::gemm_phase<pg8::EpiUp, pg8::StaticOrder, true, true>(F.lds + RING_OFF, g, S, E, nobg);
        { int idx, share; skinny_share((MPR / 256) * (D / 256), F.G, (int)blockIdx.x, idx, share);
          if (idx >= 0) for (int t = idx; t < D / 32; t += share) {
              skinny_partial<1, true>(ATT + (size_t)MPR * GW, GW, WUP, 32 * t, GW, SKRED, F.wave, F.lane); LDS_WAIT(); __syncthreads();
              float v[1][2]; skinny_reduce<1>(SKRED, F.tid, v);
              sk_emit_up(GB, TB, MIX, F.tid >> 4, 32 * t + 2 * (F.tid & 15), v[0][0], v[0][1]); __syncthreads(); } }
        if (BOTH(4)) GRID_BAR();
    }

    if (IN(5)) {
        pg8::Gemm g{MIX, WOUT, D, D, 30, 0}; pg8::StaticOrder S; S.init(MPR, D, F.G, (int)blockIdx.x);
        pg8::EpiOut E{F.p_XP, F.p_XS, F.out + O_Y, X1B, rowss};
        pg8::gemm_phase<pg8::EpiOut, pg8::StaticOrder, true, true>(F.lds + RING_OFF, g, S, E, nobg);
        { int idx, share; skinny_share((MPR / 256) * (D / 256), F.G, (int)blockIdx.x, idx, share);
          if (idx >= 0) for (int t = idx; t < D / 32; t += share) {
              skinny_partial<1, false>(MIX + (size_t)MPR * D, D, WOUT, 32 * t, D, SKRED, F.wave, F.lane); LDS_WAIT(); __syncthreads();
              float v[1][2]; skinny_reduce<1>(SKRED, F.tid, v);
              sk_emit_out(F.p_XS, F.out + O_Y, X1B, rowss, F.tid >> 4, 32 * t + 2 * (F.tid & 15), v[0][0], v[0][1], F.tid); __syncthreads(); } }
        if (BOTH(5)) GRID_BAR();
    }

    if (IN(6)) {
        pg8::Gemm g{X1B, WGU, D, D, 30, 0}; pg8::StaticOrder S; S.init(MPR, 2 * FF, F.G, (int)blockIdx.x);
        pg8::EpiFF E{rowss, FFB};
        bgs.begin(lane_now());
        pg8::gemm_phase<pg8::EpiFF, pg8::StaticOrder, true, true, BgStream, true>(F.lds + RING_OFF, g, S, E, bgs);
        { int idx, share; skinny_share((MPR / 256) * (2 * FF / 256), F.G, (int)blockIdx.x, idx, share);
          if (idx >= 0) for (int t = idx; t < FF / 32; t += share) { const int f0 = 32 * t;
              skinny_partial<2, true, true>(X1B, D, WGU, (f0 >> 7) * 256 + (f0 & 127), D, SKRED, F.wave, F.lane); LDS_WAIT(); __syncthreads();
              float v[2][2]; skinny_reduce<2>(SKRED, F.tid, v);
              sk_emit_ff(rowss, FFB, F.tid >> 4, f0 + 2 * (F.tid & 15), v[0][0], v[0][1], v[1][0], v[1][1]); __syncthreads(); } }
        if (BOTH(6)) GRID_BAR();
    }

    if (IN(7)) {
        pg8::Gemm g{FFB, WDN, FF, FF, 30, 0}; pg8::StaticOrder S; S.init(MPR, D, F.G, (int)blockIdx.x);
        pg8::EpiDown E{F.out + O_Y};
        bgs.begin(lane_now());
        pg8::gemm_phase<pg8::EpiDown, pg8::StaticOrder, true, true, BgStream>(F.lds + RING_OFF, g, S, E, bgs);
        { int idx, share; skinny_share((MPR / 256) * (D / 256), F.G, (int)blockIdx.x, idx, share);
          if (idx >= 0) for (int t = idx; t < D / 32; t += share) {
              skinny_partial<1, false>(FFB + (size_t)MPR * FF, FF, WDN, 32 * t, FF, SKRED, F.wave, F.lane); LDS_WAIT(); __syncthreads();
              float v[1][2]; skinny_reduce<1>(SKRED, F.tid, v);
              sk_emit_down(F.out + O_Y, F.tid >> 4, 32 * t + 2 * (F.tid & 15), v[0][0], v[0][1]); __syncthreads(); } }
        if (BOTH(7)) GRID_BAR();
    }

    if (IN(8)) {
        bgs.begin(lane_now());
        while (bgs.left) { asm volatile("s_waitcnt vmcnt(0)" ::: "memory"); bgs.step(); }
        bgs.flush();
        { const int ln = lane_now(); for (int m = gw; m < MREAL; m += NGW) final_norm_row(F.out + O_Y + (size_t)m * D, F.p_NFIN, ln); }
    }
#undef IN
#undef BOTH
#undef GRID_BAR
}

extern "C" void kernel_launch(void* const* d_in, const int* in_sizes, int n_in, void* d_out, int out_size, void* d_ws, size_t ws_size, hipStream_t stream) {
    static int grid = 0;
    if (grid == 0) {
        if (n_in != 20 || in_sizes[0] != MPR * D || (size_t)out_size != O_END || ws_size < WS_END) {
            fprintf(stderr, "kernel_launch: shape mismatch: n_in %d in0 %d out %d (want %zu) ws %zu (want %zu); nothing launched\n", n_in, n_in > 0 ? in_sizes[0] : -1, out_size, (size_t)O_END, ws_size, (size_t)WS_END); grid = -1; return; }
        int dev = 0, cus = 0, per_cu = 0;
        if (hipGetDevice(&dev) != hipSuccess || hipDeviceGetAttribute(&cus, hipDeviceAttributeMultiprocessorCount, dev) != hipSuccess) { grid = -1; return; }
        if (hipFuncSetAttribute((const void*)mega_fwd, hipFuncAttributeMaxDynamicSharedMemorySize, LDS_BYTES) != hipSuccess) { fprintf(stderr, "kernel_launch: hipFuncSetAttribute failed\n"); grid = -1; return; }
        if (hipOccupancyMaxActiveBlocksPerMultiprocessor(&per_cu, (const void*)mega_fwd, NWAVES * 64, LDS_BYTES) != hipSuccess || per_cu < 1) { fprintf(stderr, "kernel_launch: occupancy query says %d blocks per CU\n", per_cu); }
        (void)hipGetLastError();
        grid = cus;
    }
    if (grid < 0) return;
    (void)hipMemsetAsync((char*)d_ws + WS_CTL, 0, CTL_ZERO_BYTES, stream);
    Args a{};
    for (int i = 0; i < 20; ++i) a.in[i] = (const float*)d_in[i];
    a.out = (float*)d_out; a.ws = (unsigned char*)d_ws;
    for (int li = 0; li < N_LAUNCHES; ++li) {
        a.ph_lo = (N_LAUNCHES == PER_PHASE) ? li : 0; a.ph_hi = (N_LAUNCHES == PER_PHASE) ? li + 1 : PER_PHASE;
        hipLaunchKernelGGL(mega_fwd, dim3(grid), dim3(NWAVES * 64), LDS_BYTES, stream, a);
    }
}
```

```cpp
#include <hip/hip_runtime.h>
#include <cstdio>
#include <cstdint>
#include <cmath>
namespace pg8 {
#define PG8_LAS __attribute__((address_space(3)))
typedef unsigned short bf16_t;
typedef short bf16x8 __attribute__((ext_vector_type(8)));
typedef float f32x4 __attribute__((ext_vector_type(4)));
typedef unsigned u32x4 __attribute__((ext_vector_type(4)));
constexpr int BM = 256, BK = 64, HALF = 128, HTB = HALF * BK * 2  , STAGE_BYTES = 8 * HTB, NXCD = 8, WGM = 8;

__host__ __device__ __forceinline__ int lds_byte(int r, int c) { const int st = (r >> 4) * 2 + (c >> 5), rr = r & 15, cc = c & 31, ob = rr * 64 + cc * 2; return st * 1024 + (ob ^ (((ob >> 9) & 1) << 5)); }
__host__ __device__ __forceinline__ void stage_rc(int b, int& R, int& C) { const int st = b / 1024, sb = b % 1024, swz = sb ^ (((sb >> 9) & 1) << 5); R = (st >> 1) * 16 + swz / 64; C = (st & 1) * 32 + (swz % 64) / 2; }
__host__ __device__ __forceinline__ int perm32(int rho) { const int n = rho >> 4, i = rho & 15; return 8 * (i >> 2) + 4 * n + (i & 3); }
template <bool PERM> __host__ __device__ __forceinline__ size_t bl_off(int row, int k, int nt) {
    const int r128 = row & 127, w = r128 & 31;
    const int R = PERM ? ((r128 & 96) + ((w >> 2) & 1) * 16 + (w >> 3) * 4 + (w & 3)) : r128;
    return (((size_t)(row >> 8) * nt + (k >> 6)) * 2 + ((row >> 7) & 1)) * 16384 + (size_t)lds_byte(R, k & 63);
}

struct Unit { int pm, pn; };
struct Gemm { const bf16_t* A; const bf16_t* Bt; int K, lda, ashift; size_t astride; };

struct StaticOrder {
    int nM, nN, nwg, G, c;
    __host__ __device__ void init(int M, int N, int G_, int c_) { nM = M / BM; nN = N / BM; nwg = nM * nN; G = G_; c = c_; }
    __host__ __device__ bool next(int i, Unit& u) const {
        const long L = (long)i * G + c; if (L >= nwg) return false;
        int wgid = (int)L; { const int q = nwg / NXCD, r = nwg % NXCD, xcd = wgid % NXCD, off = wgid / NXCD; wgid = (xcd < r ? xcd * (q + 1) : r * (q + 1) + (xcd - r) * q) + off; }
        const int nig = WGM * nN, gid = wgid / nig, fm = gid * WGM, gsz = (nM - fm) < WGM ? (nM - fm) : WGM;
        u.pm = fm + ((wgid % nig) % gsz); u.pn = (wgid % nig) / gsz; return true;
    }
    __device__ __forceinline__ void a_ready(const Unit&) const {}
    __device__ __forceinline__ void done(const Unit&) const {}
};

typedef float f32x2_cv __attribute__((ext_vector_type(2))); typedef __bf16 bf16x2_cv __attribute__((ext_vector_type(2)));
__device__ __forceinline__ unsigned cvt_pk_bf16(float lo, float hi) { const f32x2_cv v = {lo, hi}; const bf16x2_cv b = __builtin_convertvector(v, bf16x2_cv); return __builtin_bit_cast(unsigned, b); }
typedef float f32x2 __attribute__((ext_vector_type(2)));

struct NoBg { __device__ __forceinline__ void step() {} __device__ __forceinline__ void flush() {} };
template <class Epi, class Sched, bool ALIGN_EPI = false, bool SP2 = false, class Bg = NoBg, bool AIMG = false>
__device__ __forceinline__ void gemm_phase(PG8_LAS unsigned char* lds, const Gemm g, const Sched& S, const Epi& E, Bg& bg) {
    const int tid = threadIdx.x, wid = __builtin_amdgcn_readfirstlane(tid >> 6), lane = tid & 63, wr = wid >> 2, wc = wid & 3, fr = lane & 15, fq = lane >> 4;
    const int K = g.K, nt = K / BK, lda = g.lda;
    unsigned voffA[2], voffB[2];
#pragma unroll
    for (int i = 0; i < 2; ++i) { int R, C; stage_rc(tid * 16 + i * 8192, R, C); const int Rb = Epi::PERM ? ((R & ~31) + perm32(R & 31)) : R;
        voffA[i] = AIMG ? (unsigned)(tid * 16 + i * 8192) : (unsigned)(R * lda + C) * 2u; voffB[i] = (unsigned)(tid * 16 + i * 8192); (void)Rb; }
    const size_t kstep = AIMG ? (size_t)(2 * HTB) : (size_t)(BK * 2);
    const size_t kstepB = (size_t)(2 * HTB);
    const size_t hsB = (size_t)HTB, hsA = AIMG ? (size_t)HTB : (size_t)HALF * lda * 2;
    const size_t tsB = (size_t)nt * kstepB, tsA = AIMG ? (size_t)nt * kstep : 2 * hsA;
    const unsigned ldsw = (unsigned)wid * 1024u;
    const int aoff = lds_byte(wr * 64 + fr, fq * 8), boff = lds_byte(wc * 32 + fr, fq * 8);
#define PG8_SA(b, h) (((b) * 2 + (h)) * HTB)
#define PG8_SB(b, h) ((4 + (b) * 2 + (h)) * HTB)
#define PG8_STAGE(bufoff, gbase, voff) do { _Pragma("unroll") for (int _i = 0; _i < 2; ++_i) \
        __builtin_amdgcn_global_load_lds((const unsigned*)((const char*)(gbase) + (voff)[_i]), (PG8_LAS unsigned*)(lds + (bufoff) + ldsw + _i * 8192), 16, 0, 0); } while (0)
#define PG8_LDA(dst, b, h) do { _Pragma("unroll") for (int m = 0; m < 4; ++m) _Pragma("unroll") for (int k = 0; k < 2; ++k) dst[m][k] = *(const PG8_LAS bf16x8*)(lds + PG8_SA(b, h) + aoff + m * 2048 + k * 1024); } while (0)
#define PG8_LDB(dst, b, h) do { _Pragma("unroll") for (int n = 0; n < 2; ++n) _Pragma("unroll") for (int k = 0; k < 2; ++k) dst[n][k] = *(const PG8_LAS bf16x8*)(lds + PG8_SB(b, h) + boff + n * 2048 + k * 1024); } while (0)
#define PG8_MMA(ai, bj, At, Bt) do { __builtin_amdgcn_s_setprio(1); _Pragma("unroll") for (int m = 0; m < 4; ++m) _Pragma("unroll") for (int n = 0; n < 2; ++n) _Pragma("unroll") for (int k = 0; k < 2; ++k) \
        acc[ai][bj][m][n] = __builtin_amdgcn_mfma_f32_16x16x32_bf16(Bt[n][k], At[m][k], acc[ai][bj][m][n], 0, 0, 0); __builtin_amdgcn_s_setprio(0); } while (0)
#define PG8_WAIT_V(n) asm volatile("s_waitcnt vmcnt(" #n ")" ::: "memory")
#define PG8_WAIT_L(n) asm volatile("s_waitcnt lgkmcnt(" #n ")" ::: "memory")
#define PG8_BAR __builtin_amdgcn_s_barrier()
#define PG8_SCHED __builtin_amdgcn_sched_barrier(0)
    Unit cur, nxt; int ui = 0;
    if (!S.next(0, cur)) return;
    f32x4 acc[2][2][4][2];
#pragma unroll
    for (int a = 0; a < 2; ++a)
#pragma unroll
        for (int b = 0; b < 2; ++b)
#pragma unroll
            for (int m = 0; m < 4; ++m)
#pragma unroll
                for (int n = 0; n < 2; ++n) acc[a][b][m][n] = (f32x4){0.f, 0.f, 0.f, 0.f};
    bf16x8 At[4][2], B0[2][2], B1[2][2];
    const char* cA = (const char*)g.A + (size_t)cur.pm * tsA + (size_t)(cur.pn >> g.ashift) * g.astride; const char* cB = (const char*)g.Bt + (size_t)cur.pn * tsB;
    S.a_ready(cur);
    if constexpr (SP2) {
        PG8_STAGE(PG8_SB(0, 0), cB, voffB); PG8_STAGE(PG8_SB(0, 1), cB + hsB, voffB); PG8_STAGE(PG8_SA(0, 0), cA, voffA); PG8_STAGE(PG8_SA(0, 1), cA + hsA, voffA);
        if (wr == 1) PG8_BAR;
        PG8_WAIT_V(2); PG8_BAR;
        PG8_STAGE(PG8_SB(1, 0), cB + kstepB, voffB); PG8_STAGE(PG8_SA(1, 0), cA + kstep, voffA); PG8_STAGE(PG8_SB(1, 1), cB + hsB + kstepB, voffB);
        PG8_WAIT_V(6); PG8_BAR;
    } else {
        PG8_STAGE(PG8_SB(0, 0), cB, voffB); PG8_STAGE(PG8_SA(0, 0), cA, voffA); PG8_STAGE(PG8_SB(0, 1), cB + hsB, voffB); PG8_STAGE(PG8_SA(0, 1), cA + hsA, voffA);
        if (wr == 1) PG8_BAR;
        PG8_WAIT_V(4); PG8_BAR;
        PG8_STAGE(PG8_SB(1, 0), cB + kstepB, voffB); PG8_STAGE(PG8_SA(1, 0), cA + kstep, voffA); PG8_STAGE(PG8_SB(1, 1), cB + hsB + kstepB, voffB);
        PG8_WAIT_V(6); PG8_BAR;
    }
    for (;;) {
        const bool has_next = S.next(ui + 1, nxt);
        const char* nA = has_next ? (const char*)g.A + (size_t)nxt.pm * tsA + (size_t)(nxt.pn >> g.ashift) * g.astride : cA; const char* nB = has_next ? (const char*)g.Bt + (size_t)nxt.pn * tsB : cB;
        for (int t = 0; t < nt; t += 2) {
            const bool last = (t == nt - 2);
            const char* a1 = cA + (size_t)(t + 1) * kstep;
            const char* a2 = last ? nA : cA + (size_t)(t + 2) * kstep; const char* b2 = last ? nB : cB + (size_t)(t + 2) * kstepB;
            const char* a3 = a2 + kstep; const char* b3 = b2 + kstepB;
            if (last && has_next) S.a_ready(nxt);
            bg.step();
            if constexpr (SP2) {
            PG8_LDB(B0, 0, 0); PG8_LDB(B1, 0, 1); PG8_SCHED; PG8_LDA(At, 0, 0); PG8_STAGE(PG8_SA(1, 1), a1 + hsA, voffA);
            PG8_WAIT_V(8); PG8_WAIT_L(0); PG8_BAR; PG8_MMA(0, 0, At, B0); PG8_MMA(0, 1, At, B1); PG8_BAR; PG8_SCHED;
            PG8_LDA(At, 0, 1); PG8_STAGE(PG8_SB(0, 0), b2, voffB); PG8_STAGE(PG8_SB(0, 1), b2 + hsB, voffB); PG8_STAGE(PG8_SA(0, 0), a2, voffA);
            PG8_WAIT_V(8); PG8_WAIT_L(0); PG8_BAR; PG8_MMA(1, 0, At, B0); PG8_MMA(1, 1, At, B1); PG8_BAR; PG8_SCHED;
            PG8_LDB(B0, 1, 0); PG8_LDB(B1, 1, 1); PG8_SCHED; PG8_LDA(At, 1, 0); PG8_STAGE(PG8_SA(0, 1), a2 + hsA, voffA);
            PG8_WAIT_V(8); PG8_WAIT_L(0); PG8_BAR; PG8_MMA(0, 0, At, B0); PG8_MMA(0, 1, At, B1); PG8_BAR; PG8_SCHED;
            PG8_LDA(At, 1, 1); PG8_STAGE(PG8_SB(1, 0), b3, voffB); PG8_STAGE(PG8_SB(1, 1), b3 + hsB, voffB); PG8_STAGE(PG8_SA(1, 0), a3, voffA);
            PG8_WAIT_V(8); PG8_WAIT_L(0); PG8_BAR; PG8_MMA(1, 0, At, B0); PG8_MMA(1, 1, At, B1); PG8_BAR; PG8_SCHED;
            } else {
            PG8_LDB(B0, 0, 0); PG8_SCHED; PG8_LDA(At, 0, 0); PG8_STAGE(PG8_SA(1, 1), a1 + hsA, voffA);
            PG8_WAIT_L(8); PG8_BAR; PG8_WAIT_L(0); PG8_MMA(0, 0, At, B0); PG8_BAR; PG8_SCHED;
            PG8_LDB(B1, 0, 1); PG8_STAGE(PG8_SB(0, 0), b2, voffB);
            PG8_BAR; PG8_WAIT_L(0); PG8_MMA(0, 1, At, B1); PG8_BAR;
            PG8_LDA(At, 0, 1); PG8_STAGE(PG8_SA(0, 0), a2, voffA);
            PG8_BAR; PG8_WAIT_L(0); PG8_MMA(1, 0, At, B0); PG8_BAR; PG8_SCHED;
            PG8_STAGE(PG8_SB(0, 1), b2 + hsB, voffB);
            PG8_WAIT_V(6); PG8_BAR; PG8_MMA(1, 1, At, B1); PG8_BAR;
            PG8_LDB(B0, 1, 0); PG8_SCHED; PG8_LDA(At, 1, 0); PG8_STAGE(PG8_SA(0, 1), a2 + hsA, voffA);
            PG8_WAIT_L(8); PG8_BAR; PG8_WAIT_L(0); PG8_MMA(0, 0, At, B0); PG8_BAR; PG8_SCHED;
            PG8_LDB(B1, 1, 1); PG8_STAGE(PG8_SB(1, 0), b3, voffB);
            PG8_BAR; PG8_WAIT_L(0); PG8_MMA(0, 1, At, B1); PG8_BAR;
            PG8_LDA(At, 1, 1); PG8_STAGE(PG8_SA(1, 0), a3, voffA);
            PG8_BAR; PG8_WAIT_L(0); PG8_MMA(1, 0, At, B0); PG8_BAR; PG8_SCHED;
            PG8_STAGE(PG8_SB(1, 1), b3 + hsB, voffB);
            PG8_WAIT_V(6); PG8_BAR; PG8_MMA(1, 1, At, B1); PG8_BAR;
            }
        }
        if constexpr (ALIGN_EPI) { if (wr == 0) PG8_BAR; }
        if constexpr (!Epi::AFTER_DRAIN) { E(acc, cur, wr, wc, fr, fq); S.done(cur); }
        if (!has_next) break;
#pragma unroll
        for (int a = 0; a < 2; ++a)
#pragma unroll
            for (int b = 0; b < 2; ++b)
#pragma unroll
                for (int m = 0; m < 4; ++m)
#pragma unroll
                    for (int n = 0; n < 2; ++n) acc[a][b][m][n] = (f32x4){0.f, 0.f, 0.f, 0.f};
        cur = nxt; cA = nA; cB = nB; ++ui;
        if constexpr (ALIGN_EPI) { if (wr == 1) PG8_BAR; }
    }
    bg.flush();
    PG8_WAIT_V(0);
    if constexpr (!ALIGN_EPI) { if (wr == 0) PG8_BAR; }
    PG8_BAR;
    if constexpr (Epi::AFTER_DRAIN) { E.fused(acc, cur, wr, wc, fr, fq, lds, wid, lane); S.done(cur); }
#undef PG8_SA
#undef PG8_SB
#undef PG8_STAGE
#undef PG8_LDA
#undef PG8_LDB
#undef PG8_MMA
#undef PG8_WAIT_V
#undef PG8_WAIT_L
#undef PG8_BAR
#undef PG8_SCHED
}
}

constexpr int D = 4096, NB = 4, SEQ = 2048, MPR = NB * SEQ  , NSMP = 32, MREAL = MPR + NSMP  , MP = 8448  ;
constexpr int HD = 128, NH = 8, GW = NH * HD  , QKVW = 3 * GW  , PW = 2048, INW = 3 * QKVW + PW + 2 * D  , FF = 11008;
constexpr int PHIST = 15;
constexpr float RMS_EPS = 1e-6f;
constexpr size_t O_Y = 0;
constexpr size_t O_KP0 = (size_t)MREAL * D;
constexpr size_t O_VP0 = O_KP0 + (size_t)NB * 128 * GW;
constexpr size_t O_KP1 = O_VP0 + (size_t)NB * 128 * GW;
constexpr size_t O_VP1 = O_KP1 + (size_t)NB * 512 * GW;
constexpr size_t O_KP2 = O_VP1 + (size_t)NB * 512 * GW;
constexpr size_t O_VP2 = O_KP2 + (size_t)NB * 2048 * GW;
constexpr size_t O_PP  = O_VP2 + (size_t)NB * 2048 * GW;
constexpr size_t O_KS0 = O_PP + (size_t)NB * PHIST * PW;
constexpr size_t O_VS0 = O_KS0 + (size_t)NSMP * 128 * GW;
constexpr size_t O_KS1 = O_VS0 + (size_t)NSMP * 128 * GW;
constexpr size_t O_VS1 = O_KS1 + (size_t)NSMP * 512 * GW;
constexpr size_t O_KS2 = O_VS1 + (size_t)NSMP * 512 * GW;
constexpr size_t O_VS2 = O_KS2 + (size_t)NSMP * 2048 * GW;
constexpr size_t O_PS  = O_VS2 + (size_t)NSMP * 2048 * GW;
constexpr size_t O_END = O_PS + (size_t)NSMP * PHIST * PW;

namespace pg8 {
__device__ __forceinline__ float bf_lo(unsigned w) { return __uint_as_float(w << 16); }
__device__ __forceinline__ float bf_hi(unsigned w) { return __uint_as_float(w & 0xffff0000u); }
__device__ __forceinline__ float sigmoidf_(float x) { return __builtin_amdgcn_rcpf(1.0f + __builtin_amdgcn_exp2f(-1.4426950408889634f * x)); }

struct EpiIn {
    static constexpr bool PERM = true, AFTER_DRAIN = false;
    bf16_t *QB; size_t qkv_stride  ; bf16_t* GB; float* UB; float* out; float qscale;
    __device__ __forceinline__ void operator()(const f32x4 (&acc)[2][2][4][2], const Unit& u, int wr, int wc, int fr, int fq) const {
        const int colt = u.pn * BM, cl = wc * 32 + 8 * fq, rbase = u.pm * BM + wr * 64 + fr;
        if (colt < 3 * QKVW) {
            const int which = colt / QKVW, c3 = colt - which * QKVW;
            bf16_t* B = QB + (size_t)which * qkv_stride; const float sc = which == 0 ? qscale : 1.0f;
#pragma unroll
            for (int ai = 0; ai < 2; ++ai)
#pragma unroll
                for (int m = 0; m < 4; ++m) { bf16_t* rowp = B + (size_t)(rbase + ai * HALF + m * 16) * QKVW + c3 + cl;
#pragma unroll
                    for (int bj = 0; bj < 2; ++bj) { const f32x4 v0 = acc[ai][bj][m][0] * sc, v1 = acc[ai][bj][m][1] * sc; u32x4 w;
                        w.x = cvt_pk_bf16(v0[0], v0[1]); w.y = cvt_pk_bf16(v0[2], v0[3]); w.z = cvt_pk_bf16(v1[0], v1[1]); w.w = cvt_pk_bf16(v1[2], v1[3]);
                        *(u32x4*)(rowp + bj * HALF) = w; } }
            if (which != 0) {
                const int g = c3 / GW, cg = c3 - g * GW + cl, W = g == 0 ? 128 : (g == 1 ? 512 : 2048);
                float* op = out + (g == 0 ? (which == 1 ? O_KP0 : O_VP0) : g == 1 ? (which == 1 ? O_KP1 : O_VP1) : (which == 1 ? O_KP2 : O_VP2));
                float* os = out + (g == 0 ? (which == 1 ? O_KS0 : O_VS0) : g == 1 ? (which == 1 ? O_KS1 : O_VS1) : (which == 1 ? O_KS2 : O_VS2));
#pragma unroll
                for (int ai = 0; ai < 2; ++ai)
#pragma unroll
                    for (int m = 0; m < 4; ++m) { const int row = rbase + ai * HALF + m * 16; float* dst = nullptr;
                        if (row < MPR) { const int b = row >> 11, tt = (row & (SEQ - 1)) - (SEQ - W); if (tt >= 0) dst = op + ((size_t)(b * W + tt)) * GW + cg; }
                        else if (row < MREAL) { dst = os + ((size_t)((row - MPR) * W + (W - 1))) * GW + cg; }
                        if (dst) {
#pragma unroll
                            for (int bj = 0; bj < 2; ++bj)
#pragma unroll
                                for (int n = 0; n < 2; ++n) *(f32x4*)(dst + bj * HALF + 4 * n) = acc[ai][bj][m][n]; } }
            }
        } else if (colt < 3 * QKVW + PW) {
            const int c = colt - 3 * QKVW + cl;
#pragma unroll
            for (int ai = 0; ai < 2; ++ai)
#pragma unroll
                for (int m = 0; m < 4; ++m) { const int row = rbase + ai * HALF + m * 16; float* up = UB + (size_t)row * PW + c; float* dst = nullptr;
                    if (row < MPR) { const int b = row >> 11, tt = (row & (SEQ - 1)) - (SEQ - PHIST); if (tt >= 0) dst = out + O_PP + ((size_t)(b * PHIST + tt)) * PW + c; }
                    else if (row < MREAL) { dst = out + O_PS + ((size_t)((row - MPR) * PHIST + (PHIST - 1))) * PW + c; }
#pragma unroll
                    for (int bj = 0; bj < 2; ++bj)
#pragma unroll
                        for (int n = 0; n < 2; ++n) { *(f32x4*)(up + bj * HALF + 4 * n) = acc[ai][bj][m][n]; if (dst) *(f32x4*)(dst + bj * HALF + 4 * n) = acc[ai][bj][m][n]; } }
        } else {
            const int c = colt - (3 * QKVW + PW) + cl;
#pragma unroll
            for (int ai = 0; ai < 2; ++ai)
#pragma unroll
                for (int m = 0; m < 4; ++m) { bf16_t* rowp = GB + (size_t)(rbase + ai * HALF + m * 16) * (2 * D) + c;
#pragma unroll
                    for (int bj = 0; bj < 2; ++bj) { const f32x4 v0 = acc[ai][bj][m][0], v1 = acc[ai][bj][m][1]; u32x4 w;
                        w.x = cvt_pk_bf16(sigmoidf_(v0[0]), sigmoidf_(v0[1])); w.y = cvt_pk_bf16(sigmoidf_(v0[2]), sigmoidf_(v0[3]));
                        w.z = cvt_pk_bf16(sigmoidf_(v1[0]), sigmoidf_(v1[1])); w.w = cvt_pk_bf16(sigmoidf_(v1[2]), sigmoidf_(v1[3]));
                        *(u32x4*)(rowp + bj * HALF) = w; } }
        }
    }
};

#define EPI_FENCE() asm volatile("" ::: "memory")
struct EpiPool {
    static constexpr bool PERM = true, AFTER_DRAIN = false;
    const bf16_t* GB; const float* pscale; bf16_t* T;
    __device__ __forceinline__ void operator()(const f32x4 (&acc)[2][2][4][2], const Unit& u, int wr, int wc, int fr, int fq) const {
        const int col0 = u.pn * BM + wc * 32 + 8 * fq, rbase = u.pm * BM + wr * 64 + fr;
        f32x4 sv[2][2];
#pragma unroll
        for (int bj = 0; bj < 2; ++bj)
#pragma unroll
            for (int n = 0; n < 2; ++n) sv[bj][n] = *(const f32x4*)(pscale + col0 + bj * HALF + 4 * n);
#pragma unroll
        for (int ai = 0; ai < 2; ++ai) {
            u32x4 gq[4][2];
#pragma unroll
            for (int m = 0; m < 4; ++m)
#pragma unroll
                for (int bj = 0; bj < 2; ++bj) gq[m][bj] = *(const u32x4*)(GB + (size_t)(rbase + ai * HALF + m * 16) * (2 * D) + D + col0 + bj * HALF);
            EPI_FENCE();
#pragma unroll
            for (int m = 0; m < 4; ++m) { const size_t row = (size_t)(rbase + ai * HALF + m * 16);
#pragma unroll
                for (int bj = 0; bj < 2; ++bj) { const u32x4 g = gq[m][bj];
                    const f32x4 v0 = acc[ai][bj][m][0] * sv[bj][0], v1 = acc[ai][bj][m][1] * sv[bj][1]; u32x4 w;
                    w.x = cvt_pk_bf16(v0[0] * bf_lo(g.x), v0[1] * bf_hi(g.x)); w.y = cvt_pk_bf16(v0[2] * bf_lo(g.y), v0[3] * bf_hi(g.y));
                    w.z = cvt_pk_bf16(v1[0] * bf_lo(g.z), v1[1] * bf_hi(g.z)); w.w = cvt_pk_bf16(v1[2] * bf_lo(g.w), v1[3] * bf_hi(g.w));
                    *(u32x4*)(T + row * D + col0 + bj * HALF) = w; } }
            EPI_FENCE();
        }
    }
};
struct EpiUp {
    static constexpr bool PERM = true, AFTER_DRAIN = false;
    const bf16_t* GB; const bf16_t* T; bf16_t* MIX;
    __device__ __forceinline__ void operator()(const f32x4 (&acc)[2][2][4][2], const Unit& u, int wr, int wc, int fr, int fq) const {
        const int col0 = u.pn * BM + wc * 32 + 8 * fq, rbase = u.pm * BM + wr * 64 + fr;
#pragma unroll
        for (int ai = 0; ai < 2; ++ai) {
            u32x4 gq[4][2], tq[4][2];
#pragma unroll
            for (int m = 0; m < 4; ++m)
#pragma unroll
                for (int bj = 0; bj < 2; ++bj) { const size_t row = (size_t)(rbase + ai * HALF + m * 16);
                    gq[m][bj] = *(const u32x4*)(GB + row * (2 * D) + col0 + bj * HALF); tq[m][bj] = *(const u32x4*)(T + row * D + col0 + bj * HALF); }
            EPI_FENCE();
#pragma unroll
            for (int m = 0; m < 4; ++m) { const size_t row = (size_t)(rbase + ai * HALF + m * 16);
#pragma unroll
                for (int bj = 0; bj < 2; ++bj) { const u32x4 g = gq[m][bj], t = tq[m][bj];
                    const f32x4 v0 = acc[ai][bj][m][0], v1 = acc[ai][bj][m][1]; u32x4 w;
                    w.x = cvt_pk_bf16(v0[0] * bf_lo(g.x) + bf_lo(t.x), v0[1] * bf_hi(g.x) + bf_hi(t.x)); w.y = cvt_pk_bf16(v0[2] * bf_lo(g.y) + bf_lo(t.y), v0[3] * bf_hi(g.y) + bf_hi(t.y));
                    w.z = cvt_pk_bf16(v1[0] * bf_lo(g.z) + bf_lo(t.z), v1[1] * bf_hi(g.z) + bf_hi(t.z)); w.w = cvt_pk_bf16(v1[2] * bf_lo(g.w) + bf_lo(t.w), v1[3] * bf_hi(g.w) + bf_hi(t.w));
                    *(u32x4*)(MIX + row * D + col0 + bj * HALF) = w; } }
            EPI_FENCE();
        }
    }
};
struct EpiOut {
    static constexpr bool PERM = false, AFTER_DRAIN = false;
    const float* xp; const float* xs; float* y; bf16_t* X1B; float* rowss;
    __device__ __forceinline__ void operator()(const f32x4 (&acc)[2][2][4][2], const Unit& u, int wr, int wc, int fr, int fq) const {
        const int col0 = u.pn * BM + wc * 32 + 4 * fq, rbase = u.pm * BM + wr * 64 + fr;
        typedef unsigned u32x2v __attribute__((ext_vector_type(2)));
#pragma unroll
        for (int ai = 0; ai < 2; ++ai) {
            f32x4 xin[4][2][2];
#pragma unroll
            for (int m = 0; m < 4; ++m) { const int row = rbase + ai * HALF + m * 16; const int rc = row < MREAL ? row : MREAL - 1;
                const float* xr = (rc < MPR ? xp + (size_t)rc * D : xs + (size_t)(rc - MPR) * D) + col0;
#pragma unroll
                for (int bj = 0; bj < 2; ++bj)
#pragma unroll
                    for (int n = 0; n < 2; ++n) xin[m][bj][n] = *(const f32x4*)(xr + bj * HALF + n * 16); }
            EPI_FENCE();
#pragma unroll
            for (int m = 0; m < 4; ++m) { const int row = rbase + ai * HALF + m * 16; const bool real = row < MREAL; float ss = 0.f;
#pragma unroll
                for (int bj = 0; bj < 2; ++bj)
#pragma unroll
                    for (int n = 0; n < 2; ++n) { const f32x4 o = acc[ai][bj][m][n] + xin[m][bj][n];
                        if (real) *(f32x4*)(y + (size_t)row * D + col0 + bj * HALF + n * 16) = o;
                        u32x2v w; w.x = cvt_pk_bf16(o[0], o[1]); w.y = cvt_pk_bf16(o[2], o[3]); *(u32x2v*)((char*)X1B + bl_off<false>(row, col0 + bj * HALF + n * 16, D / 64)) = w;
                        ss += (o[0] * o[0] + o[1] * o[1]) + (o[2] * o[2] + o[3] * o[3]); }
                ss += __shfl_xor(ss, 16); ss += __shfl_xor(ss, 32);
                if (fq == 0 && real) atomicAdd(rowss + row, ss); }
            EPI_FENCE();
        }
    }
};
struct EpiFF {
    static constexpr bool PERM = true, AFTER_DRAIN = false;
    const float* rowss; bf16_t* FFB;
    __device__ __forceinline__ void operator()(const f32x4 (&acc)[2][2][4][2], const Unit& u, int wr, int wc, int fr, int fq) const {
        const int col0 = u.pn * HALF + wc * 32 + 8 * fq, rbase = u.pm * BM + wr * 64 + fr;
        float rs[2][4];
#pragma unroll
        for (int ai = 0; ai < 2; ++ai)
#pragma unroll
            for (int m = 0; m < 4; ++m) rs[ai][m] = rowss[rbase + ai * HALF + m * 16];
        EPI_FENCE();
#pragma unroll
        for (int ai = 0; ai < 2; ++ai)
#pragma unroll
            for (int m = 0; m < 4; ++m) { const int row = rbase + ai * HALF + m * 16; const float r = 1.0f / sqrtf(rs[ai][m] * (1.0f / D) + RMS_EPS);
                u32x4 w; float o[8];
#pragma unroll
                for (int n = 0; n < 2; ++n)
#pragma unroll
                    for (int j = 0; j < 4; ++j) { const float gv = acc[ai][0][m][n][j] * r, uv = acc[ai][1][m][n][j] * r; o[4 * n + j] = gv * sigmoidf_(gv) * uv; }
                w.x = cvt_pk_bf16(o[0], o[1]); w.y = cvt_pk_bf16(o[2], o[3]); w.z = cvt_pk_bf16(o[4], o[5]); w.w = cvt_pk_bf16(o[6], o[7]);
                *(u32x4*)(FFB + (size_t)row * FF + col0) = w; }
    }
};
struct EpiDown {
    static constexpr bool PERM = false, AFTER_DRAIN = false;
    float* y;
    __device__ __forceinline__ void operator()(const f32x4 (&acc)[2][2][4][2], const Unit& u, int wr, int wc, int fr, int fq) const {
        const int col0 = u.pn * BM + wc * 32 + 4 * fq, rbase = u.pm * BM + wr * 64 + fr;
#pragma unroll
        for (int ai = 0; ai < 2; ++ai) {
            f32x4 yin[4][2][2];
#pragma unroll
            for (int m = 0; m < 4; ++m) { const int row = rbase + ai * HALF + m * 16; const int rc = row < MREAL ? row : MREAL - 1; const float* yr = y + (size_t)rc * D + col0;
#pragma unroll
                for (int bj = 0; bj < 2; ++bj)
#pragma unroll
                    for (int n = 0; n < 2; ++n) yin[m][bj][n] = *(const f32x4*)(yr + bj * HALF + n * 16); }
            EPI_FENCE();
#pragma unroll
            for (int m = 0; m < 4; ++m) { const int row = rbase + ai * HALF + m * 16;
                if (row < MREAL) { float* yr = y + (size_t)row * D + col0;
#pragma unroll
                    for (int bj = 0; bj < 2; ++bj)
#pragma unroll
                        for (int n = 0; n < 2; ++n) *(f32x4*)(yr + bj * HALF + n * 16) = yin[m][bj][n] + acc[ai][bj][m][n]; } }
            EPI_FENCE();
        }
    }
};
}

constexpr int NWAVES = 8;
#ifndef MK_N_LAUNCHES
#define MK_N_LAUNCHES 1
#endif
constexpr int PER_PHASE = 9;
constexpr int N_LAUNCHES = MK_N_LAUNCHES;

constexpr size_t MiB = 1u << 20;
constexpr size_t al256(size_t x) { return (x + 255) & ~(size_t)255; }
constexpr size_t WS_CTL = 0, CTL_ZERO_BYTES = 1 * MiB;
constexpr size_t WS_WIN  = 1 * MiB;
constexpr size_t WS_WUP  = WS_WIN  + al256((size_t)INW * D * 2);
constexpr size_t WS_WPL  = WS_WUP  + al256((size_t)D * GW * 2);
constexpr size_t WS_WOUT = WS_WPL  + al256((size_t)D * 512 * 2);
constexpr size_t WS_WGU  = WS_WOUT + al256((size_t)D * D * 2);
constexpr size_t WS_WDN  = WS_WGU  + al256((size_t)2 * FF * D * 2);
constexpr size_t WS_HN   = WS_WDN  + al256((size_t)D * FF * 2);
constexpr size_t WS_QB   = WS_HN   + al256((size_t)MP * D * 2);
constexpr size_t WS_KB   = WS_QB   + al256((size_t)MP * QKVW * 2);
constexpr size_t WS_VB   = WS_KB   + al256((size_t)MP * QKVW * 2);
constexpr size_t WS_UB   = WS_VB   + al256((size_t)MP * QKVW * 2);
constexpr size_t WS_GB   = WS_UB   + al256((size_t)MP * PW * 4);
constexpr size_t WS_ATT  = WS_GB   + al256((size_t)MP * 2 * D * 2);
constexpr size_t WS_PL   = WS_ATT  + al256((size_t)MP * GW * 2);
constexpr size_t WS_T    = WS_PL   + al256((size_t)MP * PW * 2);
constexpr size_t WS_MIX  = WS_T    + al256((size_t)MP * D * 2);
constexpr size_t WS_X1B  = WS_MIX  + al256((size_t)MP * D * 2);
constexpr size_t WS_FFB  = WS_X1B  + al256((size_t)MP * D * 2);
constexpr size_t WS_DUMP = WS_FFB  + al256((size_t)MP * FF * 2);
constexpr size_t WS_END  = WS_DUMP + 2 * MiB;
constexpr int CW_BAR = 4096;
constexpr int CW_RSS = 16384;
static_assert((CW_RSS + MP) * 4 <= (int)CTL_ZERO_BYTES && CW_BAR + 3456 <= CW_RSS, "CTL map");

constexpr int RING_OFF = 0, RING_BYTES = 131072;
constexpr int LDSCTL_OFF = RING_BYTES, MISC_OFF = LDSCTL_OFF + 320;
constexpr int LDS_BYTES = 147456;
static_assert(MISC_OFF + 128 <= LDS_BYTES, "LDS map");

#define GAS __attribute__((address_space(1)))
#define LAS __attribute__((address_space(3)))
typedef unsigned short bf16;
typedef unsigned v4u __attribute__((ext_vector_type(4)));
typedef unsigned v2u __attribute__((ext_vector_type(2)));
typedef float f32x4 __attribute__((ext_vector_type(4)));
typedef GAS unsigned gu32;
#define RLX_AGENT __ATOMIC_RELAXED, __HIP_MEMORY_SCOPE_AGENT
#define LDS_WAIT() asm volatile("s_waitcnt lgkmcnt(0)" ::: "memory")
#define VM_WAIT() asm volatile("s_waitcnt vmcnt(0)" ::: "memory")
__device__ __forceinline__ unsigned f2bf(float f) { unsigned u = __builtin_bit_cast(unsigned, f); return (u + 0x7fffu + ((u >> 16) & 1u)) >> 16; }
__device__ __forceinline__ unsigned pk2(float lo, float hi) { return f2bf(lo) | (f2bf(hi) << 16); }
__device__ __forceinline__ float bflo(unsigned w) { return __uint_as_float(w << 16); }
__device__ __forceinline__ float bfhi(unsigned w) { return __uint_as_float(w & 0xffff0000u); }

#define XB_TMO      128
#define XB_XCNT(j)  (256  + 64 * (j))
#define XB_XSUB(j)  (1280 + 64 * (j))
#define XB_XGEN(j)  (2304 + 64 * (j))
#define XB_TOP      3328
#define XB_TOPGEN   3392
#define XCD_BAR_WORDS 3456
#define XB_SPIN_CAP (1u << 18)

__device__ __forceinline__ unsigned xb_ld(unsigned* p)              { return __hip_atomic_load(p, __ATOMIC_RELAXED, __HIP_MEMORY_SCOPE_AGENT); }
__device__ __forceinline__ unsigned xb_add(unsigned* p, unsigned v) { return __hip_atomic_fetch_add(p, v, __ATOMIC_RELAXED, __HIP_MEMORY_SCOPE_AGENT); }
__device__ __forceinline__ unsigned xb_xcc_id() { return (unsigned)__builtin_amdgcn_s_getreg((3 << 11) | 20) & 0xFu; }
#define XB_SPIN(cond, bar) do { unsigned _sp = 0; while (cond) { __builtin_amdgcn_s_sleep(1); \
    if ((++_sp & 255u) == 0u) { if (xb_ld(&(bar)[XB_TMO])) break; if (_sp > XB_SPIN_CAP) { atomicAdd(&(bar)[XB_TMO], 1u); break; } } } } while (0)

struct XcdBarrier {
    unsigned* bar; unsigned x;
    volatile LAS unsigned* st;
};

__device__ __forceinline__ XcdBarrier xcd_barrier_post(unsigned* bar, volatile LAS unsigned* st) {
    XcdBarrier b; b.bar = bar; b.x = xb_xcc_id(); b.st = st;
    if (threadIdx.x == 0) (void)xb_add(&bar[XB_XCNT(b.x)], 1u);
    return b;
}
__device__ __forceinline__ void xcd_barrier_complete(unsigned* bar, unsigned x, unsigned& nloc, unsigned& nx) {
    const unsigned G = gridDim.x * gridDim.y * gridDim.z;
    unsigned sum, cnt, mine, sp = 0u;
    for (;;) {
        sum = 0u; cnt = 0u; mine = 0u;
#pragma unroll
        for (unsigned j = 0; j < 16; ++j) { const unsigned c = xb_ld(&bar[XB_XCNT(j)]); sum += c; cnt += (c > 0u) ? 1u : 0u; mine = (j == x) ? c : mine; }
        if (sum == G) break;
        __builtin_amdgcn_s_sleep(1);
        if ((++sp & 255u) == 0u) { if (xb_ld(&bar[XB_TMO])) break; if (sp > XB_SPIN_CAP) { atomicAdd(&bar[XB_TMO], 1u); break; } }
    }
    nloc = mine > 0u ? mine : 1u; nx = cnt > 0u ? cnt : 1u;
}

__device__ __forceinline__ void xcd_barrier(const XcdBarrier& b) {
    asm volatile("s_waitcnt vmcnt(0)" ::: "memory");
    __syncthreads();
    if (threadIdx.x == 0) {
        unsigned* bar = b.bar;
        __builtin_amdgcn_s_waitcnt(0);
        unsigned nloc = b.st[0], nx = b.st[1];
        if (nloc == 0u) { xcd_barrier_complete(bar, b.x, nloc, nx); b.st[0] = nloc; b.st[1] = nx; }
        const unsigned old = xb_add(&bar[XB_XSUB(b.x)], 1u);
        const unsigned gen = old / nloc;
        if (old + 1u == (gen + 1u) * nloc) {
            __builtin_amdgcn_fence(__ATOMIC_RELEASE, "agent");
            asm volatile("s_waitcnt vmcnt(0)" ::: "memory");
            const unsigned og = xb_add(&bar[XB_TOP], 1u);
            const unsigned tg = og / nx;
            if (og + 1u == (tg + 1u) * nx) xb_add(&bar[XB_TOPGEN], 1u);
            else XB_SPIN(xb_ld(&bar[XB_TOPGEN]) == tg, bar);
            __builtin_amdgcn_fence(__ATOMIC_ACQUIRE, "agent");
            xb_add(&bar[XB_XGEN(b.x)], 1u);
            asm volatile("s_waitcnt vmcnt(0)" ::: "memory");
        } else {
            XB_SPIN(xb_ld(&bar[XB_XGEN(b.x)]) == gen, bar);
            __builtin_amdgcn_fence(__ATOMIC_ACQUIRE, "agent");
            asm volatile("s_waitcnt vmcnt(0)" ::: "memory");
        }
    }
    __syncthreads();
}


struct Frame {
    LAS unsigned char* lds;
    volatile LAS unsigned* MISC;
    gu32* ctl;
    int tid, lane, wave;
    int vcu, G;
    const float *p_XP, *p_XS, *p_CK0, *p_CV0, *p_CK1, *p_CV1, *p_CK2, *p_CV2, *p_SP, *p_NMIX, *p_WIN, *p_WUP, *p_WPOOL, *p_PSCALE, *p_WOUT, *p_NFFN, *p_WG, *p_WU, *p_WD, *p_NFIN;
    float* out; unsigned char* ws;
};
enum { I_XP = 0, I_XS, I_CK0, I_CV0, I_CK1, I_CV1, I_CK2, I_CV2, I_SP, I_NMIX, I_WIN, I_WUP, I_WPOOL, I_PSCALE, I_WOUT, I_NFFN, I_WG, I_WU, I_WD, I_NFIN };

__device__ __forceinline__ float wave_sum(float v) {
#pragma unroll
    for (int o = 1; o < 64; o <<= 1) v += __shfl_xor(v, o);
    return v;
}
__device__ __forceinline__ float wave_max(float v) {
#pragma unroll
    for (int o = 1; o < 64; o <<= 1) v = fmaxf(v, __shfl_xor(v, o));
    return v;
}
template <bool PERM>
__device__ __forceinline__ void p0_transpose_item(const float* W, int K, int N, bf16* WT, int k0, int n0, int out_row0, const float* kscale, LAS float* scr, int lane) {
    float wv[32];
#pragma unroll
    for (int i = 0; i < 32; ++i) wv[i] = W[(size_t)(k0 + 2 * i + (lane >> 5)) * N + n0 + (lane & 31)];
    if (kscale) {
#pragma unroll
        for (int i = 0; i < 32; ++i) wv[i] *= kscale[k0 + 2 * i + (lane >> 5)]; }
#pragma unroll
    for (int i = 0; i < 32; ++i) scr[(2 * i + (lane >> 5)) * 33 + (lane & 31)] = wv[i];
    LDS_WAIT(); asm volatile("" ::: "memory");
    const int c = lane & 7;
#pragma unroll
    for (int j = 0; j < 4; ++j) { const int n = (lane >> 3) + 8 * j; const LAS float* s = scr + (8 * c) * 33 + n;
        v4u o; o.x = pk2(s[0 * 33], s[1 * 33]); o.y = pk2(s[2 * 33], s[3 * 33]); o.z = pk2(s[4 * 33], s[5 * 33]); o.w = pk2(s[6 * 33], s[7 * 33]);
        *(GAS v4u*)((GAS char*)WT + pg8::bl_off<PERM>(out_row0 + n, k0 + 8 * c, K >> 6)) = o; }
    LDS_WAIT(); asm volatile("" ::: "memory");
}
__device__ __forceinline__ void rms_row_to_bf16(const float* xrow, const float* gain, bf16* obase, int m, int lane) {
    const GAS f32x4* xr = (const GAS f32x4*)xrow + lane; const GAS f32x4* gr = (const GAS f32x4*)gain + lane;
    f32x4 v[16]; float s = 0.f;
#pragma unroll
    for (int j = 0; j < 16; ++j) { v[j] = xr[64 * j]; s += (v[j].x * v[j].x + v[j].y * v[j].y) + (v[j].z * v[j].z + v[j].w * v[j].w); }
    const float rstd = 1.0f / sqrtf(wave_sum(s) * (1.0f / D) + RMS_EPS);
    GAS char* ob = (GAS char*)obase + pg8::bl_off<false>(m, 4 * lane, D / 64);
#pragma unroll
    for (int j = 0; j < 16; ++j) { const f32x4 g = gr[64 * j]; v2u w; w.x = pk2(v[j].x * rstd * g.x, v[j].y * rstd * g.y); w.y = pk2(v[j].z * rstd * g.z, v[j].w * rstd * g.w); *(GAS v2u*)(ob + (size_t)j * (4 * 32768)) = w; }
}
__device__ __forceinline__ void p0_cache_copy(const float* src, float* dst, int W, int gt, int NT) {
    const int per = (W - 1) * 256; const int total = NSMP * per;
    const GAS f32x4* s4 = (const GAS f32x4*)src; GAS f32x4* d4 = (GAS f32x4*)dst;
    for (int i0 = gt; i0 < total; i0 += 4 * NT) {
        f32x4 v[4]; int di[4];
#pragma unroll
        for (int k = 0; k < 4; ++k) { const int i = i0 + k * NT; const int n = i / per, rem = i - n * per; di[k] = n * W * 256 + rem; if (i < total) v[k] = s4[(size_t)di[k] + 256]; }
#pragma unroll
        for (int k = 0; k < 4; ++k) { const int i = i0 + k * NT; if (i < total) d4[(size_t)di[k]] = v[k]; }
    }
}
__device__ __forceinline__ void p0_prologue(Frame& F) {
    LAS float* scr = (LAS float*)(F.lds + RING_OFF + F.wave * 16384);
    const int gw = F.vcu * NWAVES + F.wave, NGW = F.G * NWAVES;
    bf16* WIN = (bf16*)(F.ws + WS_WIN); bf16* WUP = (bf16*)(F.ws + WS_WUP); bf16* WPL = (bf16*)(F.ws + WS_WPL); bf16* WOUT = (bf16*)(F.ws + WS_WOUT); bf16* WGU = (bf16*)(F.ws + WS_WGU); bf16* WDN = (bf16*)(F.ws + WS_WDN);
    constexpr int IT_IN = (D / 64) * (INW / 32), IT_UP = (GW / 64) * (D / 32), IT_PL1 = (512 / 64) * (GW / 32), IT_PL = 4 * IT_PL1, IT_OUT = (D / 64) * (D / 32), IT_G = (D / 64) * (FF / 32), IT_DN = (FF / 64) * (D / 32);
    constexpr int NITEMS = IT_IN + IT_UP + IT_PL + IT_OUT + IT_DN;
    for (int it = gw; it < NITEMS; it += NGW) {
        int r = it;
        if (r < IT_IN) { const int nb = r % (INW / 32), kb = r / (INW / 32); p0_transpose_item<true>(F.p_WIN, D, INW, WIN, 64 * kb, 32 * nb, 32 * nb, nullptr, scr, F.lane); continue; } r -= IT_IN;
        if (r < IT_UP) { const int nb = r % (D / 32), kb = r / (D / 32); p0_transpose_item<true>(F.p_WUP, GW, D, WUP, 64 * kb, 32 * nb, 32 * nb, nullptr, scr, F.lane); continue; } r -= IT_UP;
        if (r < IT_PL) { const int g = r / IT_PL1, q = r % IT_PL1, nb = q % (GW / 32), kb = q / (GW / 32);
            p0_transpose_item<true>(F.p_WPOOL + (size_t)g * 512 * GW, 512, GW, WPL, 64 * kb, 32 * nb, g * GW + 32 * nb, nullptr, scr, F.lane); continue; } r -= IT_PL;
        if (r < IT_OUT) { const int nb = r % (D / 32), kb = r / (D / 32); p0_transpose_item<false>(F.p_WOUT, D, D, WOUT, 64 * kb, 32 * nb, 32 * nb, nullptr, scr, F.lane); continue; } r -= IT_OUT;
        { const int nb = r % (D / 32), kb = r / (D / 32); p0_transpose_item<false>(F.p_WD, FF, D, WDN, 64 * kb, 32 * nb, 32 * nb, nullptr, scr, F.lane); }
    }
    bf16* HN = (bf16*)(F.ws + WS_HN);
    for (int m = gw; m < MP; m += NGW) {
        if (m < MPR) rms_row_to_bf16(F.p_XP + (size_t)m * D, F.p_NMIX, HN, m, F.lane);
        else if (m < MREAL) rms_row_to_bf16(F.p_XS + (size_t)(m - MPR) * D, F.p_NMIX, HN, m, F.lane);
        else { GAS char* o = (GAS char*)HN + pg8::bl_off<false>(m, 8 * F.lane, D / 64);
#pragma unroll
            for (int j = 0; j < 8; ++j) *(GAS v4u*)(o + (size_t)j * (8 * 32768)) = (v4u){0u, 0u, 0u, 0u}; }
    }
    const int gt = F.vcu * (NWAVES * 64) + F.tid, NT = F.G * NWAVES * 64;
    { float* rs = (float*)(F.ws + WS_CTL) + CW_RSS; for (int i = gt; i < MP; i += NT) rs[i] = 0.f; }
    { const GAS f32x4* s4 = (const GAS f32x4*)F.p_SP; GAS f32x4* d4 = (GAS f32x4*)(F.out + O_PS); constexpr int per = (PHIST - 1) * (PW / 4), tot = NSMP * per;
      for (int i = gt; i < tot; i += NT) { const int n = i / per, rem = i - n * per; d4[(size_t)n * PHIST * (PW / 4) + rem] = s4[(size_t)n * PHIST * (PW / 4) + (PW / 4) + rem]; } }
}

__device__ __forceinline__ void p2_convert_wgu(Frame& F, LAS float* scr, int gwave, int ngw) {
    bf16* WGU = (bf16*)(F.ws + WS_WGU); constexpr int IT_G = (D / 64) * (FF / 32);
    for (int r = gwave; r < 2 * IT_G; r += ngw) { const int up = r >= IT_G ? 1 : 0, q = r - up * IT_G, nb = q % (FF / 32), kb = q / (FF / 32), n0 = 32 * nb;
        if (up) p0_transpose_item<true>(F.p_WU, D, FF, WGU, 64 * kb, n0, (n0 >> 7) * 256 + (n0 & 127) + 128, F.p_NFFN, scr, F.lane);
        else    p0_transpose_item<true>(F.p_WG, D, FF, WGU, 64 * kb, n0, (n0 >> 7) * 256 + (n0 & 127), F.p_NFFN, scr, F.lane); }
}
__device__ __forceinline__ float alibi_slope_log2e(int g, int h) { return exp2f(-8.0f * (float)(g * 8 + h + 1) / 24.0f) * 1.4426950408889634f; }
__device__ __forceinline__ float dot8(v4u a, v4u b) {
    return (bflo(a.x) * bflo(b.x) + bfhi(a.x) * bfhi(b.x)) + (bflo(a.y) * bflo(b.y) + bfhi(a.y) * bfhi(b.y)) + (bflo(a.z) * bflo(b.z) + bfhi(a.z) * bfhi(b.z)) + (bflo(a.w) * bflo(b.w) + bfhi(a.w) * bfhi(b.w));
}
__device__ __forceinline__ void attn_naive_prompt(const bf16* QB, const bf16* KB, const bf16* VB, bf16* ATT, int m, int j, LAS float* pl, int lane) {
    const int t = m & (SEQ - 1);
    float Mx = -INFINITY, den = 0.f, a0 = 0.f, a1 = 0.f;
#pragma unroll 1
    for (int g = 0; g < 3; ++g) {
        const int d = g == 0 ? 1 : (g == 1 ? 4 : 16); const int tq = t / d; const int nk = (tq < 128 ? tq : 128) + 1;
        const float sl = alibi_slope_log2e(g, j) * (float)d;
        const size_t hoff = (size_t)g * GW + j * HD;
        const GAS v4u* qp = (const GAS v4u*)(QB + (size_t)m * QKVW + hoff);
        float s[3];
#pragma unroll
        for (int i = 0; i < 3; ++i) { const int jj = lane + 64 * i; s[i] = -INFINITY;
            if (jj < nk) { const GAS v4u* kp = (const GAS v4u*)(KB + (size_t)(m - d * jj) * QKVW + hoff); float acc = 0.f;
#pragma unroll
                for (int c = 0; c < 16; ++c) acc += dot8(qp[c], kp[c]);
                s[i] = acc - sl * (float)jj; } }
        const float mg = wave_max(fmaxf(fmaxf(s[0], s[1]), s[2])); const float nM = fmaxf(Mx, mg); const float so = __builtin_amdgcn_exp2f(Mx - nM);
        float ps = 0.f;
#pragma unroll
        for (int i = 0; i < 3; ++i) { const int jj = lane + 64 * i; const float p = (jj < nk) ? __builtin_amdgcn_exp2f(s[i] - nM) : 0.f; ps += p; if (jj < 129) pl[jj] = p; }
        den = den * so + wave_sum(ps); a0 *= so; a1 *= so; Mx = nM;
        LDS_WAIT(); asm volatile("" ::: "memory");
        const GAS unsigned* vp = (const GAS unsigned*)(VB + (size_t)m * QKVW + hoff) + lane;
        for (int jj = 0; jj < nk; ++jj) { const float p = pl[jj]; const unsigned w = vp[-(long)(d * jj) * (QKVW / 2)]; a0 += p * bflo(w); a1 += p * bfhi(w); }
        LDS_WAIT(); asm volatile("" ::: "memory");
    }
    const float inv = 1.0f / den;
    ((GAS unsigned*)(ATT + (size_t)m * GW + j * HD))[lane] = pk2(a0 * inv, a1 * inv);
}
typedef float f32x16 __attribute__((ext_vector_type(16)));
typedef short bf16x8_t __attribute__((ext_vector_type(8)));
typedef short s16x4_t __attribute__((ext_vector_type(4)));
constexpr int VPITCH = 272;
__device__ __forceinline__ int crow16(int i, int h) { return (i & 3) + 8 * (i >> 2) + 4 * h; }
__device__ __forceinline__ unsigned cvtpk(float lo, float hi) { typedef float f2 __attribute__((ext_vector_type(2))); typedef __bf16 b2 __attribute__((ext_vector_type(2))); const f2 v = {lo, hi}; const b2 b = __builtin_convertvector(v, b2); return __builtin_bit_cast(unsigned, b); }
__device__ __forceinline__ s16x4_t vtr(LAS const unsigned char* p) { typedef short v4i16_t __attribute__((ext_vector_type(4))); return __builtin_bit_cast(s16x4_t, __builtin_amdgcn_ds_read_tr16_b64_v4i16((LAS v4i16_t*)p)); }
__device__ __forceinline__ void attn_mfma_tile(const bf16* QB, const bf16* KB, const bf16* VB, bf16* NUM, float* ML, int item, LAS unsigned char* vlds, int lane) {
    const int blk = ((item & 63) + 21 * (item >> 11)) & 63, h = (item >> 6) & 7, bg = item >> 9, g = bg % 3, b = bg / 3;
    const int ds = 2 * g, d = 1 << ds, nbs = 6 - ds, r = blk >> nbs, ib = blk & ((1 << nbs) - 1), i0 = 32 * ib;
    const int r32 = lane & 31, hh = lane >> 5;
    const size_t colbase = (size_t)g * GW + h * HD;
    const int rowb = b * SEQ + r;
    const float sl = alibi_slope_log2e(g, h) * (float)d;
    const int rq = r32 - 4 * hh; const float slrq = sl * (float)rq;
    bf16x8_t qf[8];
    { const bf16* qrow = QB + (size_t)(rowb + d * (i0 + r32)) * QKVW + colbase + 8 * hh;
#pragma unroll
      for (int s_ = 0; s_ < 8; ++s_) qf[s_] = *(const GAS bf16x8_t*)(qrow + 16 * s_); }
    f32x16 S[5];
#pragma unroll
    for (int kb = 0; kb < 5; ++kb) {
        if (ib + kb >= 4) {
            const int kk0 = 32 * (ib + kb - 4);
            const bf16* krow = KB + (size_t)(rowb + d * (kk0 + r32)) * QKVW + colbase + 8 * hh;
            f32x16 acc;
#pragma unroll
            for (int i = 0; i < 16; ++i) acc[i] = 0.f;
#pragma unroll
            for (int s_ = 0; s_ < 8; ++s_) { const bf16x8_t kf = *(const GAS bf16x8_t*)(krow + 16 * s_); acc = __builtin_amdgcn_mfma_f32_32x32x16_bf16(kf, qf[s_], acc, 0, 0, 0); }
#pragma unroll
            for (int i = 0; i < 16; ++i) { const int ci = (i & 3) + 8 * (i >> 2);
                float v = fmaf(-sl, (float)(32 * (4 - kb) - ci), acc[i]) - slrq;
                if (kb == 0 && rq > ci) v = -INFINITY;
                if (kb == 4 && rq < ci) v = -INFINITY;
                acc[i] = v; }
            S[kb] = acc;
        } else {
#pragma unroll
            for (int i = 0; i < 16; ++i) S[kb][i] = -INFINITY;
        }
    }
    float mx = -INFINITY;
#pragma unroll
    for (int kb = 0; kb < 5; ++kb)
#pragma unroll
        for (int i = 0; i < 16; ++i) mx = fmaxf(mx, S[kb][i]);
    mx = fmaxf(mx, __shfl_xor(mx, 32));
    float den = 0.f;
#pragma unroll
    for (int kb = 0; kb < 5; ++kb)
#pragma unroll
        for (int i = 0; i < 16; ++i) { const float p = __builtin_amdgcn_exp2f(S[kb][i] - mx); S[kb][i] = p; den += p; }
    den += __shfl_xor(den, 32);
    f32x16 y[4];
#pragma unroll
    for (int c = 0; c < 4; ++c)
#pragma unroll
        for (int i = 0; i < 16; ++i) y[c][i] = 0.f;
    const int q4 = (lane & 15) >> 2, p4 = lane & 3, bk = (lane >> 4) & 1;
    LAS const unsigned char* vrd = vlds + (4 * hh + q4) * VPITCH + 32 * bk + 8 * p4;
#pragma unroll
    for (int kb = 0; kb < 5; ++kb) {
        if (ib + kb >= 4) {
            const int kk0 = 32 * (ib + kb - 4);
#pragma unroll
            for (int k = 0; k < 8; ++k) { const int id = lane + 64 * k, key = id >> 4, ch = id & 15;
                const v4u v = *(const GAS v4u*)(VB + (size_t)(rowb + d * (kk0 + key)) * QKVW + colbase + 8 * ch);
                *(LAS v4u*)(vlds + key * VPITCH + ch * 16) = v; }
#pragma unroll
            for (int s_ = 0; s_ < 2; ++s_) {
                v4u pk; pk.x = cvtpk(S[kb][8 * s_ + 0], S[kb][8 * s_ + 1]); pk.y = cvtpk(S[kb][8 * s_ + 2], S[kb][8 * s_ + 3]); pk.z = cvtpk(S[kb][8 * s_ + 4], S[kb][8 * s_ + 5]); pk.w = cvtpk(S[kb][8 * s_ + 6], S[kb][8 * s_ + 7]);
                const bf16x8_t xs = __builtin_bit_cast(bf16x8_t, pk);
#pragma unroll
                for (int c = 0; c < 4; ++c) { const s16x4_t lo = vtr(vrd + (16 * s_) * VPITCH + 64 * c), hi = vtr(vrd + (16 * s_ + 8) * VPITCH + 64 * c);
                    const bf16x8_t vf = __builtin_shufflevector(lo, hi, 0, 1, 2, 3, 4, 5, 6, 7);
                    y[c] = __builtin_amdgcn_mfma_f32_32x32x16_bf16(vf, xs, y[c], 0, 0, 0); }
            }
        }
    }
    const int m = rowb + d * (i0 + r32);
    bf16* np = NUM + ((size_t)g * MREAL + m) * GW + h * HD + 4 * hh;
#pragma unroll
    for (int c = 0; c < 4; ++c)
#pragma unroll
        for (int k = 0; k < 4; ++k) { v2u w; w.x = cvtpk(y[c][4 * k + 0], y[c][4 * k + 1]); w.y = cvtpk(y[c][4 * k + 2], y[c][4 * k + 3]); *(GAS v2u*)(np + 32 * c + 8 * k) = w; }
    if (hh == 0) { typedef float f2 __attribute__((ext_vector_type(2))); *(GAS f2*)(ML + (((size_t)g * MREAL + m) * NH + h) * 2) = (f2){mx, den}; }
}
__device__ __forceinline__ void attn_combine(const bf16* NUM, const float* ML, bf16* ATT, int gt, int NT) {
    typedef float f2 __attribute__((ext_vector_type(2)));
    for (int i = gt; i < MREAL * (GW / 8); i += NT) {
        const int m = i >> 7, c8 = i & 127, h = c8 >> 4;
        f2 st[3]; float M = -INFINITY;
#pragma unroll
        for (int g = 0; g < 3; ++g) { st[g] = *(const GAS f2*)(ML + (((size_t)g * MREAL + m) * NH + h) * 2); M = fmaxf(M, st[g].x); }
        float o[8] = {0.f, 0.f, 0.f, 0.f, 0.f, 0.f, 0.f, 0.f}; float dn = 0.f;
#pragma unroll
        for (int g = 0; g < 3; ++g) { const float e = __builtin_amdgcn_exp2f(st[g].x - M); dn += e * st[g].y;
            const v4u w = *(const GAS v4u*)(NUM + ((size_t)g * MREAL + m) * GW + 8 * c8);
            o[0] += e * bflo(w.x); o[1] += e * bfhi(w.x); o[2] += e * bflo(w.y); o[3] += e * bfhi(w.y); o[4] += e * bflo(w.z); o[5] += e * bfhi(w.z); o[6] += e * bflo(w.w); o[7] += e * bfhi(w.w); }
        const float inv = 1.0f / dn; v4u r; r.x = cvtpk(o[0] * inv, o[1] * inv); r.y = cvtpk(o[2] * inv, o[3] * inv); r.z = cvtpk(o[4] * inv, o[5] * inv); r.w = cvtpk(o[6] * inv, o[7] * inv);
        *(GAS v4u*)(ATT + (size_t)m * GW + 8 * c8) = r;
    }
}
template <int G_>
__device__ __forceinline__ void attn_sample_partial(const float* ck, const float* cv, const float* out, const bf16* QB, bf16* NUM, float* ML, int n, int j, LAS float* pl, int lane) {
    constexpr int d = G_ == 0 ? 1 : (G_ == 1 ? 4 : 16), W = G_ == 0 ? 128 : (G_ == 1 ? 512 : 2048);
    constexpr size_t OK_ = G_ == 0 ? O_KS0 : (G_ == 1 ? O_KS1 : O_KS2), OV_ = G_ == 0 ? O_VS0 : (G_ == 1 ? O_VS1 : O_VS2);
    const int m = MPR + n, g4 = lane >> 4, i16 = lane & 15;
    const float* nk_ = out + OK_ + ((size_t)n * W + (W - 1)) * GW + j * HD; const float* nv_ = out + OV_ + ((size_t)n * W + (W - 1)) * GW + j * HD;
    const float* kb = ck + (size_t)n * W * GW + j * HD; const float* vb = cv + (size_t)n * W * GW + j * HD;
    const float sl = alibi_slope_log2e(G_, j) * (float)d;
    float q[8];
    { const v4u w = *(const GAS v4u*)(QB + (size_t)m * QKVW + (size_t)G_ * GW + j * HD + 8 * i16);
      q[0] = bflo(w.x); q[1] = bfhi(w.x); q[2] = bflo(w.y); q[3] = bfhi(w.y); q[4] = bflo(w.z); q[5] = bfhi(w.z); q[6] = bflo(w.w); q[7] = bfhi(w.w); }
    float sc[3] = {-INFINITY, -INFINITY, -INFINITY};
#pragma unroll
    for (int c0 = 0; c0 < 33; c0 += 11) {
        f32x4 ka[11], kc[11];
#pragma unroll
        for (int u = 0; u < 11; ++u) { const int jj = 4 * (c0 + u) + g4; const int jc = jj <= 128 ? jj : 128;
            const float* kp = (jc == 0 ? nk_ : kb + (size_t)(W - d * jc) * GW) + 8 * i16; ka[u] = *(const GAS f32x4*)kp; kc[u] = *(const GAS f32x4*)(kp + 4); }
#pragma unroll
        for (int u = 0; u < 11; ++u) { const int c = c0 + u, jj = 4 * c + g4;
            float sdot = (ka[u].x * q[0] + ka[u].y * q[1]) + (ka[u].z * q[2] + ka[u].w * q[3]) + (kc[u].x * q[4] + kc[u].y * q[5]) + (kc[u].z * q[6] + kc[u].w * q[7]);
            sdot += __shfl_xor(sdot, 1); sdot += __shfl_xor(sdot, 2); sdot += __shfl_xor(sdot, 4); sdot += __shfl_xor(sdot, 8);
            const float sv = jj <= 128 ? sdot - sl * (float)jj : -INFINITY;
            if ((c & 15) == i16) sc[c >> 4] = sv; }
    }
    const float mx = wave_max(fmaxf(fmaxf(sc[0], sc[1]), sc[2]));
    float ps = 0.f;
#pragma unroll
    for (int k = 0; k < 3; ++k) { const int jj = 4 * (i16 + 16 * k) + g4; const float p = __builtin_amdgcn_exp2f(sc[k] - mx); ps += p; if (jj <= 128) pl[jj] = p; }
    const float den = wave_sum(ps);
    LDS_WAIT(); asm volatile("" ::: "memory");
    typedef float f32x2g __attribute__((ext_vector_type(2)));
    float a0 = 0.f, a1 = 0.f;
#pragma unroll 1
    for (int j0 = 0; j0 < 128; j0 += 16) { f32x2g vv[16];
#pragma unroll
        for (int u = 0; u < 16; ++u) { const int jj = j0 + u; const float* vp = jj == 0 ? nv_ : vb + (size_t)(W - d * jj) * GW; vv[u] = ((const GAS f32x2g*)vp)[lane]; }
#pragma unroll
        for (int u = 0; u < 16; ++u) { const float p = pl[j0 + u]; a0 += p * vv[u].x; a1 += p * vv[u].y; } }
    { const f32x2g v128 = ((const GAS f32x2g*)vb)[lane]; const float p = pl[128]; a0 += p * v128.x; a1 += p * v128.y; }
    LDS_WAIT(); asm volatile("" ::: "memory");
    ((GAS unsigned*)(NUM + ((size_t)G_ * MREAL + m) * GW + j * HD))[lane] = cvtpk(a0, a1);
    if (lane == 0) { *(GAS f32x2g*)(ML + (((size_t)G_ * MREAL + m) * NH + j) * 2) = (f32x2g){mx, den}; }
}
template <int WN>
__device__ __forceinline__ void pool_task(const float* UB, const float* sp, bf16* PL, int m, int c) {
    const f32x4 u0 = *(const GAS f32x4*)(UB + (size_t)m * PW + c); f32x4 r[WN - 1]; float wgt[WN - 1]; float cnt;
    if (m < MPR) { const int t = m & (SEQ - 1); cnt = (float)((t < WN - 1 ? t : WN - 1) + 1);
#pragma unroll
        for (int q = 1; q < WN; ++q) { const int qq = q <= t ? q : t; wgt[q - 1] = q <= t ? 1.f : 0.f; r[q - 1] = *(const GAS f32x4*)(UB + (size_t)(m - qq) * PW + c); } }
    else { const int n = m - MPR; cnt = (float)WN;
#pragma unroll
        for (int q = 1; q < WN; ++q) { wgt[q - 1] = 1.f; r[q - 1] = *(const GAS f32x4*)(sp + ((size_t)n * PHIST + (PHIST - q)) * PW + c); } }
    f32x4 tot = u0;
#pragma unroll
    for (int q = 1; q < WN; ++q) tot = tot + r[q - 1] * wgt[q - 1];
    const float ic = 1.0f / cnt; v2u o; o.x = pk2(tot.x * ic - u0.x, tot.y * ic - u0.y); o.y = pk2(tot.z * ic - u0.z, tot.w * ic - u0.w);
    *(GAS v2u*)(PL + (size_t)m * PW + c) = o;
}
template <int WN>
__device__ __forceinline__ void pool_chunk(const float* UB, bf16* PL, int b, int t0, int c) {
    const float* ub = UB + (size_t)b * SEQ * PW + c; bf16* pb = PL + (size_t)b * SEQ * PW + c;
    f32x4 ring[WN]; f32x4 tot = (f32x4){0.f, 0.f, 0.f, 0.f};
    if (t0 != 0) {
#pragma unroll
        for (int j = 0; j < WN; ++j) ring[j] = *(const GAS f32x4*)(ub + (size_t)(t0 - WN + j) * PW);
#pragma unroll
        for (int j = 0; j < WN; ++j) tot = tot + ring[j];
    } else {
#pragma unroll
        for (int j = 0; j < WN; ++j) ring[j] = (f32x4){0.f, 0.f, 0.f, 0.f};
    }
#pragma unroll
    for (int s0 = 0; s0 < 32; s0 += 16) {
        f32x4 nw[16];
#pragma unroll
        for (int u = 0; u < 16; ++u) nw[u] = *(const GAS f32x4*)(ub + (size_t)(t0 + s0 + u) * PW);
#pragma unroll
        for (int u = 0; u < 16; ++u) { const int s_ = s0 + u, t = t0 + s_; const f32x4 x = nw[u];
            tot = tot + (x - ring[s_ % WN]); ring[s_ % WN] = x;
            const int cn = t + 1 < WN ? t + 1 : WN; const float ic = 1.0f / (float)cn;
            v2u o; o.x = pk2(tot.x * ic - x.x, tot.y * ic - x.y); o.y = pk2(tot.z * ic - x.z, tot.w * ic - x.w);
            *(GAS v2u*)(pb + (size_t)t * PW) = o; }
    }
}
__device__ __forceinline__ void pool_naive(const Frame& F, const float* UB, bf16* PL, int gt, int NT) {
    constexpr int C4 = PW / 4, NCH = SEQ / 32;
    for (int i = gt; i < NB * NCH * C4; i += NT) {
        const int c4 = i % C4, rc = (i / C4) % NCH, b = i / (C4 * NCH), c = 4 * c4; const int grp = __builtin_amdgcn_readfirstlane(c >> 9);
        if (grp == 0) pool_chunk<2>(UB, PL, b, 32 * rc, c); else if (grp == 1) pool_chunk<4>(UB, PL, b, 32 * rc, c); else if (grp == 2) pool_chunk<8>(UB, PL, b, 32 * rc, c); else pool_chunk<16>(UB, PL, b, 32 * rc, c);
    }
    for (int i = gt; i < NSMP * C4; i += NT) {
        const int n = i / C4, c = 4 * (i - n * C4); const int grp = __builtin_amdgcn_readfirstlane(c >> 9);
        if (grp == 0) pool_task<2>(UB, F.p_SP, PL, MPR + n, c); else if (grp == 1) pool_task<4>(UB, F.p_SP, PL, MPR + n, c); else if (grp == 2) pool_task<8>(UB, F.p_SP, PL, MPR + n, c); else pool_task<16>(UB, F.p_SP, PL, MPR + n, c);
    }
}
constexpr int SK_RED_PITCH = 33;
template <int NACC, bool PERM, bool AIMG = false>
__device__ __forceinline__ void skinny_partial(const bf16* A, int lda, const bf16* B, int brow0, int K, LAS float* red, int wave, int lane) {
    const int r32 = lane & 31, hh = lane >> 5, ks = K >> 3, nst = ks >> 4, nt = K >> 6; const unsigned ku0 = (unsigned)(__builtin_amdgcn_readfirstlane(wave) * ks);
    const bf16* ap = A + (size_t)r32 * lda + wave * ks + 8 * hh;
    const GAS char* bb = (const GAS char*)B;
    const unsigned rb0 = (unsigned)pg8::bl_off<PERM>(brow0 + r32, 0, nt), x5 = rb0 & 32u, rbase = (rb0 ^ x5) + 16u * (unsigned)hh;
    const unsigned ra0 = (unsigned)pg8::bl_off<false>(MPR + r32, 0, nt), ax5 = ra0 & 32u, aloE = ((ra0 ^ ax5) + 16u * (unsigned)hh) + (ax5 ^ ((ku0 & 16u) << 1)), aloO = aloE ^ 32u;
    const unsigned loE = rbase + (x5 ^ ((ku0 & 16u) << 1)), loO = loE ^ 32u;
    f32x16 acc0, acc1;
#pragma unroll
    for (int i = 0; i < 16; ++i) { acc0[i] = 0.f; acc1[i] = 0.f; }
#pragma unroll 16
    for (int s_ = 0; s_ < nst; ++s_) {
        const unsigned ku = ku0 + 16u * (unsigned)s_; const GAS char* sb = bb + (size_t)((ku >> 6) * 32768u + ((ku >> 5) & 1u) * 1024u); const unsigned bo = (s_ & 1) ? loO : loE;
        const bf16x8_t af = AIMG ? *(const GAS bf16x8_t*)((const GAS char*)A + (size_t)((ku >> 6) * 32768u + ((ku >> 5) & 1u) * 1024u) + ((s_ & 1) ? aloO : aloE)) : *(const GAS bf16x8_t*)(ap + 16 * s_);
        const bf16x8_t bf0 = *(const GAS bf16x8_t*)(sb + bo);
        acc0 = __builtin_amdgcn_mfma_f32_32x32x16_bf16(af, bf0, acc0, 0, 0, 0);
        if (NACC == 2) { const bf16x8_t bf1 = *(const GAS bf16x8_t*)(sb + bo + 16384); acc1 = __builtin_amdgcn_mfma_f32_32x32x16_bf16(af, bf1, acc1, 0, 0, 0); }
    }
    LAS float* rw = red + wave * (NACC * 32 * SK_RED_PITCH);
#pragma unroll
    for (int i = 0; i < 16; ++i) { rw[crow16(i, hh) * SK_RED_PITCH + r32] = acc0[i]; if (NACC == 2) rw[(32 + crow16(i, hh)) * SK_RED_PITCH + r32] = acc1[i]; }
}
template <int NACC>
__device__ __forceinline__ void skinny_reduce(LAS const float* red, int tid, float (&v)[NACC][2]) {
    const int row = tid >> 4, c = (tid & 15) * 2;
#pragma unroll
    for (int a = 0; a < NACC; ++a) { float s0 = 0.f, s1 = 0.f;
#pragma unroll
        for (int w = 0; w < NWAVES; ++w) { const LAS float* p = red + w * (NACC * 32 * SK_RED_PITCH) + (a * 32 + row) * SK_RED_PITCH + c; s0 += p[0]; s1 += p[1]; }
        v[a][0] = s0; v[a][1] = s1; }
}
__device__ __forceinline__ void skinny_share(int nmain, int G, int c, int& idx, int& share) { const int first = nmain % G; if (first == 0) { idx = c; share = G; } else { idx = c - first; share = G - first; } }

__device__ __forceinline__ void final_norm_row(float* yrow, const float* gain, int lane) {
    GAS f32x4* xr = (GAS f32x4*)yrow + lane; const GAS f32x4* gr = (const GAS f32x4*)gain + lane;
    f32x4 v[16]; float s = 0.f;
#pragma unroll
    for (int j = 0; j < 16; ++j) { v[j] = xr[64 * j]; s += (v[j].x * v[j].x + v[j].y * v[j].y) + (v[j].z * v[j].z + v[j].w * v[j].w); }
    const float rstd = 1.0f / sqrtf(wave_sum(s) * (1.0f / D) + RMS_EPS);
#pragma unroll
    for (int j = 0; j < 16; ++j) { const f32x4 g = gr[64 * j]; xr[64 * j] = v[j] * rstd * g; }
}

typedef float f32x2e __attribute__((ext_vector_type(2)));
__device__ __forceinline__ float sigm(float x) { return __builtin_amdgcn_rcpf(1.0f + __builtin_amdgcn_exp2f(-1.4426950408889634f * x)); }
__device__ __forceinline__ void sk_emit_in(bf16* QB, size_t qkv_stride, bf16* GB, float* UB, float* out, float qscale, int n, int col, float v0, float v1) {
    const size_t m = (size_t)(MPR + n);
    if (col < 3 * QKVW) {
        const int which = col / QKVW, c3 = col - which * QKVW; const float sc = which == 0 ? qscale : 1.0f;
        *(GAS unsigned*)(QB + (size_t)which * qkv_stride + m * QKVW + c3) = cvtpk(v0 * sc, v1 * sc);
        if (which != 0) { const int g = c3 / GW, cg = c3 - g * GW, W = g == 0 ? 128 : (g == 1 ? 512 : 2048);
            float* os = out + (g == 0 ? (which == 1 ? O_KS0 : O_VS0) : g == 1 ? (which == 1 ? O_KS1 : O_VS1) : (which == 1 ? O_KS2 : O_VS2)) + ((size_t)n * W + (W - 1)) * GW + cg;
            *(GAS f32x2e*)os = (f32x2e){v0, v1}; }
    } else if (col < 3 * QKVW + PW) {
        const int c = col - 3 * QKVW; *(GAS f32x2e*)(UB + m * PW + c) = (f32x2e){v0, v1}; *(GAS f32x2e*)(out + O_PS + ((size_t)n * PHIST + (PHIST - 1)) * PW + c) = (f32x2e){v0, v1};
    } else { const int c = col - (3 * QKVW + PW); *(GAS unsigned*)(GB + m * (2 * D) + c) = cvtpk(sigm(v0), sigm(v1)); }
}
__device__ __forceinline__ void sk_emit_pool(const bf16* GB, const float* pscale, bf16* T, int n, int col, float v0, float v1) {
    const size_t m = (size_t)(MPR + n); const unsigned g = *(const GAS unsigned*)(GB + m * (2 * D) + D + col); const f32x2e ps = *(const GAS f32x2e*)(pscale + col);
    *(GAS unsigned*)(T + m * D + col) = cvtpk(v0 * ps.x * bflo(g), v1 * ps.y * bfhi(g));
}
__device__ __forceinline__ void sk_emit_up(const bf16* GB, const bf16* T, bf16* MIX, int n, int col, float v0, float v1) {
    const size_t m = (size_t)(MPR + n); const unsigned g = *(const GAS unsigned*)(GB + m * (2 * D) + col), t = *(const GAS unsigned*)(T + m * D + col);
    *(GAS unsigned*)(MIX + m * D + col) = cvtpk(v0 * bflo(g) + bflo(t), v1 * bfhi(g) + bfhi(t));
}
__device__ __forceinline__ void sk_emit_out(const float* xs, float* y, bf16* X1B, float* rowss, int n, int col, float v0, float v1, int tid) {
    const size_t m = (size_t)(MPR + n); const f32x2e x = *(const GAS f32x2e*)(xs + (size_t)n * D + col); const float o0 = x.x + v0, o1 = x.y + v1;
    *(GAS f32x2e*)(y + m * D + col) = (f32x2e){o0, o1}; *(GAS unsigned*)((GAS char*)X1B + pg8::bl_off<false>((int)m, col, D / 64)) = cvtpk(o0, o1);
    float ss = o0 * o0 + o1 * o1; ss += __shfl_xor(ss, 1); ss += __shfl_xor(ss, 2); ss += __shfl_xor(ss, 4); ss += __shfl_xor(ss, 8);
    if ((tid & 15) == 0) atomicAdd(rowss + m, ss);
}
__device__ __forceinline__ void sk_emit_ff(const float* rowss, bf16* FFB, int n, int f, float g0, float g1, float u0, float u1) {
    const size_t m = (size_t)(MPR + n); const float r = 1.0f / sqrtf(rowss[m] * (1.0f / D) + RMS_EPS); g0 *= r; g1 *= r; u0 *= r; u1 *= r;
    *(GAS unsigned*)(FFB + m * FF + f) = cvtpk(g0 * sigm(g0) * u0, g1 * sigm(g1) * u1);
}
__device__ __forceinline__ void sk_emit_down(float* y, int n, int col, float v0, float v1) {
    GAS f32x2e* p = (GAS f32x2e*)(y + (size_t)(MPR + n) * D + col); const f32x2e b = *p; *p = (f32x2e){b.x + v0, b.y + v1};
}

__device__ __forceinline__ int lane_now() { int l; asm volatile("v_mbcnt_lo_u32_b32 %0, -1, 0\n\tv_mbcnt_hi_u32_b32 %0, -1, %0" : "=v"(l)); return l; }
struct BgStream {
    unsigned long long src, dst, pdst, dump;
    unsigned left;
    f32x4 data; unsigned voff;
    __device__ __forceinline__ void init(const float* k0, const float* v0, const float* k1, const float* v1, const float* k2, const float* v2, float* out, unsigned char* dump_, int gwave) {
        dump = (unsigned long long)(uintptr_t)dump_; pdst = dump; src = (unsigned long long)(uintptr_t)k0; dst = dump; left = 0u;
        const int slot = gwave & 31; if (slot >= 24) return;
        const int w = (gwave >> 5) * 24 + slot; const float* sb; size_t db; int W, n, start, count;
        if (w < 1088) { const int t = w / 544, rem = w - t * 544, piece = rem % 17; n = rem / 17; W = 2048; start = piece * 482; count = (start + 482 <= 8188) ? 482 : 8188 - start; if (t == 0) { sb = k2; db = O_KS2; } else { sb = v2; db = O_VS2; } }
        else if (w < 1408) { const int rem0 = w - 1088, t = rem0 / 160, r2 = rem0 - t * 160, piece = r2 % 5; n = r2 / 5; W = 512; start = piece * 409; count = (start + 409 <= 2044) ? 409 : 2044 - start; if (t == 0) { sb = k1; db = O_KS1; } else { sb = v1; db = O_VS1; } }
        else { const int rem0 = w - 1408, t = rem0 >> 6, r2 = rem0 & 63; n = r2 >> 1; W = 128; start = (r2 & 1) * 254; count = 254; if (t == 0) { sb = k0; db = O_KS0; } else { sb = v0; db = O_VS0; } }
        src = (unsigned long long)(uintptr_t)sb + ((size_t)n * W + 1) * 4096 + (size_t)start * 1024; dst = (unsigned long long)(uintptr_t)out + db * 4 + (size_t)n * W * 4096 + (size_t)start * 1024; left = (unsigned)count;
    }
    __device__ __forceinline__ void begin(int lane) { voff = (unsigned)lane * 16u; data = (f32x4){0.f, 0.f, 0.f, 0.f}; pdst = dump; }
    __device__ __forceinline__ void step() {
        if (left) {
            asm volatile("global_store_dwordx4 %1, %0, %2 nt\n\tglobal_load_dwordx4 %0, %1, %3 nt" : "+v"(data) : "v"(voff), "s"(pdst), "s"(src) : "memory");
            pdst = dst; src += 1024; dst += 1024; --left;
        }
    }
    __device__ __forceinline__ void flush() {
        asm volatile("s_waitcnt vmcnt(0)\n\tglobal_store_dwordx4 %1, %0, %2 nt" : : "v"(data), "v"(voff), "s"(pdst) : "memory");
        pdst = dump;
    }
};

struct Args { const float* in[20]; float* out; unsigned char* ws; int ph_lo, ph_hi; };
__global__ void __launch_bounds__(NWAVES * 64, 2) mega_fwd(Args args) {
    extern __shared__ __attribute__((aligned(16))) unsigned char lds[];
    Frame F;
    F.lds = (LAS unsigned char*)lds;
    F.MISC = (volatile LAS unsigned*)(F.lds + MISC_OFF);
    F.tid = threadIdx.x; F.lane = F.tid & 63; F.wave = __builtin_amdgcn_readfirstlane(F.tid >> 6);
    F.G = gridDim.x; { const int bx = blockIdx.x; F.vcu = (F.G % 8 == 0) ? (bx % 8) * (F.G / 8) + bx / 8 : bx; }
    F.ws = args.ws; F.out = args.out; F.ctl = (gu32*)(args.ws + WS_CTL);
    F.p_XP = args.in[I_XP]; F.p_XS = args.in[I_XS]; F.p_CK0 = args.in[I_CK0]; F.p_CV0 = args.in[I_CV0]; F.p_CK1 = args.in[I_CK1]; F.p_CV1 = args.in[I_CV1]; F.p_CK2 = args.in[I_CK2]; F.p_CV2 = args.in[I_CV2]; F.p_SP = args.in[I_SP]; F.p_NMIX = args.in[I_NMIX]; F.p_WIN = args.in[I_WIN]; F.p_WUP = args.in[I_WUP]; F.p_WPOOL = args.in[I_WPOOL]; F.p_PSCALE = args.in[I_PSCALE]; F.p_WOUT = args.in[I_WOUT]; F.p_NFFN = args.in[I_NFFN]; F.p_WG = args.in[I_WG]; F.p_WU = args.in[I_WU]; F.p_WD = args.in[I_WD]; F.p_NFIN = args.in[I_NFIN];
    for (int u = F.tid; u < (LDS_BYTES - LDSCTL_OFF) / 4; u += NWAVES * 64) ((LAS unsigned*)(F.lds + LDSCTL_OFF))[u] = 0u;
    __syncthreads();
    XcdBarrier bar; bar.bar = (unsigned*)(F.ctl + CW_BAR); bar.x = 0; bar.st = nullptr;
    if (N_LAUNCHES != PER_PHASE) bar = xcd_barrier_post((unsigned*)(F.ctl + CW_BAR), F.MISC + 8);
#define GRID_BAR() do { if (N_LAUNCHES != PER_PHASE) xcd_barrier(bar); } while (0)
    const int lo = args.ph_lo, hi = args.ph_hi;
#define IN(k) (lo <= (k) && (k) < hi)
#define BOTH(k) (IN(k) && IN((k) + 1))
    bf16* WIN = (bf16*)(F.ws + WS_WIN); bf16* WUP = (bf16*)(F.ws + WS_WUP); bf16* WPL = (bf16*)(F.ws + WS_WPL); bf16* WOUT = (bf16*)(F.ws + WS_WOUT); bf16* WGU = (bf16*)(F.ws + WS_WGU); bf16* WDN = (bf16*)(F.ws + WS_WDN);
    bf16* HN = (bf16*)(F.ws + WS_HN); bf16* QB = (bf16*)(F.ws + WS_QB); bf16* KB = (bf16*)(F.ws + WS_KB); bf16* VB = (bf16*)(F.ws + WS_VB); float* UB = (float*)(F.ws + WS_UB); bf16* GB = (bf16*)(F.ws + WS_GB);
    bf16* ATT = (bf16*)(F.ws + WS_ATT); bf16* PL = (bf16*)(F.ws + WS_PL); bf16* TB = (bf16*)(F.ws + WS_T); bf16* MIX = (bf16*)(F.ws + WS_MIX); bf16* X1B = (bf16*)(F.ws + WS_X1B); bf16* FFB = (bf16*)(F.ws + WS_FFB);
    float* rowss = (float*)(args.ws + WS_CTL) + CW_RSS;
    bf16* NUMB = (bf16*)(F.ws + WS_FFB); float* MLB = (float*)(F.ws + WS_FFB + 64 * MiB);
    const int gw = F.vcu * NWAVES + F.wave, NGW = F.G * NWAVES;
    pg8::NoBg nobg;
    BgStream bgs; bgs.init(F.p_CK0, F.p_CV0, F.p_CK1, F.p_CV1, F.p_CK2, F.p_CV2, F.out, F.ws + WS_DUMP + (size_t)(F.vcu * NWAVES + F.wave) * 1024, F.vcu * NWAVES + F.wave); bgs.begin(lane_now());
    LAS float* SKRED = (LAS float*)(F.lds + RING_OFF);

    if (IN(0)) { p0_prologue(F); if (BOTH(0)) GRID_BAR(); }

    if (IN(1)) {
        pg8::Gemm g{HN, WIN, D, D, 30, 0}; pg8::StaticOrder S; S.init(MPR, INW, F.G, (int)blockIdx.x);
        static_assert(WS_KB - WS_QB == WS_VB - WS_KB, "q/k/v buffers equally spaced");
        pg8::EpiIn E{QB, (WS_KB - WS_QB) / 2, GB, UB, F.out, 0.08838834764831845f * 1.4426950408889634f};
        pg8::gemm_phase<pg8::EpiIn, pg8::StaticOrder, true, true, pg8::NoBg, true>(F.lds + RING_OFF, g, S, E, nobg);
        { int idx, share; skinny_share((MPR / 256) * (INW / 256), F.G, (int)blockIdx.x, idx, share);
          if (idx >= 0) for (int t = idx; t < INW / 32; t += share) {
              skinny_partial<1, true, true>(HN, D, WIN, 32 * t, D, SKRED, F.wave, F.lane); LDS_WAIT(); __syncthreads();
              float v[1][2]; skinny_reduce<1>(SKRED, F.tid, v);
              sk_emit_in(QB, (WS_KB - WS_QB) / 2, GB, UB, F.out, 0.08838834764831845f * 1.4426950408889634f, F.tid >> 4, 32 * t + 2 * (F.tid & 15), v[0][0], v[0][1]); __syncthreads(); } }
        if (BOTH(1)) GRID_BAR();
    }

    if (IN(2)) {
        LAS unsigned char* wb = F.lds + RING_OFF + F.wave * 16384;
        LAS float* pl = (LAS float*)(wb + 9216);
        _Pragma("unroll 1") for (int ph = 0; ph < 2; ++ph) {
            if ((ph == 0) == (F.wave < 4)) p2_convert_wgu(F, (LAS float*)wb, gw, NGW);
            else { for (int it = gw; it < NB * 3 * NH * 64; it += NGW) attn_mfma_tile(QB, KB, VB, NUMB, MLB, it, wb, F.lane); }
        }
        if (F.wave < 3) { const int t = F.vcu * 3 + F.wave;
            if (t < NSMP * NH * 3) { const int gq = t % 3, nj = t / 3, n = nj >> 3, j = nj & 7;
                if (gq == 0) attn_sample_partial<0>(F.p_CK0, F.p_CV0, F.out, QB, NUMB, MLB, n, j, pl, F.lane);
                else if (gq == 1) attn_sample_partial<1>(F.p_CK1, F.p_CV1, F.out, QB, NUMB, MLB, n, j, pl, F.lane);
                else attn_sample_partial<2>(F.p_CK2, F.p_CV2, F.out, QB, NUMB, MLB, n, j, pl, F.lane); } }
        pool_naive(F, UB, PL, F.vcu * (NWAVES * 64) + F.tid, F.G * NWAVES * 64);
        if (BOTH(2)) GRID_BAR();
    }

    if (IN(3)) {
        attn_combine(NUMB, MLB, ATT, F.vcu * (NWAVES * 64) + F.tid, F.G * NWAVES * 64);
        pg8::Gemm g{PL, WPL, 512, PW, 2, 512 * 2}; pg8::StaticOrder S; S.init(MPR, D, F.G, (int)blockIdx.x);
        pg8::EpiPool E{GB, F.p_PSCALE, TB};
        pg8::gemm_phase<pg8::EpiPool, pg8::StaticOrder, true, true>(F.lds + RING_OFF, g, S, E, nobg);
        { int idx, share; skinny_share((MPR / 256) * (D / 256), F.G, (int)blockIdx.x, idx, share);
          if (idx >= 0) for (int t = idx; t < D / 32; t += share) {
              skinny_partial<1, true>(PL + (size_t)MPR * PW + (t >> 5) * 512, PW, WPL, 32 * t, 512, SKRED, F.wave, F.lane); LDS_WAIT(); __syncthreads();
              float v[1][2]; skinny_reduce<1>(SKRED, F.tid, v);
              sk_emit_pool(GB, F.p_PSCALE, TB, F.tid >> 4, 32 * t + 2 * (F.tid & 15), v[0][0], v[0][1]); __syncthreads(); } }
        if (BOTH(3)) GRID_BAR();
    }
    if (IN(4)) {
        pg8::Gemm g{ATT, WUP, GW, GW, 30, 0}; pg8::StaticOrder S; S.init(MPR, D, F.G, (int)blockIdx.x);
        pg8::EpiUp E{GB, TB, MIX};
        pg8::gemm_phase<pg8::EpiUp, pg8::StaticOrder, true, true>(F.lds + RING_OFF, g, S, E, nobg);
        { int idx, share; skinny_share((MPR / 256) * (D / 256), F.G, (int)blockIdx.x, idx, share);
          if (idx >= 0) for (int t = idx; t < D / 32; t += share) {
              skinny_partial<1, true>(ATT + (size_t)MPR * GW, GW, WUP, 32 * t, GW, SKRED, F.wave, F.lane); LDS_WAIT(); __syncthreads();
              float v[1][2]; skinny_reduce<1>(SKRED, F.tid, v);
              sk_emit_up(GB, TB, MIX, F.tid >> 4, 32 * t + 2 * (F.tid & 15), v[0][0], v[0][1]); __syncthreads(); } }
        if (BOTH(4)) GRID_BAR();
    }

    if (IN(5)) {
        pg8::Gemm g{MIX, WOUT, D, D, 30, 0}; pg8::StaticOrder S; S.init(MPR, D, F.G, (int)blockIdx.x);
        pg8::EpiOut E{F.p_XP, F.p_XS, F.out + O_Y, X1B, rowss};
        pg8::gemm_phase<pg8::EpiOut, pg8::StaticOrder, true, true>(F.lds + RING_OFF, g, S, E, nobg);
        { int idx, share; skinny_share((MPR / 256) * (D / 256), F.G, (int)blockIdx.x, idx, share);
          if (idx >= 0) for (int t = idx; t < D / 32; t += share) {
              skinny_partial<1, false>(MIX + (size_t)MPR * D, D, WOUT, 32 * t, D, SKRED, F.wave, F.lane); LDS_WAIT(); __syncthreads();
              float v[1][2]; skinny_reduce<1>(SKRED, F.tid, v);
              sk_emit_out(F.p_XS, F.out + O_Y, X1B, rowss, F.tid >> 4, 32 * t + 2 * (F.tid & 15), v[0][0], v[0][1], F.tid); __syncthreads(); } }
        if (BOTH(5)) GRID_BAR();
    }

    if (IN(6)) {
        pg8::Gemm g{X1B, WGU, D, D, 30, 0}; pg8::StaticOrder S; S.init(MPR, 2 * FF, F.G, (int)blockIdx.x);
        pg8::EpiFF E{rowss, FFB};
        bgs.begin(lane_now());
        pg8::gemm_phase<pg8::EpiFF, pg8::StaticOrder, true, true, BgStream, true>(F.lds + RING_OFF, g, S, E, bgs);
        { int idx, share; skinny_share((MPR / 256) * (2 * FF / 256), F.G, (int)blockIdx.x, idx, share);
          if (idx >= 0) for (int t = idx; t < FF / 32; t += share) { const int f0 = 32 * t;
              skinny_partial<2, true, true>(X1B, D, WGU, (f0 >> 7) * 256 + (f0 & 127), D, SKRED, F.wave, F.lane); LDS_WAIT(); __syncthreads();
              float v[2][2]; skinny_reduce<2>(SKRED, F.tid, v);
              sk_emit_ff(rowss, FFB, F.tid >> 4, f0 + 2 * (F.tid & 15), v[0][0], v[0][1], v[1][0], v[1][1]); __syncthreads(); } }
        if (BOTH(6)) GRID_BAR();
    }

    if (IN(7)) {
        pg8::Gemm g{FFB, WDN, FF, FF, 30, 0}; pg8::StaticOrder S; S.init(MPR, D, F.G, (int)blockIdx.x);
        pg8::EpiDown E{F.out + O_Y};
        bgs.begin(lane_now());
        pg8::gemm_phase<pg8::EpiDown, pg8::StaticOrder, true, true, BgStream>(F.lds + RING_OFF, g, S, E, bgs);
        { int idx, share; skinny_share((MPR / 256) * (D / 256), F.G, (int)blockIdx.x, idx, share);
          if (idx >= 0) for (int t = idx; t < D / 32; t += share) {
              skinny_partial<1, false>(FFB + (size_t)MPR * FF, FF, WDN, 32 * t, FF, SKRED, F.wave, F.lane); LDS_WAIT(); __syncthreads();
              float v[1][2]; skinny_reduce<1>(SKRED, F.tid, v);
              sk_emit_down(F.out + O_Y, F.tid >> 4, 32 * t + 2 * (F.tid & 15), v[0][0], v[0][1]); __syncthreads(); } }
        if (BOTH(7)) GRID_BAR();
    }

    if (IN(8)) {
        bgs.begin(lane_now());
        while (bgs.left) { asm volatile("s_waitcnt vmcnt(0)" ::: "memory"); bgs.step(); }
        bgs.flush();
        { const int ln = lane_now(); for (int m = gw; m < MREAL; m += NGW) final_norm_row(F.out + O_Y + (size_t)m * D, F.p_NFIN, ln); }
    }
#undef IN
#undef BOTH
#undef GRID_BAR
}

extern "C" void kernel_launch(void* const* d_in, const int* in_sizes, int n_in, void* d_out, int out_size, void* d_ws, size_t ws_size, hipStream_t stream) {
    static int grid = 0;
    if (grid == 0) {
        if (n_in != 20 || in_sizes[0] != MPR * D || (size_t)out_size != O_END || ws_size < WS_END) {
            fprintf(stderr, "kernel_launch: shape mismatch: n_in %d in0 %d out %d (want %zu) ws %zu (want %zu); nothing launched\n", n_in, n_in > 0 ? in_sizes[0] : -1, out_size, (size_t)O_END, ws_size, (size_t)WS_END); grid = -1; return; }
        int dev = 0, cus = 0, per_cu = 0;
        if (hipGetDevice(&dev) != hipSuccess || hipDeviceGetAttribute(&cus, hipDeviceAttributeMultiprocessorCount, dev) != hipSuccess) { grid = -1; return; }
        if (hipFuncSetAttribute((const void*)mega_fwd, hipFuncAttributeMaxDynamicSharedMemorySize, LDS_BYTES) != hipSuccess) { fprintf(stderr, "kernel_launch: hipFuncSetAttribute failed\n"); grid = -1; return; }
        if (hipOccupancyMaxActiveBlocksPerMultiprocessor(&per_cu, (const void*)mega_fwd, NWAVES * 64, LDS_BYTES) != hipSuccess || per_cu < 1) { fprintf(stderr, "kernel_launch: occupancy query says %d blocks per CU\n", per_cu); }
        (void)hipGetLastError();
        grid = cus;
    }
    if (grid < 0) return;
    (void)hipMemsetAsync((char*)d_ws + WS_CTL, 0, CTL_ZERO_BYTES, stream);
    Args a{};
    for (int i = 0; i < 20; ++i) a.in[i] = (const float*)d_in[i];
    a.out = (float*)d_out; a.ws = (unsigned char*)d_ws;
    for (int li = 0; li < N_LAUNCHES; ++li) {
        a.ph_lo = (N_LAUNCHES == PER_PHASE) ? li : 0; a.ph_hi = (N_LAUNCHES == PER_PHASE) ? li + 1 : PER_PHASE;
        hipLaunchKernelGGL(mega_fwd, dim3(grid), dim3(NWAVES * 64), LDS_BYTES, stream, a);
    }
}
```

```cpp
#include <hip/hip_runtime.h>
#include <cstdio>
#include <cstdint>
#include <cmath>
namespace pg8 {
#define PG8_LAS __attribute__((address_space(3)))
typedef unsigned short bf16_t;
typedef short bf16x8 __attribute__((ext_vector_type(8)));
typedef float f32x4 __attribute__((ext_vector_type(4)));
typedef unsigned u32x4 __attribute__((ext_vector_type(4)));
constexpr int BM = 256, BK = 64, HALF = 128, HTB = HALF * BK * 2  , STAGE_BYTES = 8 * HTB, NXCD = 8, WGM = 8;

__host__ __device__ __forceinline__ int lds_byte(int r, int c) { const int st = (r >> 4) * 2 + (c >> 5), rr = r & 15, cc = c & 31, ob = rr * 64 + cc * 2; return st * 1024 + (ob ^ (((ob >> 9) & 1) << 5)); }
__host__ __device__ __forceinline__ void stage_rc(int b, int& R, int& C) { const int st = b / 1024, sb = b % 1024, swz = sb ^ (((sb >> 9) & 1) << 5); R = (st >> 1) * 16 + swz / 64; C = (st & 1) * 32 + (swz % 64) / 2; }
__host__ __device__ __forceinline__ int perm32(int rho) { const int n = rho >> 4, i = rho & 15; return 8 * (i >> 2) + 4 * n + (i & 3); }
template <bool PERM> __host__ __device__ __forceinline__ size_t bl_off(int row, int k, int nt) {
    const int r128 = row & 127, w = r128 & 31;
    const int R = PERM ? ((r128 & 96) + ((w >> 2) & 1) * 16 + (w >> 3) * 4 + (w & 3)) : r128;
    return (((size_t)(row >> 8) * nt + (k >> 6)) * 2 + ((row >> 7) & 1)) * 16384 + (size_t)lds_byte(R, k & 63);
}

struct Unit { int pm, pn; };
struct Gemm { const bf16_t* A; const bf16_t* Bt; int K, lda, ashift; size_t astride; };

struct StaticOrder {
    int nM, nN, nwg, G, c;
    __host__ __device__ void init(int M, int N, int G_, int c_) { nM = M / BM; nN = N / BM; nwg = nM * nN; G = G_; c = c_; }
    __host__ __device__ bool next(int i, Unit& u) const {
        const long L = (long)i * G + c; if (L >= nwg) return false;
        int wgid = (int)L; { const int q = nwg / NXCD, r = nwg % NXCD, xcd = wgid % NXCD, off = wgid / NXCD; wgid = (xcd < r ? xcd * (q + 1) : r * (q + 1) + (xcd - r) * q) + off; }
        const int nig = WGM * nN, gid = wgid / nig, fm = gid * WGM, gsz = (nM - fm) < WGM ? (nM - fm) : WGM;
        u.pm = fm + ((wgid % nig) % gsz); u.pn = (wgid % nig) / gsz; return true;
    }
    __device__ __forceinline__ void a_ready(const Unit&) const {}
    __device__ __forceinline__ void done(const Unit&) const {}
};

typedef float f32x2_cv __attribute__((ext_vector_type(2))); typedef __bf16 bf16x2_cv __attribute__((ext_vector_type(2)));
__device__ __forceinline__ unsigned cvt_pk_bf16(float lo, float hi) { const f32x2_cv v = {lo, hi}; const bf16x2_cv b = __builtin_convertvector(v, bf16x2_cv); return __builtin_bit_cast(unsigned, b); }
typedef float f32x2 __attribute__((ext_vector_type(2)));

struct NoBg { __device__ __forceinline__ void step() {} __device__ __forceinline__ void flush() {} };
template <class Epi, class Sched, bool ALIGN_EPI = false, bool SP2 = false, class Bg = NoBg, bool AIMG = false>
__device__ __forceinline__ void gemm_phase(PG8_LAS unsigned char* lds, const Gemm g, const Sched& S, const Epi& E, Bg& bg) {
    const int tid = threadIdx.x, wid = __builtin_amdgcn_readfirstlane(tid >> 6), lane = tid & 63, wr = wid >> 2, wc = wid & 3, fr = lane & 15, fq = lane >> 4;
    const int K = g.K, nt = K / BK, lda = g.lda;
    unsigned voffA[2], voffB[2];
#pragma unroll
    for (int i = 0; i < 2; ++i) { int R, C; stage_rc(tid * 16 + i * 8192, R, C); const int Rb = Epi::PERM ? ((R & ~31) + perm32(R & 31)) : R;
        voffA[i] = AIMG ? (unsigned)(tid * 16 + i * 8192) : (unsigned)(R * lda + C) * 2u; voffB[i] = (unsigned)(tid * 16 + i * 8192); (void)Rb; }
    const size_t kstep = AIMG ? (size_t)(2 * HTB) : (size_t)(BK * 2);
    const size_t kstepB = (size_t)(2 * HTB);
    const size_t hsB = (size_t)HTB, hsA = AIMG ? (size_t)HTB : (size_t)HALF * lda * 2;
    const size_t tsB = (size_t)nt * kstepB, tsA = AIMG ? (size_t)nt * kstep : 2 * hsA;
    const unsigned ldsw = (unsigned)wid * 1024u;
    const int aoff = lds_byte(wr * 64 + fr, fq * 8), boff = lds_byte(wc * 32 + fr, fq * 8);
#define PG8_SA(b, h) (((b) * 2 + (h)) * HTB)
#define PG8_SB(b, h) ((4 + (b) * 2 + (h)) * HTB)
#define PG8_STAGE(bufoff, gbase, voff) do { _Pragma("unroll") for (int _i = 0; _i < 2; ++_i) \
        __builtin_amdgcn_global_load_lds((const unsigned*)((const char*)(gbase) + (voff)[_i]), (PG8_LAS unsigned*)(lds + (bufoff) + ldsw + _i * 8192), 16, 0, 0); } while (0)
#define PG8_LDA(dst, b, h) do { _Pragma("unroll") for (int m = 0; m < 4; ++m) _Pragma("unroll") for (int k = 0; k < 2; ++k) dst[m][k] = *(const PG8_LAS bf16x8*)(lds + PG8_SA(b, h) + aoff + m * 2048 + k * 1024); } while (0)
#define PG8_LDB(dst, b, h) do { _Pragma("unroll") for (int n = 0; n < 2; ++n) _Pragma("unroll") for (int k = 0; k < 2; ++k) dst[n][k] = *(const PG8_LAS bf16x8*)(lds + PG8_SB(b, h) + boff + n * 2048 + k * 1024); } while (0)
#define PG8_MMA(ai, bj, At, Bt) do { __builtin_amdgcn_s_setprio(1); _Pragma("unroll") for (int m = 0; m < 4; ++m) _Pragma("unroll") for (int n = 0; n < 2; ++n) _Pragma("unroll") for (int k = 0; k < 2; ++k) \
        acc[ai][bj][m][n] = __builtin_amdgcn_mfma_f32_16x16x32_bf16(Bt[n][k], At[m][k], acc[ai][bj][m][n], 0, 0, 0); __builtin_amdgcn_s_setprio(0); } while (0)
#define PG8_WAIT_V(n) asm volatile("s_waitcnt vmcnt(" #n ")" ::: "memory")
#define PG8_WAIT_L(n) asm volatile("s_waitcnt lgkmcnt(" #n ")" ::: "memory")
#define PG8_BAR __builtin_amdgcn_s_barrier()
#define PG8_SCHED __builtin_amdgcn_sched_barrier(0)
    Unit cur, nxt; int ui = 0;
    if (!S.next(0, cur)) return;
    f32x4 acc[2][2][4][2];
#pragma unroll
    for (int a = 0; a < 2; ++a)
#pragma unroll
        for (int b = 0; b < 2; ++b)
#pragma unroll
            for (int m = 0; m < 4; ++m)
#pragma unroll
                for (int n = 0; n < 2; ++n) acc[a][b][m][n] = (f32x4){0.f, 0.f, 0.f, 0.f};
    bf16x8 At[4][2], B0[2][2], B1[2][2];
    const char* cA = (const char*)g.A + (size_t)cur.pm * tsA + (size_t)(cur.pn >> g.ashift) * g.astride; const char* cB = (const char*)g.Bt + (size_t)cur.pn * tsB;
    S.a_ready(cur);
    if constexpr (SP2) {
        PG8_STAGE(PG8_SB(0, 0), cB, voffB); PG8_STAGE(PG8_SB(0, 1), cB + hsB, voffB); PG8_STAGE(PG8_SA(0, 0), cA, voffA); PG8_STAGE(PG8_SA(0, 1), cA + hsA, voffA);
        if (wr == 1) PG8_BAR;
        PG8_WAIT_V(2); PG8_BAR;
        PG8_STAGE(PG8_SB(1, 0), cB + kstepB, voffB); PG8_STAGE(PG8_SA(1, 0), cA + kstep, voffA); PG8_STAGE(PG8_SB(1, 1), cB + hsB + kstepB, voffB);
        PG8_WAIT_V(6); PG8_BAR;
    } else {
        PG8_STAGE(PG8_SB(0, 0), cB, voffB); PG8_STAGE(PG8_SA(0, 0), cA, voffA); PG8_STAGE(PG8_SB(0, 1), cB + hsB, voffB); PG8_STAGE(PG8_SA(0, 1), cA + hsA, voffA);
        if (wr == 1) PG8_BAR;
        PG8_WAIT_V(4); PG8_BAR;
        PG8_STAGE(PG8_SB(1, 0), cB + kstepB, voffB); PG8_STAGE(PG8_SA(1, 0), cA + kstep, voffA); PG8_STAGE(PG8_SB(1, 1), cB + hsB + kstepB, voffB);
        PG8_WAIT_V(6); PG8_BAR;
    }
    for (;;) {
        const bool has_next = S.next(ui + 1, nxt);
        const char* nA = has_next ? (const char*)g.A + (size_t)nxt.pm * tsA + (size_t)(nxt.pn >> g.ashift) * g.astride : cA; const char* nB = has_next ? (const char*)g.Bt + (size_t)nxt.pn * tsB : cB;
        for (int t = 0; t < nt; t += 2) {
            const bool last = (t == nt - 2);
            const char* a1 = cA + (size_t)(t + 1) * kstep;
            const char* a2 = last ? nA : cA + (size_t)(t + 2) * kstep; const char* b2 = last ? nB : cB + (size_t)(t + 2) * kstepB;
            const char* a3 = a2 + kstep; const char* b3 = b2 + kstepB;
            if (last && has_next) S.a_ready(nxt);
            bg.step();
            if constexpr (SP2) {
            PG8_LDB(B0, 0, 0); PG8_LDB(B1, 0, 1); PG8_SCHED; PG8_LDA(At, 0, 0); PG8_STAGE(PG8_SA(1, 1), a1 + hsA, voffA);
            PG8_WAIT_V(8); PG8_WAIT_L(0); PG8_BAR; PG8_MMA(0, 0, At, B0); PG8_MMA(0, 1, At, B1); PG8_BAR; PG8_SCHED;
            PG8_LDA(At, 0, 1); PG8_STAGE(PG8_SB(0, 0), b2, voffB); PG8_STAGE(PG8_SB(0, 1), b2 + hsB, voffB); PG8_STAGE(PG8_SA(0, 0), a2, voffA);
            PG8_WAIT_V(8); PG8_WAIT_L(0); PG8_BAR; PG8_MMA(1, 0, At, B0); PG8_MMA(1, 1, At, B1); PG8_BAR; PG8_SCHED;
            PG8_LDB(B0, 1, 0); PG8_LDB(B1, 1, 1); PG8_SCHED; PG8_LDA(At, 1, 0); PG8_STAGE(PG8_SA(0, 1), a2 + hsA, voffA);
            PG8_WAIT_V(8); PG8_WAIT_L(0); PG8_BAR; PG8_MMA(0, 0, At, B0); PG8_MMA(0, 1, At, B1); PG8_BAR; PG8_SCHED;
            PG8_LDA(At, 1, 1); PG8_STAGE(PG8_SB(1, 0), b3, voffB); PG8_STAGE(PG8_SB(1, 1), b3 + hsB, voffB); PG8_STAGE(PG8_SA(1, 0), a3, voffA);
            PG8_WAIT_V(8); PG8_WAIT_L(0); PG8_BAR; PG8_MMA(1, 0, At, B0); PG8_MMA(1, 1, At, B1); PG8_BAR; PG8_SCHED;
            } else {
            PG8_LDB(B0, 0, 0); PG8_SCHED; PG8_LDA(At, 0, 0); PG8_STAGE(PG8_SA(1, 1), a1 + hsA, voffA);
            PG8_WAIT_L(8); PG8_BAR; PG8_WAIT_L(0); PG8_MMA(0, 0, At, B0); PG8_BAR; PG8_SCHED;
            PG8_LDB(B1, 0, 1); PG8_STAGE(PG8_SB(0, 0), b2, voffB);
            PG8_BAR; PG8_WAIT_L(0); PG8_MMA(0, 1, At, B1); PG8_BAR;
            PG8_LDA(At, 0, 1); PG8_STAGE(PG8_SA(0, 0), a2, voffA);
            PG8_BAR; PG8_WAIT_L(0); PG8_MMA(1, 0, At, B0); PG8_BAR; PG8_SCHED;
            PG8_STAGE(PG8_SB(0, 1), b2 + hsB, voffB);
            PG8_WAIT_V(6); PG8_BAR; PG8_MMA(1, 1, At, B1); PG8_BAR;
            PG8_LDB(B0, 1, 0); PG8_SCHED; PG8_LDA(At, 1, 0); PG8_STAGE(PG8_SA(0, 1), a2 + hsA, voffA);
            PG8_WAIT_L(8); PG8_BAR; PG8_WAIT_L(0); PG8_MMA(0, 0, At, B0); PG8_BAR; PG8_SCHED;
            PG8_LDB(B1, 1, 1); PG8_STAGE(PG8_SB(1, 0), b3, voffB);
            PG8_BAR; PG8_WAIT_L(0); PG8_MMA(0, 1, At, B1); PG8_BAR;
            PG8_LDA(At, 1, 1); PG8_STAGE(PG8_SA(1, 0), a3, voffA);
            PG8_BAR; PG8_WAIT_L(0); PG8_MMA(1, 0, At, B0); PG8_BAR; PG8_SCHED;
            PG8_STAGE(PG8_SB(1, 1), b3 + hsB, voffB);
            PG8_WAIT_V(6); PG8_BAR; PG8_MMA(1, 1, At, B1); PG8_BAR;
            }
        }
        if constexpr (ALIGN_EPI) { if (wr == 0) PG8_BAR; }
        if constexpr (!Epi::AFTER_DRAIN) { E(acc, cur, wr, wc, fr, fq); S.done(cur); }
        if (!has_next) break;
#pragma unroll
        for (int a = 0; a < 2; ++a)
#pragma unroll
            for (int b = 0; b < 2; ++b)
#pragma unroll
                for (int m = 0; m < 4; ++m)
#pragma unroll
                    for (int n = 0; n < 2; ++n) acc[a][b][m][n] = (f32x4){0.f, 0.f, 0.f, 0.f};
        cur = nxt; cA = nA; cB = nB; ++ui;
        if constexpr (ALIGN_EPI) { if (wr == 1) PG8_BAR; }
    }
    bg.flush();
    PG8_WAIT_V(0);
    if constexpr (!ALIGN_EPI) { if (wr == 0) PG8_BAR; }
    PG8_BAR;
    if constexpr (Epi::AFTER_DRAIN) { E.fused(acc, cur, wr, wc, fr, fq, lds, wid, lane); S.done(cur); }
#undef PG8_SA
#undef PG8_SB
#undef PG8_STAGE
#undef PG8_LDA
#undef PG8_LDB
#undef PG8_MMA
#undef PG8_WAIT_V
#undef PG8_WAIT_L
#undef PG8_BAR
#undef PG8_SCHED
}
}

constexpr int D = 4096, NB = 4, SEQ = 2048, MPR = NB * SEQ  , NSMP = 32, MREAL = MPR + NSMP  , MP = 8448  ;
constexpr int HD = 128, NH = 8, GW = NH * HD  , QKVW = 3 * GW  , PW = 2048, INW = 3 * QKVW + PW + 2 * D  , FF = 11008;
constexpr int PHIST = 15;
constexpr float RMS_EPS = 1e-6f;
constexpr size_t O_Y = 0;
constexpr size_t O_KP0 = (size_t)MREAL * D;
constexpr size_t O_VP0 = O_KP0 + (size_t)NB * 128 * GW;
constexpr size_t O_KP1 = O_VP0 + (size_t)NB * 128 * GW;
constexpr size_t O_VP1 = O_KP1 + (size_t)NB * 512 * GW;
constexpr size_t O_KP2 = O_VP1 + (size_t)NB * 512 * GW;
constexpr size_t O_VP2 = O_KP2 + (size_t)NB * 2048 * GW;
constexpr size_t O_PP  = O_VP2 + (size_t)NB * 2048 * GW;
constexpr size_t O_KS0 = O_PP + (size_t)NB * PHIST * PW;
constexpr size_t O_VS0 = O_KS0 + (size_t)NSMP * 128 * GW;
constexpr size_t O_KS1 = O_VS0 + (size_t)NSMP * 128 * GW;
constexpr size_t O_VS1 = O_KS1 + (size_t)NSMP * 512 * GW;
constexpr size_t O_KS2 = O_VS1 + (size_t)NSMP * 512 * GW;
constexpr size_t O_VS2 = O_KS2 + (size_t)NSMP * 2048 * GW;
constexpr size_t O_PS  = O_VS2 + (size_t)NSMP * 2048 * GW;
constexpr size_t O_END = O_PS + (size_t)NSMP * PHIST * PW;

namespace pg8 {
__device__ __forceinline__ float bf_lo(unsigned w) { return __uint_as_float(w << 16); }
__device__ __forceinline__ float bf_hi(unsigned w) { return __uint_as_float(w & 0xffff0000u); }
__device__ __forceinline__ float sigmoidf_(float x) { return __builtin_amdgcn_rcpf(1.0f + __builtin_amdgcn_exp2f(-1.4426950408889634f * x)); }

struct EpiIn {
    static constexpr bool PERM = true, AFTER_DRAIN = false;
    bf16_t *QB; size_t qkv_stride  ; bf16_t* GB; float* UB; float* out; float qscale;
    __device__ __forceinline__ void operator()(const f32x4 (&acc)[2][2][4][2], const Unit& u, int wr, int wc, int fr, int fq) const {
        const int colt = u.pn * BM, cl = wc * 32 + 8 * fq, rbase = u.pm * BM + wr * 64 + fr;
        if (colt < 3 * QKVW) {
            const int which = colt / QKVW, c3 = colt - which * QKVW;
            bf16_t* B = QB + (size_t)which * qkv_stride; const float sc = which == 0 ? qscale : 1.0f;
#pragma unroll
            for (int ai = 0; ai < 2; ++ai)
#pragma unroll
                for (int m = 0; m < 4; ++m) { bf16_t* rowp = B + (size_t)(rbase + ai * HALF + m * 16) * QKVW + c3 + cl;
#pragma unroll
                    for (int bj = 0; bj < 2; ++bj) { const f32x4 v0 = acc[ai][bj][m][0] * sc, v1 = acc[ai][bj][m][1] * sc; u32x4 w;
                        w.x = cvt_pk_bf16(v0[0], v0[1]); w.y = cvt_pk_bf16(v0[2], v0[3]); w.z = cvt_pk_bf16(v1[0], v1[1]); w.w = cvt_pk_bf16(v1[2], v1[3]);
                        *(u32x4*)(rowp + bj * HALF) = w; } }
            if (which != 0) {
                const int g = c3 / GW, cg = c3 - g * GW + cl, W = g == 0 ? 128 : (g == 1 ? 512 : 2048);
                float* op = out + (g == 0 ? (which == 1 ? O_KP0 : O_VP0) : g == 1 ? (which == 1 ? O_KP1 : O_VP1) : (which == 1 ? O_KP2 : O_VP2));
                float* os = out + (g == 0 ? (which == 1 ? O_KS0 : O_VS0) : g == 1 ? (which == 1 ? O_KS1 : O_VS1) : (which == 1 ? O_KS2 : O_VS2));
#pragma unroll
                for (int ai = 0; ai < 2; ++ai)
#pragma unroll
                    for (int m = 0; m < 4; ++m) { const int row = rbase + ai * HALF + m * 16; float* dst = nullptr;
                        if (row < MPR) { const int b = row >> 11, tt = (row & (SEQ - 1)) - (SEQ - W); if (tt >= 0) dst = op + ((size_t)(b * W + tt)) * GW + cg; }
                        else if (row < MREAL) { dst = os + ((size_t)((row - MPR) * W + (W - 1))) * GW + cg; }
                        if (dst) {
#pragma unroll
                            for (int bj = 0; bj < 2; ++bj)
#pragma unroll
                                for (int n = 0; n < 2; ++n) __builtin_nontemporal_store(acc[ai][bj][m][n], (f32x4*)(dst + bj * HALF + 4 * n)); } }
            }
        } else if (colt < 3 * QKVW + PW) {
            const int c = colt - 3 * QKVW + cl;
#pragma unroll
            for (int ai = 0; ai < 2; ++ai)
#pragma unroll
                for (int m = 0; m < 4; ++m) { const int row = rbase + ai * HALF + m * 16; float* up = UB + (size_t)row * PW + c; float* dst = nullptr;
                    if (row < MPR) { const int b = row >> 11, tt = (row & (SEQ - 1)) - (SEQ - PHIST); if (tt >= 0) dst = out + O_PP + ((size_t)(b * PHIST + tt)) * PW + c; }
                    else if (row < MREAL) { dst = out + O_PS + ((size_t)((row - MPR) * PHIST + (PHIST - 1))) * PW + c; }
#pragma unroll
                    for (int bj = 0; bj < 2; ++bj)
#pragma unroll
                        for (int n = 0; n < 2; ++n) { *(f32x4*)(up + bj * HALF + 4 * n) = acc[ai][bj][m][n]; if (dst) *(f32x4*)(dst + bj * HALF + 4 * n) = acc[ai][bj][m][n]; } }
        } else {
            const int c = colt - (3 * QKVW + PW) + cl;
#pragma unroll
            for (int ai = 0; ai < 2; ++ai)
#pragma unroll
                for (int m = 0; m < 4; ++m) { bf16_t* rowp = GB + (size_t)(rbase + ai * HALF + m * 16) * (2 * D) + c;
#pragma unroll
                    for (int bj = 0; bj < 2; ++bj) { const f32x4 v0 = acc[ai][bj][m][0], v1 = acc[ai][bj][m][1]; u32x4 w;
                        w.x = cvt_pk_bf16(sigmoidf_(v0[0]), sigmoidf_(v0[1])); w.y = cvt_pk_bf16(sigmoidf_(v0[2]), sigmoidf_(v0[3]));
                        w.z = cvt_pk_bf16(sigmoidf_(v1[0]), sigmoidf_(v1[1])); w.w = cvt_pk_bf16(sigmoidf_(v1[2]), sigmoidf_(v1[3]));
                        *(u32x4*)(rowp + bj * HALF) = w; } }
        }
    }
};

#define EPI_FENCE() asm volatile("" ::: "memory")
struct EpiPool {
    static constexpr bool PERM = true, AFTER_DRAIN = false;
    const bf16_t* GB; const float* pscale; bf16_t* T;
    __device__ __forceinline__ void operator()(const f32x4 (&acc)[2][2][4][2], const Unit& u, int wr, int wc, int fr, int fq) const {
        const int col0 = u.pn * BM + wc * 32 + 8 * fq, rbase = u.pm * BM + wr * 64 + fr;
        f32x4 sv[2][2];
#pragma unroll
        for (int bj = 0; bj < 2; ++bj)
#pragma unroll
            for (int n = 0; n < 2; ++n) sv[bj][n] = *(const f32x4*)(pscale + col0 + bj * HALF + 4 * n);
#pragma unroll
        for (int ai = 0; ai < 2; ++ai) {
            u32x4 gq[4][2];
#pragma unroll
            for (int m = 0; m < 4; ++m)
#pragma unroll
                for (int bj = 0; bj < 2; ++bj) gq[m][bj] = *(const u32x4*)(GB + (size_t)(rbase + ai * HALF + m * 16) * (2 * D) + D + col0 + bj * HALF);
            EPI_FENCE();
#pragma unroll
            for (int m = 0; m < 4; ++m) { const size_t row = (size_t)(rbase + ai * HALF + m * 16);
#pragma unroll
                for (int bj = 0; bj < 2; ++bj) { const u32x4 g = gq[m][bj];
                    const f32x4 v0 = acc[ai][bj][m][0] * sv[bj][0], v1 = acc[ai][bj][m][1] * sv[bj][1]; u32x4 w;
                    w.x = cvt_pk_bf16(v0[0] * bf_lo(g.x), v0[1] * bf_hi(g.x)); w.y = cvt_pk_bf16(v0[2] * bf_lo(g.y), v0[3] * bf_hi(g.y));
                    w.z = cvt_pk_bf16(v1[0] * bf_lo(g.z), v1[1] * bf_hi(g.z)); w.w = cvt_pk_bf16(v1[2] * bf_lo(g.w), v1[3] * bf_hi(g.w));
                    *(u32x4*)(T + row * D + col0 + bj * HALF) = w; } }
            EPI_FENCE();
        }
    }
};
struct EpiUp {
    static constexpr bool PERM = true, AFTER_DRAIN = false;
    const bf16_t* GB; const bf16_t* T; bf16_t* MIX;
    __device__ __forceinline__ void operator()(const f32x4 (&acc)[2][2][4][2], const Unit& u, int wr, int wc, int fr, int fq) const {
        const int col0 = u.pn * BM + wc * 32 + 8 * fq, rbase = u.pm * BM + wr * 64 + fr;
#pragma unroll
        for (int ai = 0; ai < 2; ++ai) {
            u32x4 gq[4][2], tq[4][2];
#pragma unroll
            for (int m = 0; m < 4; ++m)
#pragma unroll
                for (int bj = 0; bj < 2; ++bj) { const size_t row = (size_t)(rbase + ai * HALF + m * 16);
                    gq[m][bj] = *(const u32x4*)(GB + row * (2 * D) + col0 + bj * HALF); tq[m][bj] = *(const u32x4*)(T + row * D + col0 + bj * HALF); }
            EPI_FENCE();
#pragma unroll
            for (int m = 0; m < 4; ++m) { const size_t row = (size_t)(rbase + ai * HALF + m * 16);
#pragma unroll
                for (int bj = 0; bj < 2; ++bj) { const u32x4 g = gq[m][bj], t = tq[m][bj];
                    const f32x4 v0 = acc[ai][bj][m][0], v1 = acc[ai][bj][m][1]; u32x4 w;
                    w.x = cvt_pk_bf16(v0[0] * bf_lo(g.x) + bf_lo(t.x), v0[1] * bf_hi(g.x) + bf_hi(t.x)); w.y = cvt_pk_bf16(v0[2] * bf_lo(g.y) + bf_lo(t.y), v0[3] * bf_hi(g.y) + bf_hi(t.y));
                    w.z = cvt_pk_bf16(v1[0] * bf_lo(g.z) + bf_lo(t.z), v1[1] * bf_hi(g.z) + bf_hi(t.z)); w.w = cvt_pk_bf16(v1[2] * bf_lo(g.w) + bf_lo(t.w), v1[3] * bf_hi(g.w) + bf_hi(t.w));
                    *(u32x4*)(MIX + row * D + col0 + bj * HALF) = w; } }
            EPI_FENCE();
        }
    }
};
struct EpiOut {
    static constexpr bool PERM = false, AFTER_DRAIN = false;
    const float* xp; const float* xs; float* y; bf16_t* X1B; float* rowss;
    __device__ __forceinline__ void operator()(const f32x4 (&acc)[2][2][4][2], const Unit& u, int wr, int wc, int fr, int fq) const {
        const int col0 = u.pn * BM + wc * 32 + 4 * fq, rbase = u.pm * BM + wr * 64 + fr;
        typedef unsigned u32x2v __attribute__((ext_vector_type(2)));
#pragma unroll
        for (int ai = 0; ai < 2; ++ai) {
            f32x4 xin[4][2][2];
#pragma unroll
            for (int m = 0; m < 4; ++m) { const int row = rbase + ai * HALF + m * 16; const int rc = row < MREAL ? row : MREAL - 1;
                const float* xr = (rc < MPR ? xp + (size_t)rc * D : xs + (size_t)(rc - MPR) * D) + col0;
#pragma unroll
                for (int bj = 0; bj < 2; ++bj)
#pragma unroll
                    for (int n = 0; n < 2; ++n) xin[m][bj][n] = *(const f32x4*)(xr + bj * HALF + n * 16); }
            EPI_FENCE();
#pragma unroll
            for (int m = 0; m < 4; ++m) { const int row = rbase + ai * HALF + m * 16; const bool real = row < MREAL; float ss = 0.f;
#pragma unroll
                for (int bj = 0; bj < 2; ++bj)
#pragma unroll
                    for (int n = 0; n < 2; ++n) { const f32x4 o = acc[ai][bj][m][n] + xin[m][bj][n];
                        if (real) *(f32x4*)(y + (size_t)row * D + col0 + bj * HALF + n * 16) = o;
                        u32x2v w; w.x = cvt_pk_bf16(o[0], o[1]); w.y = cvt_pk_bf16(o[2], o[3]); *(u32x2v*)((char*)X1B + bl_off<false>(row, col0 + bj * HALF + n * 16, D / 64)) = w;
                        ss += (o[0] * o[0] + o[1] * o[1]) + (o[2] * o[2] + o[3] * o[3]); }
                ss += __shfl_xor(ss, 16); ss += __shfl_xor(ss, 32);
                if (fq == 0 && real) atomicAdd(rowss + row, ss); }
            EPI_FENCE();
        }
    }
};
struct EpiFF {
    static constexpr bool PERM = true, AFTER_DRAIN = false;
    const float* rowss; bf16_t* FFB;
    __device__ __forceinline__ void operator()(const f32x4 (&acc)[2][2][4][2], const Unit& u, int wr, int wc, int fr, int fq) const {
        const int col0 = u.pn * HALF + wc * 32 + 8 * fq, rbase = u.pm * BM + wr * 64 + fr;
        float rs[2][4];
#pragma unroll
        for (int ai = 0; ai < 2; ++ai)
#pragma unroll
            for (int m = 0; m < 4; ++m) rs[ai][m] = rowss[rbase + ai * HALF + m * 16];
        EPI_FENCE();
#pragma unroll
        for (int ai = 0; ai < 2; ++ai)
#pragma unroll
            for (int m = 0; m < 4; ++m) { const int row = rbase + ai * HALF + m * 16; const float r = 1.0f / sqrtf(rs[ai][m] * (1.0f / D) + RMS_EPS);
                u32x4 w; float o[8];
#pragma unroll
                for (int n = 0; n < 2; ++n)
#pragma unroll
                    for (int j = 0; j < 4; ++j) { const float gv = acc[ai][0][m][n][j] * r, uv = acc[ai][1][m][n][j] * r; o[4 * n + j] = gv * sigmoidf_(gv) * uv; }
                w.x = cvt_pk_bf16(o[0], o[1]); w.y = cvt_pk_bf16(o[2], o[3]); w.z = cvt_pk_bf16(o[4], o[5]); w.w = cvt_pk_bf16(o[6], o[7]);
                *(u32x4*)(FFB + (size_t)row * FF + col0) = w; }
    }
};
struct EpiDown {
    static constexpr bool PERM = false, AFTER_DRAIN = false;
    float* y;
    __device__ __forceinline__ void operator()(const f32x4 (&acc)[2][2][4][2], const Unit& u, int wr, int wc, int fr, int fq) const {
        const int col0 = u.pn * BM + wc * 32 + 4 * fq, rbase = u.pm * BM + wr * 64 + fr;
#pragma unroll
        for (int ai = 0; ai < 2; ++ai) {
            f32x4 yin[4][2][2];
#pragma unroll
            for (int m = 0; m < 4; ++m) { const int row = rbase + ai * HALF + m * 16; const int rc = row < MREAL ? row : MREAL - 1; const float* yr = y + (size_t)rc * D + col0;
#pragma unroll
                for (int bj = 0; bj < 2; ++bj)
#pragma unroll
                    for (int n = 0; n < 2; ++n) yin[m][bj][n] = *(const f32x4*)(yr + bj * HALF + n * 16); }
            EPI_FENCE();
#pragma unroll
            for (int m = 0; m < 4; ++m) { const int row = rbase + ai * HALF + m * 16;
                if (row < MREAL) { float* yr = y + (size_t)row * D + col0;
#pragma unroll
                    for (int bj = 0; bj < 2; ++bj)
#pragma unroll
                        for (int n = 0; n < 2; ++n) *(f32x4*)(yr + bj * HALF + n * 16) = yin[m][bj][n] + acc[ai][bj][m][n]; } }
            EPI_FENCE();
        }
    }
};
}

constexpr int NWAVES = 8;
#ifndef MK_N_LAUNCHES
#define MK_N_LAUNCHES 1
#endif
constexpr int PER_PHASE = 9;
constexpr int N_LAUNCHES = MK_N_LAUNCHES;

constexpr size_t MiB = 1u << 20;
constexpr size_t al256(size_t x) { return (x + 255) & ~(size_t)255; }
constexpr size_t WS_CTL = 0, CTL_ZERO_BYTES = 1 * MiB;
constexpr size_t WS_WIN  = 1 * MiB;
constexpr size_t WS_WUP  = WS_WIN  + al256((size_t)INW * D * 2);
constexpr size_t WS_WPL  = WS_WUP  + al256((size_t)D * GW * 2);
constexpr size_t WS_WOUT = WS_WPL  + al256((size_t)D * 512 * 2);
constexpr size_t WS_WGU  = WS_WOUT + al256((size_t)D * D * 2);
constexpr size_t WS_WDN  = WS_WGU  + al256((size_t)2 * FF * D * 2);
constexpr size_t WS_HN   = WS_WDN  + al256((size_t)D * FF * 2);
constexpr size_t WS_QB   = WS_HN   + al256((size_t)MP * D * 2);
constexpr size_t WS_KB   = WS_QB   + al256((size_t)MP * QKVW * 2);
constexpr size_t WS_VB   = WS_KB   + al256((size_t)MP * QKVW * 2);
constexpr size_t WS_UB   = WS_VB   + al256((size_t)MP * QKVW * 2);
constexpr size_t WS_GB   = WS_UB   + al256((size_t)MP * PW * 4);
constexpr size_t WS_ATT  = WS_GB   + al256((size_t)MP * 2 * D * 2);
constexpr size_t WS_PL   = WS_ATT  + al256((size_t)MP * GW * 2);
constexpr size_t WS_T    = WS_PL   + al256((size_t)MP * PW * 2);
constexpr size_t WS_MIX  = WS_T    + al256((size_t)MP * D * 2);
constexpr size_t WS_X1B  = WS_MIX  + al256((size_t)MP * D * 2);
constexpr size_t WS_FFB  = WS_X1B  + al256((size_t)MP * D * 2);
constexpr size_t WS_DUMP = WS_FFB  + al256((size_t)MP * FF * 2);
constexpr size_t WS_END  = WS_DUMP + 2 * MiB;
constexpr int CW_BAR = 4096;
constexpr int CW_RSS = 16384;
static_assert((CW_RSS + MP) * 4 <= (int)CTL_ZERO_BYTES && CW_BAR + 3456 <= CW_RSS, "CTL map");

constexpr int RING_OFF = 0, RING_BYTES = 131072;
constexpr int LDSCTL_OFF = RING_BYTES, MISC_OFF = LDSCTL_OFF + 320;
constexpr int LDS_BYTES = 147456;
static_assert(MISC_OFF + 128 <= LDS_BYTES, "LDS map");

#define GAS __attribute__((address_space(1)))
#define LAS __attribute__((address_space(3)))
typedef unsigned short bf16;
typedef unsigned v4u __attribute__((ext_vector_type(4)));
typedef unsigned v2u __attribute__((ext_vector_type(2)));
typedef float f32x4 __attribute__((ext_vector_type(4)));
typedef GAS unsigned gu32;
#define RLX_AGENT __ATOMIC_RELAXED, __HIP_MEMORY_SCOPE_AGENT
#define LDS_WAIT() asm volatile("s_waitcnt lgkmcnt(0)" ::: "memory")
#define VM_WAIT() asm volatile("s_waitcnt vmcnt(0)" ::: "memory")
__device__ __forceinline__ unsigned f2bf(float f) { unsigned u = __builtin_bit_cast(unsigned, f); return (u + 0x7fffu + ((u >> 16) & 1u)) >> 16; }
__device__ __forceinline__ unsigned pk2(float lo, float hi) { return f2bf(lo) | (f2bf(hi) << 16); }
__device__ __forceinline__ float bflo(unsigned w) { return __uint_as_float(w << 16); }
__device__ __forceinline__ float bfhi(unsigned w) { return __uint_as_float(w & 0xffff0000u); }

#define XB_TMO      128
#define XB_XCNT(j)  (256  + 64 * (j))
#define XB_XSUB(j)  (1280 + 64 * (j))
#define XB_XGEN(j)  (2304 + 64 * (j))
#define XB_TOP      3328
#define XB_TOPGEN   3392
#define XCD_BAR_WORDS 3456
#define XB_SPIN_CAP (1u << 18)

__device__ __forceinline__ unsigned xb_ld(unsigned* p)              { return __hip_atomic_load(p, __ATOMIC_RELAXED, __HIP_MEMORY_SCOPE_AGENT); }
__device__ __forceinline__ unsigned xb_add(unsigned* p, unsigned v) { return __hip_atomic_fetch_add(p, v, __ATOMIC_RELAXED, __HIP_MEMORY_SCOPE_AGENT); }
__device__ __forceinline__ unsigned xb_xcc_id() { return (unsigned)__builtin_amdgcn_s_getreg((3 << 11) | 20) & 0xFu; }
#define XB_SPIN(cond, bar) do { unsigned _sp = 0; while (cond) { __builtin_amdgcn_s_sleep(1); \
    if ((++_sp & 255u) == 0u) { if (xb_ld(&(bar)[XB_TMO])) break; if (_sp > XB_SPIN_CAP) { atomicAdd(&(bar)[XB_TMO], 1u); break; } } } } while (0)

struct XcdBarrier {
    unsigned* bar; unsigned x;
    volatile LAS unsigned* st;
};

__device__ __forceinline__ XcdBarrier xcd_barrier_post(unsigned* bar, volatile LAS unsigned* st) {
    XcdBarrier b; b.bar = bar; b.x = xb_xcc_id(); b.st = st;
    if (threadIdx.x == 0) (void)xb_add(&bar[XB_XCNT(b.x)], 1u);
    return b;
}
__device__ __forceinline__ void xcd_barrier_complete(unsigned* bar, unsigned x, unsigned& nloc, unsigned& nx) {
    const unsigned G = gridDim.x * gridDim.y * gridDim.z;
    unsigned sum, cnt, mine, sp = 0u;
    for (;;) {
        sum = 0u; cnt = 0u; mine = 0u;
#pragma unroll
        for (unsigned j = 0; j < 16; ++j) { const unsigned c = xb_ld(&bar[XB_XCNT(j)]); sum += c; cnt += (c > 0u) ? 1u : 0u; mine = (j == x) ? c : mine; }
        if (sum == G) break;
        __builtin_amdgcn_s_sleep(1);
        if ((++sp & 255u) == 0u) { if (xb_ld(&bar[XB_TMO])) break; if (sp > XB_SPIN_CAP) { atomicAdd(&bar[XB_TMO], 1u); break; } }
    }
    nloc = mine > 0u ? mine : 1u; nx = cnt > 0u ? cnt : 1u;
}

__device__ __forceinline__ void xcd_barrier(const XcdBarrier& b) {
    asm volatile("s_waitcnt vmcnt(0)" ::: "memory");
    __syncthreads();
    if (threadIdx.x == 0) {
        unsigned* bar = b.bar;
        __builtin_amdgcn_s_waitcnt(0);
        unsigned nloc = b.st[0], nx = b.st[1];
        if (nloc == 0u) { xcd_barrier_complete(bar, b.x, nloc, nx); b.st[0] = nloc; b.st[1] = nx; }
        const unsigned old = xb_add(&bar[XB_XSUB(b.x)], 1u);
        const unsigned gen = old / nloc;
        if (old + 1u == (gen + 1u) * nloc) {
            __builtin_amdgcn_fence(__ATOMIC_RELEASE, "agent");
            asm volatile("s_waitcnt vmcnt(0)" ::: "memory");
            const unsigned og = xb_add(&bar[XB_TOP], 1u);
            const unsigned tg = og / nx;
            if (og + 1u == (tg + 1u) * nx) xb_add(&bar[XB_TOPGEN], 1u);
            else XB_SPIN(xb_ld(&bar[XB_TOPGEN]) == tg, bar);
            __builtin_amdgcn_fence(__ATOMIC_ACQUIRE, "agent");
            xb_add(&bar[XB_XGEN(b.x)], 1u);
            asm volatile("s_waitcnt vmcnt(0)" ::: "memory");
        } else {
            XB_SPIN(xb_ld(&bar[XB_XGEN(b.x)]) == gen, bar);
            __builtin_amdgcn_fence(__ATOMIC_ACQUIRE, "agent");
            asm volatile("s_waitcnt vmcnt(0)" ::: "memory");
        }
    }
    __syncthreads();
}


struct Frame {
    LAS unsigned char* lds;
    volatile LAS unsigned* MISC;
    gu32* ctl;
    int tid, lane, wave;
    int vcu, G;
    const float *p_XP, *p_XS, *p_CK0, *p_CV0, *p_CK1, *p_CV1, *p_CK2, *p_CV2, *p_SP, *p_NMIX, *p_WIN, *p_WUP, *p_WPOOL, *p_PSCALE, *p_WOUT, *p_NFFN, *p_WG, *p_WU, *p_WD, *p_NFIN;
    float* out; unsigned char* ws;
};
enum { I_XP = 0, I_XS, I_CK0, I_CV0, I_CK1, I_CV1, I_CK2, I_CV2, I_SP, I_NMIX, I_WIN, I_WUP, I_WPOOL, I_PSCALE, I_WOUT, I_NFFN, I_WG, I_WU, I_WD, I_NFIN };

__device__ __forceinline__ float wave_sum(float v) {
#pragma unroll
    for (int o = 1; o < 64; o <<= 1) v += __shfl_xor(v, o);
    return v;
}
__device__ __forceinline__ float wave_max(float v) {
#pragma unroll
    for (int o = 1; o < 64; o <<= 1) v = fmaxf(v, __shfl_xor(v, o));
    return v;
}
template <bool PERM>
__device__ __forceinline__ void p0_transpose_item(const float* W, int K, int N, bf16* WT, int k0, int n0, int out_row0, const float* kscale, LAS float* scr, int lane) {
    float wv[32];
#pragma unroll
    for (int i = 0; i < 32; ++i) wv[i] = __builtin_nontemporal_load(W + (size_t)(k0 + 2 * i + (lane >> 5)) * N + n0 + (lane & 31));
    if (kscale) {
#pragma unroll
        for (int i = 0; i < 32; ++i) wv[i] *= kscale[k0 + 2 * i + (lane >> 5)]; }
#pragma unroll
    for (int i = 0; i < 32; ++i) scr[(2 * i + (lane >> 5)) * 33 + (lane & 31)] = wv[i];
    LDS_WAIT(); asm volatile("" ::: "memory");
    const int c = lane & 7;
#pragma unroll
    for (int j = 0; j < 4; ++j) { const int n = (lane >> 3) + 8 * j; const LAS float* s = scr + (8 * c) * 33 + n;
        v4u o; o.x = pk2(s[0 * 33], s[1 * 33]); o.y = pk2(s[2 * 33], s[3 * 33]); o.z = pk2(s[4 * 33], s[5 * 33]); o.w = pk2(s[6 * 33], s[7 * 33]);
        *(GAS v4u*)((GAS char*)WT + pg8::bl_off<PERM>(out_row0 + n, k0 + 8 * c, K >> 6)) = o; }
    LDS_WAIT(); asm volatile("" ::: "memory");
}
__device__ __forceinline__ void rms_row_to_bf16(const float* xrow, const float* gain, bf16* obase, int m, int lane) {
    const GAS f32x4* xr = (const GAS f32x4*)xrow + lane; const GAS f32x4* gr = (const GAS f32x4*)gain + lane;
    f32x4 v[16]; float s = 0.f;
#pragma unroll
    for (int j = 0; j < 16; ++j) { v[j] = xr[64 * j]; s += (v[j].x * v[j].x + v[j].y * v[j].y) + (v[j].z * v[j].z + v[j].w * v[j].w); }
    const float rstd = 1.0f / sqrtf(wave_sum(s) * (1.0f / D) + RMS_EPS);
    GAS char* ob = (GAS char*)obase + pg8::bl_off<false>(m, 4 * lane, D / 64);
#pragma unroll
    for (int j = 0; j < 16; ++j) { const f32x4 g = gr[64 * j]; v2u w; w.x = pk2(v[j].x * rstd * g.x, v[j].y * rstd * g.y); w.y = pk2(v[j].z * rstd * g.z, v[j].w * rstd * g.w); *(GAS v2u*)(ob + (size_t)j * (4 * 32768)) = w; }
}
__device__ __forceinline__ void p0_cache_copy(const float* src, float* dst, int W, int gt, int NT) {
    const int per = (W - 1) * 256; const int total = NSMP * per;
    const GAS f32x4* s4 = (const GAS f32x4*)src; GAS f32x4* d4 = (GAS f32x4*)dst;
    for (int i0 = gt; i0 < total; i0 += 4 * NT) {
        f32x4 v[4]; int di[4];
#pragma unroll
        for (int k = 0; k < 4; ++k) { const int i = i0 + k * NT; const int n = i / per, rem = i - n * per; di[k] = n * W * 256 + rem; if (i < total) v[k] = s4[(size_t)di[k] + 256]; }
#pragma unroll
        for (int k = 0; k < 4; ++k) { const int i = i0 + k * NT; if (i < total) d4[(size_t)di[k]] = v[k]; }
    }
}
__device__ __forceinline__ void p0_prologue(Frame& F) {
    LAS float* scr = (LAS float*)(F.lds + RING_OFF + F.wave * 16384);
    const int gw = F.vcu * NWAVES + F.wave, NGW = F.G * NWAVES;
    bf16* WIN = (bf16*)(F.ws + WS_WIN); bf16* WUP = (bf16*)(F.ws + WS_WUP); bf16* WPL = (bf16*)(F.ws + WS_WPL); bf16* WOUT = (bf16*)(F.ws + WS_WOUT); bf16* WGU = (bf16*)(F.ws + WS_WGU); bf16* WDN = (bf16*)(F.ws + WS_WDN);
    constexpr int IT_IN = (D / 64) * (INW / 32), IT_UP = (GW / 64) * (D / 32), IT_PL1 = (512 / 64) * (GW / 32), IT_PL = 4 * IT_PL1, IT_OUT = (D / 64) * (D / 32), IT_G = (D / 64) * (FF / 32), IT_DN = (FF / 64) * (D / 32);
    constexpr int NITEMS = IT_IN + IT_UP + IT_PL + IT_OUT + IT_DN;
    for (int it = gw; it < NITEMS; it += NGW) {
        int r = it;
        if (r < IT_IN) { const int nb = r % (INW / 32), kb = r / (INW / 32); p0_transpose_item<true>(F.p_WIN, D, INW, WIN, 64 * kb, 32 * nb, 32 * nb, nullptr, scr, F.lane); continue; } r -= IT_IN;
        if (r < IT_UP) { const int nb = r % (D / 32), kb = r / (D / 32); p0_transpose_item<true>(F.p_WUP, GW, D, WUP, 64 * kb, 32 * nb, 32 * nb, nullptr, scr, F.lane); continue; } r -= IT_UP;
        if (r < IT_PL) { const int g = r / IT_PL1, q = r % IT_PL1, nb = q % (GW / 32), kb = q / (GW / 32);
            p0_transpose_item<true>(F.p_WPOOL + (size_t)g * 512 * GW, 512, GW, WPL, 64 * kb, 32 * nb, g * GW + 32 * nb, nullptr, scr, F.lane); continue; } r -= IT_PL;
        if (r < IT_OUT) { const int nb = r % (D / 32), kb = r / (D / 32); p0_transpose_item<false>(F.p_WOUT, D, D, WOUT, 64 * kb, 32 * nb, 32 * nb, nullptr, scr, F.lane); continue; } r -= IT_OUT;
        { const int nb = r % (D / 32), kb = r / (D / 32); p0_transpose_item<false>(F.p_WD, FF, D, WDN, 64 * kb, 32 * nb, 32 * nb, nullptr, scr, F.lane); }
    }
    bf16* HN = (bf16*)(F.ws + WS_HN);
    for (int m = gw; m < MP; m += NGW) {
        if (m < MPR) rms_row_to_bf16(F.p_XP + (size_t)m * D, F.p_NMIX, HN, m, F.lane);
        else if (m < MREAL) rms_row_to_bf16(F.p_XS + (size_t)(m - MPR) * D, F.p_NMIX, HN, m, F.lane);
        else { GAS char* o = (GAS char*)HN + pg8::bl_off<false>(m, 8 * F.lane, D / 64);
#pragma unroll
            for (int j = 0; j < 8; ++j) *(GAS v4u*)(o + (size_t)j * (8 * 32768)) = (v4u){0u, 0u, 0u, 0u}; }
    }
    const int gt = F.vcu * (NWAVES * 64) + F.tid, NT = F.G * NWAVES * 64;
    { float* rs = (float*)(F.ws + WS_CTL) + CW_RSS; for (int i = gt; i < MP; i += NT) rs[i] = 0.f; }
    { const GAS f32x4* s4 = (const GAS f32x4*)F.p_SP; GAS f32x4* d4 = (GAS f32x4*)(F.out + O_PS); constexpr int per = (PHIST - 1) * (PW / 4), tot = NSMP * per;
      for (int i = gt; i < tot; i += NT) { const int n = i / per, rem = i - n * per; d4[(size_t)n * PHIST * (PW / 4) + rem] = s4[(size_t)n * PHIST * (PW / 4) + (PW / 4) + rem]; } }
}

__device__ __forceinline__ void p2_convert_wgu(Frame& F, LAS float* scr, int gwave, int ngw) {
    bf16* WGU = (bf16*)(F.ws + WS_WGU); constexpr int IT_G = (D / 64) * (FF / 32);
    for (int r = gwave; r < 2 * IT_G; r += ngw) { const int up = r >= IT_G ? 1 : 0, q = r - up * IT_G, nb = q % (FF / 32), kb = q / (FF / 32), n0 = 32 * nb;
        if (up) p0_transpose_item<true>(F.p_WU, D, FF, WGU, 64 * kb, n0, (n0 >> 7) * 256 + (n0 & 127) + 128, F.p_NFFN, scr, F.lane);
        else    p0_transpose_item<true>(F.p_WG, D, FF, WGU, 64 * kb, n0, (n0 >> 7) * 256 + (n0 & 127), F.p_NFFN, scr, F.lane); }
}
__device__ __forceinline__ float alibi_slope_log2e(int g, int h) { return exp2f(-8.0f * (float)(g * 8 + h + 1) / 24.0f) * 1.4426950408889634f; }
__device__ __forceinline__ float dot8(v4u a, v4u b) {
    return (bflo(a.x) * bflo(b.x) + bfhi(a.x) * bfhi(b.x)) + (bflo(a.y) * bflo(b.y) + bfhi(a.y) * bfhi(b.y)) + (bflo(a.z) * bflo(b.z) + bfhi(a.z) * bfhi(b.z)) + (bflo(a.w) * bflo(b.w) + bfhi(a.w) * bfhi(b.w));
}
__device__ __forceinline__ void attn_naive_prompt(const bf16* QB, const bf16* KB, const bf16* VB, bf16* ATT, int m, int j, LAS float* pl, int lane) {
    const int t = m & (SEQ - 1);
    float Mx = -INFINITY, den = 0.f, a0 = 0.f, a1 = 0.f;
#pragma unroll 1
    for (int g = 0; g < 3; ++g) {
        const int d = g == 0 ? 1 : (g == 1 ? 4 : 16); const int tq = t / d; const int nk = (tq < 128 ? tq : 128) + 1;
        const float sl = alibi_slope_log2e(g, j) * (float)d;
        const size_t hoff = (size_t)g * GW + j * HD;
        const GAS v4u* qp = (const GAS v4u*)(QB + (size_t)m * QKVW + hoff);
        float s[3];
#pragma unroll
        for (int i = 0; i < 3; ++i) { const int jj = lane + 64 * i; s[i] = -INFINITY;
            if (jj < nk) { const GAS v4u* kp = (const GAS v4u*)(KB + (size_t)(m - d * jj) * QKVW + hoff); float acc = 0.f;
#pragma unroll
                for (int c = 0; c < 16; ++c) acc += dot8(qp[c], kp[c]);
                s[i] = acc - sl * (float)jj; } }
        const float mg = wave_max(fmaxf(fmaxf(s[0], s[1]), s[2])); const float nM = fmaxf(Mx, mg); const float so = __builtin_amdgcn_exp2f(Mx - nM);
        float ps = 0.f;
#pragma unroll
        for (int i = 0; i < 3; ++i) { const int jj = lane + 64 * i; const float p = (jj < nk) ? __builtin_amdgcn_exp2f(s[i] - nM) : 0.f; ps += p; if (jj < 129) pl[jj] = p; }
        den = den * so + wave_sum(ps); a0 *= so; a1 *= so; Mx = nM;
        LDS_WAIT(); asm volatile("" ::: "memory");
        const GAS unsigned* vp = (const GAS unsigned*)(VB + (size_t)m * QKVW + hoff) + lane;
        for (int jj = 0; jj < nk; ++jj) { const float p = pl[jj]; const unsigned w = vp[-(long)(d * jj) * (QKVW / 2)]; a0 += p * bflo(w); a1 += p * bfhi(w); }
        LDS_WAIT(); asm volatile("" ::: "memory");
    }
    const float inv = 1.0f / den;
    ((GAS unsigned*)(ATT + (size_t)m * GW + j * HD))[lane] = pk2(a0 * inv, a1 * inv);
}
typedef float f32x16 __attribute__((ext_vector_type(16)));
typedef short bf16x8_t __attribute__((ext_vector_type(8)));
typedef short s16x4_t __attribute__((ext_vector_type(4)));
constexpr int VPITCH = 272;
__device__ __forceinline__ int crow16(int i, int h) { return (i & 3) + 8 * (i >> 2) + 4 * h; }
__device__ __forceinline__ unsigned cvtpk(float lo, float hi) { typedef float f2 __attribute__((ext_vector_type(2))); typedef __bf16 b2 __attribute__((ext_vector_type(2))); const f2 v = {lo, hi}; const b2 b = __builtin_convertvector(v, b2); return __builtin_bit_cast(unsigned, b); }
__device__ __forceinline__ s16x4_t vtr(LAS const unsigned char* p) { typedef short v4i16_t __attribute__((ext_vector_type(4))); return __builtin_bit_cast(s16x4_t, __builtin_amdgcn_ds_read_tr16_b64_v4i16((LAS v4i16_t*)p)); }
__device__ __forceinline__ void attn_mfma_tile(const bf16* QB, const bf16* KB, const bf16* VB, bf16* NUM, float* ML, int item, LAS unsigned char* vlds, int lane) {
    const int blk = ((item & 63) + 21 * (item >> 11)) & 63, h = (item >> 6) & 7, bg = item >> 9, g = bg % 3, b = bg / 3;
    const int ds = 2 * g, d = 1 << ds, nbs = 6 - ds, r = blk >> nbs, ib = blk & ((1 << nbs) - 1), i0 = 32 * ib;
    const int r32 = lane & 31, hh = lane >> 5;
    const size_t colbase = (size_t)g * GW + h * HD;
    const int rowb = b * SEQ + r;
    const float sl = alibi_slope_log2e(g, h) * (float)d;
    const int rq = r32 - 4 * hh; const float slrq = sl * (float)rq;
    bf16x8_t qf[8];
    { const bf16* qrow = QB + (size_t)(rowb + d * (i0 + r32)) * QKVW + colbase + 8 * hh;
#pragma unroll
      for (int s_ = 0; s_ < 8; ++s_) qf[s_] = *(const GAS bf16x8_t*)(qrow + 16 * s_); }
    f32x16 S[5];
#pragma unroll
    for (int kb = 0; kb < 5; ++kb) {
        if (ib + kb >= 4) {
            const int kk0 = 32 * (ib + kb - 4);
            const bf16* krow = KB + (size_t)(rowb + d * (kk0 + r32)) * QKVW + colbase + 8 * hh;
            f32x16 acc;
#pragma unroll
            for (int i = 0; i < 16; ++i) acc[i] = 0.f;
#pragma unroll
            for (int s_ = 0; s_ < 8; ++s_) { const bf16x8_t kf = *(const GAS bf16x8_t*)(krow + 16 * s_); acc = __builtin_amdgcn_mfma_f32_32x32x16_bf16(kf, qf[s_], acc, 0, 0, 0); }
#pragma unroll
            for (int i = 0; i < 16; ++i) { const int ci = (i & 3) + 8 * (i >> 2);
                float v = fmaf(-sl, (float)(32 * (4 - kb) - ci), acc[i]) - slrq;
                if (kb == 0 && rq > ci) v = -INFINITY;
                if (kb == 4 && rq < ci) v = -INFINITY;
                acc[i] = v; }
            S[kb] = acc;
        } else {
#pragma unroll
            for (int i = 0; i < 16; ++i) S[kb][i] = -INFINITY;
        }
    }
    float mx = -INFINITY;
#pragma unroll
    for (int kb = 0; kb < 5; ++kb)
#pragma unroll
        for (int i = 0; i < 16; ++i) mx = fmaxf(mx, S[kb][i]);
    mx = fmaxf(mx, __shfl_xor(mx, 32));
    float den = 0.f;
#pragma unroll
    for (int kb = 0; kb < 5; ++kb)
#pragma unroll
        for (int i = 0; i < 16; ++i) { const float p = __builtin_amdgcn_exp2f(S[kb][i] - mx); S[kb][i] = p; den += p; }
    den += __shfl_xor(den, 32);
    f32x16 y[4];
#pragma unroll
    for (int c = 0; c < 4; ++c)
#pragma unroll
        for (int i = 0; i < 16; ++i) y[c][i] = 0.f;
    const int q4 = (lane & 15) >> 2, p4 = lane & 3, bk = (lane >> 4) & 1;
    LAS const unsigned char* vrd = vlds + (4 * hh + q4) * VPITCH + 32 * bk + 8 * p4;
#pragma unroll
    for (int kb = 0; kb < 5; ++kb) {
        if (ib + kb >= 4) {
            const int kk0 = 32 * (ib + kb - 4);
#pragma unroll
            for (int k = 0; k < 8; ++k) { const int id = lane + 64 * k, key = id >> 4, ch = id & 15;
                const v4u v = *(const GAS v4u*)(VB + (size_t)(rowb + d * (kk0 + key)) * QKVW + colbase + 8 * ch);
                *(LAS v4u*)(vlds + key * VPITCH + ch * 16) = v; }
#pragma unroll
            for (int s_ = 0; s_ < 2; ++s_) {
                v4u pk; pk.x = cvtpk(S[kb][8 * s_ + 0], S[kb][8 * s_ + 1]); pk.y = cvtpk(S[kb][8 * s_ + 2], S[kb][8 * s_ + 3]); pk.z = cvtpk(S[kb][8 * s_ + 4], S[kb][8 * s_ + 5]); pk.w = cvtpk(S[kb][8 * s_ + 6], S[kb][8 * s_ + 7]);
                const bf16x8_t xs = __builtin_bit_cast(bf16x8_t, pk);
#pragma unroll
                for (int c = 0; c < 4; ++c) { const s16x4_t lo = vtr(vrd + (16 * s_) * VPITCH + 64 * c), hi = vtr(vrd + (16 * s_ + 8) * VPITCH + 64 * c);
                    const bf16x8_t vf = __builtin_shufflevector(lo, hi, 0, 1, 2, 3, 4, 5, 6, 7);
                    y[c] = __builtin_amdgcn_mfma_f32_32x32x16_bf16(vf, xs, y[c], 0, 0, 0); }
            }
        }
    }
    const int m = rowb + d * (i0 + r32);
    bf16* np = NUM + ((size_t)g * MREAL + m) * GW + h * HD + 4 * hh;
#pragma unroll
    for (int c = 0; c < 4; ++c)
#pragma unroll
        for (int k = 0; k < 4; ++k) { v2u w; w.x = cvtpk(y[c][4 * k + 0], y[c][4 * k + 1]); w.y = cvtpk(y[c][4 * k + 2], y[c][4 * k + 3]); *(GAS v2u*)(np + 32 * c + 8 * k) = w; }
    if (hh == 0) { typedef float f2 __attribute__((ext_vector_type(2))); *(GAS f2*)(ML + (((size_t)g * MREAL + m) * NH + h) * 2) = (f2){mx, den}; }
}
__device__ __forceinline__ void attn_combine(const bf16* NUM, const float* ML, bf16* ATT, int gt, int NT) {
    typedef float f2 __attribute__((ext_vector_type(2)));
    for (int i = gt; i < MREAL * (GW / 8); i += NT) {
        const int m = i >> 7, c8 = i & 127, h = c8 >> 4;
        f2 st[3]; float M = -INFINITY;
#pragma unroll
        for (int g = 0; g < 3; ++g) { st[g] = *(const GAS f2*)(ML + (((size_t)g * MREAL + m) * NH + h) * 2); M = fmaxf(M, st[g].x); }
        float o[8] = {0.f, 0.f, 0.f, 0.f, 0.f, 0.f, 0.f, 0.f}; float dn = 0.f;
#pragma unroll
        for (int g = 0; g < 3; ++g) { const float e = __builtin_amdgcn_exp2f(st[g].x - M); dn += e * st[g].y;
            const v4u w = *(const GAS v4u*)(NUM + ((size_t)g * MREAL + m) * GW + 8 * c8);
            o[0] += e * bflo(w.x); o[1] += e * bfhi(w.x); o[2] += e * bflo(w.y); o[3] += e * bfhi(w.y); o[4] += e * bflo(w.z); o[5] += e * bfhi(w.z); o[6] += e * bflo(w.w); o[7] += e * bfhi(w.w); }
        const float inv = 1.0f / dn; v4u r; r.x = cvtpk(o[0] * inv, o[1] * inv); r.y = cvtpk(o[2] * inv, o[3] * inv); r.z = cvtpk(o[4] * inv, o[5] * inv); r.w = cvtpk(o[6] * inv, o[7] * inv);
        *(GAS v4u*)(ATT + (size_t)m * GW + 8 * c8) = r;
    }
}
template <int G_>
__device__ __forceinline__ void attn_sample_partial(const float* ck, const float* cv, const float* out, const bf16* QB, bf16* NUM, float* ML, int n, int j, LAS float* pl, int lane) {
    constexpr int d = G_ == 0 ? 1 : (G_ == 1 ? 4 : 16), W = G_ == 0 ? 128 : (G_ == 1 ? 512 : 2048);
    constexpr size_t OK_ = G_ == 0 ? O_KS0 : (G_ == 1 ? O_KS1 : O_KS2), OV_ = G_ == 0 ? O_VS0 : (G_ == 1 ? O_VS1 : O_VS2);
    const int m = MPR + n, g4 = lane >> 4, i16 = lane & 15;
    const float* nk_ = out + OK_ + ((size_t)n * W + (W - 1)) * GW + j * HD; const float* nv_ = out + OV_ + ((size_t)n * W + (W - 1)) * GW + j * HD;
    const float* kb = ck + (size_t)n * W * GW + j * HD; const float* vb = cv + (size_t)n * W * GW + j * HD;
    const float sl = alibi_slope_log2e(G_, j) * (float)d;
    float q[8];
    { const v4u w = *(const GAS v4u*)(QB + (size_t)m * QKVW + (size_t)G_ * GW + j * HD + 8 * i16);
      q[0] = bflo(w.x); q[1] = bfhi(w.x); q[2] = bflo(w.y); q[3] = bfhi(w.y); q[4] = bflo(w.z); q[5] = bfhi(w.z); q[6] = bflo(w.w); q[7] = bfhi(w.w); }
    float sc[3] = {-INFINITY, -INFINITY, -INFINITY};
#pragma unroll
    for (int c0 = 0; c0 < 33; c0 += 11) {
        f32x4 ka[11], kc[11];
#pragma unroll
        for (int u = 0; u < 11; ++u) { const int jj = 4 * (c0 + u) + g4; const int jc = jj <= 128 ? jj : 128;
            const float* kp = (jc == 0 ? nk_ : kb + (size_t)(W - d * jc) * GW) + 8 * i16; ka[u] = *(const GAS f32x4*)kp; kc[u] = *(const GAS f32x4*)(kp + 4); }
#pragma unroll
        for (int u = 0; u < 11; ++u) { const int c = c0 + u, jj = 4 * c + g4;
            float sdot = (ka[u].x * q[0] + ka[u].y * q[1]) + (ka[u].z * q[2] + ka[u].w * q[3]) + (kc[u].x * q[4] + kc[u].y * q[5]) + (kc[u].z * q[6] + kc[u].w * q[7]);
            sdot += __shfl_xor(sdot, 1); sdot += __shfl_xor(sdot, 2); sdot += __shfl_xor(sdot, 4); sdot += __shfl_xor(sdot, 8);
            const float sv = jj <= 128 ? sdot - sl * (float)jj : -INFINITY;
            if ((c & 15) == i16) sc[c >> 4] = sv; }
    }
    const float mx = wave_max(fmaxf(fmaxf(sc[0], sc[1]), sc[2]));
    float ps = 0.f;
#pragma unroll
    for (int k = 0; k < 3; ++k) { const int jj = 4 * (i16 + 16 * k) + g4; const float p = __builtin_amdgcn_exp2f(sc[k] - mx); ps += p; if (jj <= 128) pl[jj] = p; }
    const float den = wave_sum(ps);
    LDS_WAIT(); asm volatile("" ::: "memory");
    typedef float f32x2g __attribute__((ext_vector_type(2)));
    float a0 = 0.f, a1 = 0.f;
#pragma unroll 1
    for (int j0 = 0; j0 < 128; j0 += 16) { f32x2g vv[16];
#pragma unroll
        for (int u = 0; u < 16; ++u) { const int jj = j0 + u; const float* vp = jj == 0 ? nv_ : vb + (size_t)(W - d * jj) * GW; vv[u] = ((const GAS f32x2g*)vp)[lane]; }
#pragma unroll
        for (int u = 0; u < 16; ++u) { const float p = pl[j0 + u]; a0 += p * vv[u].x; a1 += p * vv[u].y; } }
    { const f32x2g v128 = ((const GAS f32x2g*)vb)[lane]; const float p = pl[128]; a0 += p * v128.x; a1 += p * v128.y; }
    LDS_WAIT(); asm volatile("" ::: "memory");
    ((GAS unsigned*)(NUM + ((size_t)G_ * MREAL + m) * GW + j * HD))[lane] = cvtpk(a0, a1);
    if (lane == 0) { *(GAS f32x2g*)(ML + (((size_t)G_ * MREAL + m) * NH + j) * 2) = (f32x2g){mx, den}; }
}
template <int WN>
__device__ __forceinline__ void pool_task(const float* UB, const float* sp, bf16* PL, int m, int c) {
    const f32x4 u0 = *(const GAS f32x4*)(UB + (size_t)m * PW + c); f32x4 r[WN - 1]; float wgt[WN - 1]; float cnt;
    if (m < MPR) { const int t = m & (SEQ - 1); cnt = (float)((t < WN - 1 ? t : WN - 1) + 1);
#pragma unroll
        for (int q = 1; q < WN; ++q) { const int qq = q <= t ? q : t; wgt[q - 1] = q <= t ? 1.f : 0.f; r[q - 1] = *(const GAS f32x4*)(UB + (size_t)(m - qq) * PW + c); } }
    else { const int n = m - MPR; cnt = (float)WN;
#pragma unroll
        for (int q = 1; q < WN; ++q) { wgt[q - 1] = 1.f; r[q - 1] = *(const GAS f32x4*)(sp + ((size_t)n * PHIST + (PHIST - q)) * PW + c); } }
    f32x4 tot = u0;
#pragma unroll
    for (int q = 1; q < WN; ++q) tot = tot + r[q - 1] * wgt[q - 1];
    const float ic = 1.0f / cnt; v2u o; o.x = pk2(tot.x * ic - u0.x, tot.y * ic - u0.y); o.y = pk2(tot.z * ic - u0.z, tot.w * ic - u0.w);
    *(GAS v2u*)(PL + (size_t)m * PW + c) = o;
}
template <int WN>
__device__ __forceinline__ void pool_chunk(const float* UB, bf16* PL, int b, int t0, int c) {
    const float* ub = UB + (size_t)b * SEQ * PW + c; bf16* pb = PL + (size_t)b * SEQ * PW + c;
    f32x4 ring[WN]; f32x4 tot = (f32x4){0.f, 0.f, 0.f, 0.f};
    if (t0 != 0) {
#pragma unroll
        for (int j = 0; j < WN; ++j) ring[j] = *(const GAS f32x4*)(ub + (size_t)(t0 - WN + j) * PW);
#pragma unroll
        for (int j = 0; j < WN; ++j) tot = tot + ring[j];
    } else {
#pragma unroll
        for (int j = 0; j < WN; ++j) ring[j] = (f32x4){0.f, 0.f, 0.f, 0.f};
    }
#pragma unroll
    for (int s0 = 0; s0 < 32; s0 += 16) {
        f32x4 nw[16];
#pragma unroll
        for (int u = 0; u < 16; ++u) nw[u] = *(const GAS f32x4*)(ub + (size_t)(t0 + s0 + u) * PW);
#pragma unroll
        for (int u = 0; u < 16; ++u) { const int s_ = s0 + u, t = t0 + s_; const f32x4 x = nw[u];
            tot = tot + (x - ring[s_ % WN]); ring[s_ % WN] = x;
            const int cn = t + 1 < WN ? t + 1 : WN; const float ic = 1.0f / (float)cn;
            v2u o; o.x = pk2(tot.x * ic - x.x, tot.y * ic - x.y); o.y = pk2(tot.z * ic - x.z, tot.w * ic - x.w);
            *(GAS v2u*)(pb + (size_t)t * PW) = o; }
    }
}
__device__ __forceinline__ void pool_naive(const Frame& F, const float* UB, bf16* PL, int gt, int NT) {
    constexpr int C4 = PW / 4, NCH = SEQ / 32;
    for (int i = gt; i < NB * NCH * C4; i += NT) {
        const int c4 = i % C4, rc = (i / C4) % NCH, b = i / (C4 * NCH), c = 4 * c4; const int grp = __builtin_amdgcn_readfirstlane(c >> 9);
        if (grp == 0) pool_chunk<2>(UB, PL, b, 32 * rc, c); else if (grp == 1) pool_chunk<4>(UB, PL, b, 32 * rc, c); else if (grp == 2) pool_chunk<8>(UB, PL, b, 32 * rc, c); else pool_chunk<16>(UB, PL, b, 32 * rc, c);
    }
    for (int i = gt; i < NSMP * C4; i += NT) {
        const int n = i / C4, c = 4 * (i - n * C4); const int grp = __builtin_amdgcn_readfirstlane(c >> 9);
        if (grp == 0) pool_task<2>(UB, F.p_SP, PL, MPR + n, c); else if (grp == 1) pool_task<4>(UB, F.p_SP, PL, MPR + n, c); else if (grp == 2) pool_task<8>(UB, F.p_SP, PL, MPR + n, c); else pool_task<16>(UB, F.p_SP, PL, MPR + n, c);
    }
}
constexpr int SK_RED_PITCH = 33;
template <int NACC, bool PERM, bool AIMG = false>
__device__ __forceinline__ void skinny_partial(const bf16* A, int lda, const bf16* B, int brow0, int K, LAS float* red, int wave, int lane) {
    const int r32 = lane & 31, hh = lane >> 5, ks = K >> 3, nst = ks >> 4, nt = K >> 6; const unsigned ku0 = (unsigned)(__builtin_amdgcn_readfirstlane(wave) * ks);
    const bf16* ap = A + (size_t)r32 * lda + wave * ks + 8 * hh;
    const GAS char* bb = (const GAS char*)B;
    const unsigned rb0 = (unsigned)pg8::bl_off<PERM>(brow0 + r32, 0, nt), x5 = rb0 & 32u, rbase = (rb0 ^ x5) + 16u * (unsigned)hh;
    const unsigned ra0 = (unsigned)pg8::bl_off<false>(MPR + r32, 0, nt), ax5 = ra0 & 32u, aloE = ((ra0 ^ ax5) + 16u * (unsigned)hh) + (ax5 ^ ((ku0 & 16u) << 1)), aloO = aloE ^ 32u;
    const unsigned loE = rbase + (x5 ^ ((ku0 & 16u) << 1)), loO = loE ^ 32u;
    f32x16 acc0, acc1;
#pragma unroll
    for (int i = 0; i < 16; ++i) { acc0[i] = 0.f; acc1[i] = 0.f; }
#pragma unroll 16
    for (int s_ = 0; s_ < nst; ++s_) {
        const unsigned ku = ku0 + 16u * (unsigned)s_; const GAS char* sb = bb + (size_t)((ku >> 6) * 32768u + ((ku >> 5) & 1u) * 1024u); const unsigned bo = (s_ & 1) ? loO : loE;
        const bf16x8_t af = AIMG ? *(const GAS bf16x8_t*)((const GAS char*)A + (size_t)((ku >> 6) * 32768u + ((ku >> 5) & 1u) * 1024u) + ((s_ & 1) ? aloO : aloE)) : *(const GAS bf16x8_t*)(ap + 16 * s_);
        const bf16x8_t bf0 = *(const GAS bf16x8_t*)(sb + bo);
        acc0 = __builtin_amdgcn_mfma_f32_32x32x16_bf16(af, bf0, acc0, 0, 0, 0);
        if (NACC == 2) { const bf16x8_t bf1 = *(const GAS bf16x8_t*)(sb + bo + 16384); acc1 = __builtin_amdgcn_mfma_f32_32x32x16_bf16(af, bf1, acc1, 0, 0, 0); }
    }
    LAS float* rw = red + wave * (NACC * 32 * SK_RED_PITCH);
#pragma unroll
    for (int i = 0; i < 16; ++i) { rw[crow16(i, hh) * SK_RED_PITCH + r32] = acc0[i]; if (NACC == 2) rw[(32 + crow16(i, hh)) * SK_RED_PITCH + r32] = acc1[i]; }
}
template <int NACC>
__device__ __forceinline__ void skinny_reduce(LAS const float* red, int tid, float (&v)[NACC][2]) {
    const int row = tid >> 4, c = (tid & 15) * 2;
#pragma unroll
    for (int a = 0; a < NACC; ++a) { float s0 = 0.f, s1 = 0.f;
#pragma unroll
        for (int w = 0; w < NWAVES; ++w) { const LAS float* p = red + w * (NACC * 32 * SK_RED_PITCH) + (a * 32 + row) * SK_RED_PITCH + c; s0 += p[0]; s1 += p[1]; }
        v[a][0] = s0; v[a][1] = s1; }
}
__device__ __forceinline__ void skinny_share(int nmain, int G, int c, int& idx, int& share) { const int first = nmain % G; if (first == 0) { idx = c; share = G; } else { idx = c - first; share = G - first; } }

__device__ __forceinline__ void final_norm_row(float* yrow, const float* gain, int lane) {
    GAS f32x4* xr = (GAS f32x4*)yrow + lane; const GAS f32x4* gr = (const GAS f32x4*)gain + lane;
    f32x4 v[16]; float s = 0.f;
#pragma unroll
    for (int j = 0; j < 16; ++j) { v[j] = xr[64 * j]; s += (v[j].x * v[j].x + v[j].y * v[j].y) + (v[j].z * v[j].z + v[j].w * v[j].w); }
    const float rstd = 1.0f / sqrtf(wave_sum(s) * (1.0f / D) + RMS_EPS);
#pragma unroll
    for (int j = 0; j < 16; ++j) { const f32x4 g = gr[64 * j]; xr[64 * j] = v[j] * rstd * g; }
}

typedef float f32x2e __attribute__((ext_vector_type(2)));
__device__ __forceinline__ float sigm(float x) { return __builtin_amdgcn_rcpf(1.0f + __builtin_amdgcn_exp2f(-1.4426950408889634f * x)); }
__device__ __forceinline__ void sk_emit_in(bf16* QB, size_t qkv_stride, bf16* GB, float* UB, float* out, float qscale, int n, int col, float v0, float v1) {
    const size_t m = (size_t)(MPR + n);
    if (col < 3 * QKVW) {
        const int which = col / QKVW, c3 = col - which * QKVW; const float sc = which == 0 ? qscale : 1.0f;
        *(GAS unsigned*)(QB + (size_t)which * qkv_stride + m * QKVW + c3) = cvtpk(v0 * sc, v1 * sc);
        if (which != 0) { const int g = c3 / GW, cg = c3 - g * GW, W = g == 0 ? 128 : (g == 1 ? 512 : 2048);
            float* os = out + (g == 0 ? (which == 1 ? O_KS0 : O_VS0) : g == 1 ? (which == 1 ? O_KS1 : O_VS1) : (which == 1 ? O_KS2 : O_VS2)) + ((size_t)n * W + (W - 1)) * GW + cg;
            *(GAS f32x2e*)os = (f32x2e){v0, v1}; }
    } else if (col < 3 * QKVW + PW) {
        const int c = col - 3 * QKVW; *(GAS f32x2e*)(UB + m * PW + c) = (f32x2e){v0, v1}; *(GAS f32x2e*)(out + O_PS + ((size_t)n * PHIST + (PHIST - 1)) * PW + c) = (f32x2e){v0, v1};
    } else { const int c = col - (3 * QKVW + PW); *(GAS unsigned*)(GB + m * (2 * D) + c) = cvtpk(sigm(v0), sigm(v1)); }
}
__device__ __forceinline__ void sk_emit_pool(const bf16* GB, const float* pscale, bf16* T, int n, int col, float v0, float v1) {
    const size_t m = (size_t)(MPR + n); const unsigned g = *(const GAS unsigned*)(GB + m * (2 * D) + D + col); const f32x2e ps = *(const GAS f32x2e*)(pscale + col);
    *(GAS unsigned*)(T + m * D + col) = cvtpk(v0 * ps.x * bflo(g), v1 * ps.y * bfhi(g));
}
__device__ __forceinline__ void sk_emit_up(const bf16* GB, const bf16* T, bf16* MIX, int n, int col, float v0, float v1) {
    const size_t m = (size_t)(MPR + n); const unsigned g = *(const GAS unsigned*)(GB + m * (2 * D) + col), t = *(const GAS unsigned*)(T + m * D + col);
    *(GAS unsigned*)(MIX + m * D + col) = cvtpk(v0 * bflo(g) + bflo(t), v1 * bfhi(g) + bfhi(t));
}
__device__ __forceinline__ void sk_emit_out(const float* xs, float* y, bf16* X1B, float* rowss, int n, int col, float v0, float v1, int tid) {
    const size_t m = (size_t)(MPR + n); const f32x2e x = *(const GAS f32x2e*)(xs + (size_t)n * D + col); const float o0 = x.x + v0, o1 = x.y + v1;
    *(GAS f32x2e*)(y + m * D + col) = (f32x2e){o0, o1}; *(GAS unsigned*)((GAS char*)X1B + pg8::bl_off<false>((int)m, col, D / 64)) = cvtpk(o0, o1);
    float ss = o0 * o0 + o1 * o1; ss += __shfl_xor(ss, 1); ss += __shfl_xor(ss, 2); ss += __shfl_xor(ss, 4); ss += __shfl_xor(ss, 8);
    if ((tid & 15) == 0) atomicAdd(rowss + m, ss);
}
__device__ __forceinline__ void sk_emit_ff(const float* rowss, bf16* FFB, int n, int f, float g0, float g1, float u0, float u1) {
    const size_t m = (size_t)(MPR + n); const float r = 1.0f / sqrtf(rowss[m] * (1.0f / D) + RMS_EPS); g0 *= r; g1 *= r; u0 *= r; u1 *= r;
    *(GAS unsigned*)(FFB + m * FF + f) = cvtpk(g0 * sigm(g0) * u0, g1 * sigm(g1) * u1);
}
__device__ __forceinline__ void sk_emit_down(float* y, int n, int col, float v0, float v1) {
    GAS f32x2e* p = (GAS f32x2e*)(y + (size_t)(MPR + n) * D + col); const f32x2e b = *p; *p = (f32x2e){b.x + v0, b.y + v1};
}

__device__ __forceinline__ int lane_now() { int l; asm volatile("v_mbcnt_lo_u32_b32 %0, -1, 0\n\tv_mbcnt_hi_u32_b32 %0, -1, %0" : "=v"(l)); return l; }
struct BgStream {
    unsigned long long src, dst, pdst, dump;
    unsigned left;
    f32x4 data; unsigned voff;
    __device__ __forceinline__ void init(const float* k0, const float* v0, const float* k1, const float* v1, const float* k2, const float* v2, float* out, unsigned char* dump_, int gwave) {
        dump = (unsigned long long)(uintptr_t)dump_; pdst = dump; src = (unsigned long long)(uintptr_t)k0; dst = dump; left = 0u;
        const int slot = gwave & 31; if (slot >= 24) return;
        const int w = (gwave >> 5) * 24 + slot; const float* sb; size_t db; int W, n, start, count;
        if (w < 1088) { const int t = w / 544, rem = w - t * 544, piece = rem % 17; n = rem / 17; W = 2048; start = piece * 482; count = (start + 482 <= 8188) ? 482 : 8188 - start; if (t == 0) { sb = k2; db = O_KS2; } else { sb = v2; db = O_VS2; } }
        else if (w < 1408) { const int rem0 = w - 1088, t = rem0 / 160, r2 = rem0 - t * 160, piece = r2 % 5; n = r2 / 5; W = 512; start = piece * 409; count = (start + 409 <= 2044) ? 409 : 2044 - start; if (t == 0) { sb = k1; db = O_KS1; } else { sb = v1; db = O_VS1; } }
        else { const int rem0 = w - 1408, t = rem0 >> 6, r2 = rem0 & 63; n = r2 >> 1; W = 128; start = (r2 & 1) * 254; count = 254; if (t == 0) { sb = k0; db = O_KS0; } else { sb = v0; db = O_VS0; } }
        src = (unsigned long long)(uintptr_t)sb + ((size_t)n * W + 1) * 4096 + (size_t)start * 1024; dst = (unsigned long long)(uintptr_t)out + db * 4 + (size_t)n * W * 4096 + (size_t)start * 1024; left = (unsigned)count;
    }
    __device__ __forceinline__ void begin(int lane) { voff = (unsigned)lane * 16u; data = (f32x4){0.f, 0.f, 0.f, 0.f}; pdst = dump; }
    __device__ __forceinline__ void step() {
        if (left) {
            asm volatile("global_store_dwordx4 %1, %0, %2 nt\n\tglobal_load_dwordx4 %0, %1, %3 nt" : "+v"(data) : "v"(voff), "s"(pdst), "s"(src) : "memory");
            pdst = dst; src += 1024; dst += 1024; --left;
        }
    }
    __device__ __forceinline__ void flush() {
        asm volatile("s_waitcnt vmcnt(0)\n\tglobal_store_dwordx4 %1, %0, %2 nt" : : "v"(data), "v"(voff), "s"(pdst) : "memory");
        pdst = dump;
    }
};

struct Args { const float* in[20]; float* out; unsigned char* ws; int ph_lo, ph_hi; };
__global__ void __launch_bounds__(NWAVES * 64, 2) mega_fwd(Args args) {
    extern __shared__ __attribute__((aligned(16))) unsigned char lds[];
    Frame F;
    F.lds = (LAS unsigned char*)lds;
    F.MISC = (volatile LAS unsigned*)(F.lds + MISC_OFF);
    F.tid = threadIdx.x; F.lane = F.tid & 63; F.wave = __builtin_amdgcn_readfirstlane(F.tid >> 6);
    F.G = gridDim.x; { const int bx = blockIdx.x; F.vcu = (F.G % 8 == 0) ? (bx % 8) * (F.G / 8) + bx / 8 : bx; }
    F.ws = args.ws; F.out = args.out; F.ctl = (gu32*)(args.ws + WS_CTL);
    F.p_XP = args.in[I_XP]; F.p_XS = args.in[I_XS]; F.p_CK0 = args.in[I_CK0]; F.p_CV0 = args.in[I_CV0]; F.p_CK1 = args.in[I_CK1]; F.p_CV1 = args.in[I_CV1]; F.p_CK2 = args.in[I_CK2]; F.p_CV2 = args.in[I_CV2]; F.p_SP = args.in[I_SP]; F.p_NMIX = args.in[I_NMIX]; F.p_WIN = args.in[I_WIN]; F.p_WUP = args.in[I_WUP]; F.p_WPOOL = args.in[I_WPOOL]; F.p_PSCALE = args.in[I_PSCALE]; F.p_WOUT = args.in[I_WOUT]; F.p_NFFN = args.in[I_NFFN]; F.p_WG = args.in[I_WG]; F.p_WU = args.in[I_WU]; F.p_WD = args.in[I_WD]; F.p_NFIN = args.in[I_NFIN];
    for (int u = F.tid; u < (LDS_BYTES - LDSCTL_OFF) / 4; u += NWAVES * 64) ((LAS unsigned*)(F.lds + LDSCTL_OFF))[u] = 0u;
    __syncthreads();
    XcdBarrier bar; bar.bar = (unsigned*)(F.ctl + CW_BAR); bar.x = 0; bar.st = nullptr;
    if (N_LAUNCHES != PER_PHASE) bar = xcd_barrier_post((unsigned*)(F.ctl + CW_BAR), F.MISC + 8);
#define GRID_BAR() do { if (N_LAUNCHES != PER_PHASE) xcd_barrier(bar); } while (0)
    const int lo = args.ph_lo, hi = args.ph_hi;
#define IN(k) (lo <= (k) && (k) < hi)
#define BOTH(k) (IN(k) && IN((k) + 1))
    bf16* WIN = (bf16*)(F.ws + WS_WIN); bf16* WUP = (bf16*)(F.ws + WS_WUP); bf16* WPL = (bf16*)(F.ws + WS_WPL); bf16* WOUT = (bf16*)(F.ws + WS_WOUT); bf16* WGU = (bf16*)(F.ws + WS_WGU); bf16* WDN = (bf16*)(F.ws + WS_WDN);
    bf16* HN = (bf16*)(F.ws + WS_HN); bf16* QB = (bf16*)(F.ws + WS_QB); bf16* KB = (bf16*)(F.ws + WS_KB); bf16* VB = (bf16*)(F.ws + WS_VB); float* UB = (float*)(F.ws + WS_UB); bf16* GB = (bf16*)(F.ws + WS_GB);
    bf16* ATT = (bf16*)(F.ws + WS_ATT); bf16* PL = (bf16*)(F.ws + WS_PL); bf16* TB = (bf16*)(F.ws + WS_T); bf16* MIX = (bf16*)(F.ws + WS_MIX); bf16* X1B = (bf16*)(F.ws + WS_X1B); bf16* FFB = (bf16*)(F.ws + WS_FFB);
    float* rowss = (float*)(args.ws + WS_CTL) + CW_RSS;
    bf16* NUMB = (bf16*)(F.ws + WS_FFB); float* MLB = (float*)(F.ws + WS_FFB + 64 * MiB);
    const int gw = F.vcu * NWAVES + F.wave, NGW = F.G * NWAVES;
    pg8::NoBg nobg;
    BgStream bgs; bgs.init(F.p_CK0, F.p_CV0, F.p_CK1, F.p_CV1, F.p_CK2, F.p_CV2, F.out, F.ws + WS_DUMP + (size_t)(F.vcu * NWAVES + F.wave) * 1024, F.vcu * NWAVES + F.wave); bgs.begin(lane_now());
    LAS float* SKRED = (LAS float*)(F.lds + RING_OFF);

    if (IN(0)) { p0_prologue(F); if (BOTH(0)) GRID_BAR(); }

    if (IN(1)) {
        pg8::Gemm g{HN, WIN, D, D, 30, 0}; pg8::StaticOrder S; S.init(MPR, INW, F.G, (int)blockIdx.x);
        static_assert(WS_KB - WS_QB == WS_VB - WS_KB, "q/k/v buffers equally spaced");
        pg8::EpiIn E{QB, (WS_KB - WS_QB) / 2, GB, UB, F.out, 0.08838834764831845f * 1.4426950408889634f};
        pg8::gemm_phase<pg8::EpiIn, pg8::StaticOrder, true, true, pg8::NoBg, true>(F.lds + RING_OFF, g, S, E, nobg);
        { int idx, share; skinny_share((MPR / 256) * (INW / 256), F.G, (int)blockIdx.x, idx, share);
          if (idx >= 0) for (int t = idx; t < INW / 32; t += share) {
              skinny_partial<1, true, true>(HN, D, WIN, 32 * t, D, SKRED, F.wave, F.lane); LDS_WAIT(); __syncthreads();
              float v[1][2]; skinny_reduce<1>(SKRED, F.tid, v);
              sk_emit_in(QB, (WS_KB - WS_QB) / 2, GB, UB, F.out, 0.08838834764831845f * 1.4426950408889634f, F.tid >> 4, 32 * t + 2 * (F.tid & 15), v[0][0], v[0][1]); __syncthreads(); } }
        if (BOTH(1)) GRID_BAR();
    }

    if (IN(2)) {
        LAS unsigned char* wb = F.lds + RING_OFF + F.wave * 16384;
        LAS float* pl = (LAS float*)(wb + 9216);
        _Pragma("unroll 1") for (int ph = 0; ph < 2; ++ph) {
            if ((ph == 0) == (F.wave < 4)) p2_convert_wgu(F, (LAS float*)wb, gw, NGW);
            else { for (int it = gw; it < NB * 3 * NH * 64; it += NGW) attn_mfma_tile(QB, KB, VB, NUMB, MLB, it, wb, F.lane); }
        }
        if (F.wave < 3) { const int t = F.vcu * 3 + F.wave;
            if (t < NSMP * NH * 3) { const int gq = t % 3, nj = t / 3, n = nj >> 3, j = nj & 7;
                if (gq == 0) attn_sample_partial<0>(F.p_CK0, F.p_CV0, F.out, QB, NUMB, MLB, n, j, pl, F.lane);
                else if (gq == 1) attn_sample_partial<1>(F.p_CK1, F.p_CV1, F.out, QB, NUMB, MLB, n, j, pl, F.lane);
                else attn_sample_partial<2>(F.p_CK2, F.p_CV2, F.out, QB, NUMB, MLB, n, j, pl, F.lane); } }
        pool_naive(F, UB, PL, F.vcu * (NWAVES * 64) + F.tid, F.G * NWAVES * 64);
        if (BOTH(2)) GRID_BAR();
    }

    if (IN(3)) {
        attn_combine(NUMB, MLB, ATT, F.vcu * (NWAVES * 64) + F.tid, F.G * NWAVES * 64);
        pg8::Gemm g{PL, WPL, 512, PW, 2, 512 * 2}; pg8::StaticOrder S; S.init(MPR, D, F.G, (int)blockIdx.x);
        pg8::EpiPool E{GB, F.p_PSCALE, TB};
        pg8::gemm_phase<pg8::EpiPool, pg8::StaticOrder, true, true>(F.lds + RING_OFF, g, S, E, nobg);
        { int idx, share; skinny_share((MPR / 256) * (D / 256), F.G, (int)blockIdx.x, idx, share);
          if (idx >= 0) for (int t = idx; t < D / 32; t += share) {
              skinny_partial<1, true>(PL + (size_t)MPR * PW + (t >> 5) * 512, PW, WPL, 32 * t, 512, SKRED, F.wave, F.lane); LDS_WAIT(); __syncthreads();
              float v[1][2]; skinny_reduce<1>(SKRED, F.tid, v);
              sk_emit_pool(GB, F.p_PSCALE, TB, F.tid >> 4, 32 * t + 2 * (F.tid & 15), v[0][0], v[0][1]); __syncthreads(); } }
        if (BOTH(3)) GRID_BAR();
    }
    if (IN(4)) {
        pg8::Gemm g{ATT, WUP, GW, GW, 30, 0}; pg8::StaticOrder S; S.init(MPR, D, F.G, (int)blockIdx.x);
        pg8::EpiUp E{GB, TB, MIX};
        pg8::gemm_phase<pg8::EpiUp, pg8::StaticOrder, true, true>(F.lds + RING_OFF, g, S, E, nobg);
        { int idx, share; skinny_share((MPR / 256) * (D / 256), F.G, (int)blockIdx.x, idx, share);
          if (idx >= 0) for (int t = idx; t < D / 32; t += share) {
              skinny_partial<1, true>(ATT + (size_t)MPR * GW, GW, WUP, 32 * t, GW, SKRED, F.wave, F.lane); LDS_WAIT(); __syncthreads();
              float v[1][2]; skinny_reduce<1>(SKRED, F.tid, v);
              sk_emit_up(GB, TB, MIX, F.tid >> 4, 32 * t + 2 * (F.tid & 15), v[0][0], v[0][1]); __syncthreads(); } }
        if (BOTH(4)) GRID_BAR();
    }

    if (IN(5)) {
        pg8::Gemm g{MIX, WOUT, D, D, 30, 0}; pg8::StaticOrder S; S.init(MPR, D, F.G, (int)blockIdx.x);
        pg8::EpiOut E{F.p_XP, F.p_XS, F.out + O_Y, X1B, rowss};
        pg8::gemm_phase<pg8::EpiOut, pg8::StaticOrder, true, true>(F.lds + RING_OFF, g, S, E, nobg);
        { int idx, share; skinny_share((MPR / 256) * (D / 256), F.G, (int)blockIdx.x, idx, share);
          if (idx >= 0) for (int t = idx; t < D / 32; t += share) {
              skinny_partial<1, false>(MIX + (size_t)MPR * D, D, WOUT, 32 * t, D, SKRED, F.wave, F.lane); LDS_WAIT(); __syncthreads();
              float v[1][2]; skinny_reduce<1>(SKRED, F.tid, v);
              sk_emit_out(F.p_XS, F.out + O_Y, X1B, rowss, F.tid >> 4, 32 * t + 2 * (F.tid & 15), v[0][0], v[0][1], F.tid); __syncthreads(); } }
        if (BOTH(5)) GRID_BAR();
    }

    if (IN(6)) {
        pg8::Gemm g{X1B, WGU, D, D, 30, 0}; pg8::StaticOrder S; S.init(MPR, 2 * FF, F.G, (int)blockIdx.x);
        pg8::EpiFF E{rowss, FFB};
        bgs.begin(lane_now());
        pg8::gemm_phase<pg8::EpiFF, pg8::StaticOrder, true, true, BgStream, true>(F.lds + RING_OFF, g, S, E, bgs);
        { int idx, share; skinny_share((MPR / 256) * (2 * FF / 256), F.G, (int)blockIdx.x, idx, share);
          if (idx >= 0) for (int t = idx; t < FF / 32; t += share) { const int f0 = 32 * t;
              skinny_partial<2, true, true>(X1B, D, WGU, (f0 >> 7) * 256 + (f0 & 127), D, SKRED, F.wave, F.lane); LDS_WAIT(); __syncthreads();
              float v[2][2]; skinny_reduce<2>(SKRED, F.tid, v);
              sk_emit_ff(rowss, FFB, F.tid >> 4, f0 + 2 * (F.tid & 15), v[0][0], v[0][1], v[1][0], v[1][1]); __syncthreads(); } }
        if (BOTH(6)) GRID_BAR();
    }

    if (IN(7)) {
        pg8::Gemm g{FFB, WDN, FF, FF, 30, 0}; pg8::StaticOrder S; S.init(MPR, D, F.G, (int)blockIdx.x);
        pg8::EpiDown E{F.out + O_Y};
        bgs.begin(lane_now());
        pg8::gemm_phase<pg8::EpiDown, pg8::StaticOrder, true, true, BgStream>(F.lds + RING_OFF, g, S, E, bgs);
        { int idx, share; skinny_share((MPR / 256) * (D / 256), F.G, (int)blockIdx.x, idx, share);
          if (idx >= 0) for (int t = idx; t < D / 32; t += share) {
              skinny_partial<1, false>(FFB + (size_t)MPR * FF, FF, WDN, 32 * t, FF, SKRED, F.wave, F.lane); LDS_WAIT(); __syncthreads();
              float v[1][2]; skinny_reduce<1>(SKRED, F.tid, v);
              sk_emit_down(F.out + O_Y, F.tid >> 4, 32 * t + 2 * (F.tid & 15), v[0][0], v[0][1]); __syncthreads(); } }
        if (BOTH(7)) GRID_BAR();
    }

    if (IN(8)) {
        bgs.begin(lane_now());
        while (bgs.left) { asm volatile("s_waitcnt vmcnt(0)" ::: "memory"); bgs.step(); }
        bgs.flush();
        { const int ln = lane_now(); for (int m = gw; m < MREAL; m += NGW) final_norm_row(F.out + O_Y + (size_t)m * D, F.p_NFIN, ln); }
    }
#undef IN
#undef BOTH
#undef GRID_BAR
}

extern "C" void kernel_launch(void* const* d_in, const int* in_sizes, int n_in, void* d_out, int out_size, void* d_ws, size_t ws_size, hipStream_t stream) {
    static int grid = 0;
    if (grid == 0) {
        if (n_in != 20 || in_sizes[0] != MPR * D || (size_t)out_size != O_END || ws_size < WS_END) {
            fprintf(stderr, "kernel_launch: shape mismatch: n_in %d in0 %d out %d (want %zu) ws %zu (want %zu); nothing launched\n", n_in, n_in > 0 ? in_sizes[0] : -1, out_size, (size_t)O_END, ws_size, (size_t)WS_END); grid = -1; return; }
        int dev = 0, cus = 0, per_cu = 0;
        if (hipGetDevice(&dev) != hipSuccess || hipDeviceGetAttribute(&cus, hipDeviceAttributeMultiprocessorCount, dev) != hipSuccess) { grid = -1; return; }
        if (hipFuncSetAttribute((const void*)mega_fwd, hipFuncAttributeMaxDynamicSharedMemorySize, LDS_BYTES) != hipSuccess) { fprintf(stderr, "kernel_launch: hipFuncSetAttribute failed\n"); grid = -1; return; }
        if (hipOccupancyMaxActiveBlocksPerMultiprocessor(&per_cu, (const void*)mega_fwd, NWAVES * 64, LDS_BYTES) != hipSuccess || per_cu < 1) { fprintf(stderr, "kernel_launch: occupancy query says %d blocks per CU\n", per_cu); }
        (void)hipGetLastError();
        grid = cus;
    }
    if (grid < 0) return;
    (void)hipMemsetAsync((char*)d_ws + WS_CTL, 0, CTL_ZERO_BYTES, stream);
    Args a{};
    for (int i = 0; i < 20; ++i) a.in[i] = (const float*)d_in[i];
    a.out = (float*)d_out; a.ws = (unsigned char*)d_ws;
    for (int li = 0; li < N_LAUNCHES; ++li) {
        a.ph_lo = (N_LAUNCHES == PER_PHASE) ? li : 0; a.ph_hi = (N_LAUNCHES == PER_PHASE) ? li + 1 : PER_PHASE;
        hipLaunchKernelGGL(mega_fwd, dim3(grid), dim3(NWAVES * 64), LDS_BYTES, stream, a);
    }
}
```

```cpp
#include <hip/hip_runtime.h>
#include <cstdio>
#include <cstdint>
#include <cmath>
namespace pg8 {
#define PG8_LAS __attribute__((address_space(3)))
typedef unsigned short bf16_t;
typedef short bf16x8 __attribute__((ext_vector_type(8)));
typedef float f32x4 __attribute__((ext_vector_type(4)));
typedef unsigned u32x4 __attribute__((ext_vector_type(4)));
constexpr int BM = 256, BK = 64, HALF = 128, HTB = HALF * BK * 2  , STAGE_BYTES = 8 * HTB, NXCD = 8, WGM = 8;

__host__ __device__ __forceinline__ int lds_byte(int r, int c) { const int st = (r >> 4) * 2 + (c >> 5), rr = r & 15, cc = c & 31, ob = rr * 64 + cc * 2; return st * 1024 + (ob ^ (((ob >> 9) & 1) << 5)); }
__host__ __device__ __forceinline__ void stage_rc(int b, int& R, int& C) { const int st = b / 1024, sb = b % 1024, swz = sb ^ (((sb >> 9) & 1) << 5); R = (st >> 1) * 16 + swz / 64; C = (st & 1) * 32 + (swz % 64) / 2; }
__host__ __device__ __forceinline__ int perm32(int rho) { const int n = rho >> 4, i = rho & 15; return 8 * (i >> 2) + 4 * n + (i & 3); }
template <bool PERM> __host__ __device__ __forceinline__ size_t bl_off(int row, int k, int nt) {
    const int r128 = row & 127, w = r128 & 31;
    const int R = PERM ? ((r128 & 96) + ((w >> 2) & 1) * 16 + (w >> 3) * 4 + (w & 3)) : r128;
    return (((size_t)(row >> 8) * nt + (k >> 6)) * 2 + ((row >> 7) & 1)) * 16384 + (size_t)lds_byte(R, k & 63);
}

struct Unit { int pm, pn; };
struct Gemm { const bf16_t* A; const bf16_t* Bt; int K, lda, ashift; size_t astride; };

struct StaticOrder {
    int nM, nN, nwg, G, c;
    __host__ __device__ void init(int M, int N, int G_, int c_) { nM = M / BM; nN = N / BM; nwg = nM * nN; G = G_; c = c_; }
    __host__ __device__ bool next(int i, Unit& u) const {
        const long L = (long)i * G + c; if (L >= nwg) return false;
        int wgid = (int)L; { const int q = nwg / NXCD, r = nwg % NXCD, xcd = wgid % NXCD, off = wgid / NXCD; wgid = (xcd < r ? xcd * (q + 1) : r * (q + 1) + (xcd - r) * q) + off; }
        const int nig = WGM * nN, gid = wgid / nig, fm = gid * WGM, gsz = (nM - fm) < WGM ? (nM - fm) : WGM;
        u.pm = fm + ((wgid % nig) % gsz); u.pn = (wgid % nig) / gsz; return true;
    }
    __device__ __forceinline__ void a_ready(const Unit&) const {}
    __device__ __forceinline__ void done(const Unit&) const {}
};

typedef float f32x2_cv __attribute__((ext_vector_type(2))); typedef __bf16 bf16x2_cv __attribute__((ext_vector_type(2)));
__device__ __forceinline__ unsigned cvt_pk_bf16(float lo, float hi) { const f32x2_cv v = {lo, hi}; const bf16x2_cv b = __builtin_convertvector(v, bf16x2_cv); return __builtin_bit_cast(unsigned, b); }
typedef float f32x2 __attribute__((ext_vector_type(2)));

struct NoBg { __device__ __forceinline__ void step() {} __device__ __forceinline__ void flush() {} };
template <class Epi, class Sched, bool ALIGN_EPI = false, bool SP2 = false, class Bg = NoBg, bool AIMG = false>
__device__ __forceinline__ void gemm_phase(PG8_LAS unsigned char* lds, const Gemm g, const Sched& S, const Epi& E, Bg& bg) {
    const int tid = threadIdx.x, wid = __builtin_amdgcn_readfirstlane(tid >> 6), lane = tid & 63, wr = wid >> 2, wc = wid & 3, fr = lane & 15, fq = lane >> 4;
    const int K = g.K, nt = K / BK, lda = g.lda;
    unsigned voffA[2], voffB[2];
#pragma unroll
    for (int i = 0; i < 2; ++i) { int R, C; stage_rc(tid * 16 + i * 8192, R, C); const int Rb = Epi::PERM ? ((R & ~31) + perm32(R & 31)) : R;
        voffA[i] = AIMG ? (unsigned)(tid * 16 + i * 8192) : (unsigned)(R * lda + C) * 2u; voffB[i] = (unsigned)(tid * 16 + i * 8192); (void)Rb; }
    const size_t kstep = AIMG ? (size_t)(2 * HTB) : (size_t)(BK * 2);
    const size_t kstepB = (size_t)(2 * HTB);
    const size_t hsB = (size_t)HTB, hsA = AIMG ? (size_t)HTB : (size_t)HALF * lda * 2;
    const size_t tsB = (size_t)nt * kstepB, tsA = AIMG ? (size_t)nt * kstep : 2 * hsA;
    const unsigned ldsw = (unsigned)wid * 1024u;
    const int aoff = lds_byte(wr * 64 + fr, fq * 8), boff = lds_byte(wc * 32 + fr, fq * 8);
#define PG8_SA(b, h) (((b) * 2 + (h)) * HTB)
#define PG8_SB(b, h) ((4 + (b) * 2 + (h)) * HTB)
#define PG8_STAGE(bufoff, gbase, voff) do { _Pragma("unroll") for (int _i = 0; _i < 2; ++_i) \
        __builtin_amdgcn_global_load_lds((const unsigned*)((const char*)(gbase) + (voff)[_i]), (PG8_LAS unsigned*)(lds + (bufoff) + ldsw + _i * 8192), 16, 0, 0); } while (0)
#define PG8_LDA(dst, b, h) do { _Pragma("unroll") for (int m = 0; m < 4; ++m) _Pragma("unroll") for (int k = 0; k < 2; ++k) dst[m][k] = *(const PG8_LAS bf16x8*)(lds + PG8_SA(b, h) + aoff + m * 2048 + k * 1024); } while (0)
#define PG8_LDB(dst, b, h) do { _Pragma("unroll") for (int n = 0; n < 2; ++n) _Pragma("unroll") for (int k = 0; k < 2; ++k) dst[n][k] = *(const PG8_LAS bf16x8*)(lds + PG8_SB(b, h) + boff + n * 2048 + k * 1024); } while (0)
#define PG8_MMA(ai, bj, At, Bt) do { __builtin_amdgcn_s_setprio(1); _Pragma("unroll") for (int m = 0; m < 4; ++m) _Pragma("unroll") for (int n = 0; n < 2; ++n) _Pragma("unroll") for (int k = 0; k < 2; ++k) \
        acc[ai][bj][m][n] = __builtin_amdgcn_mfma_f32_16x16x32_bf16(Bt[n][k], At[m][k], acc[ai][bj][m][n], 0, 0, 0); __builtin_amdgcn_s_setprio(0); } while (0)
#define PG8_WAIT_V(n) asm volatile("s_waitcnt vmcnt(" #n ")" ::: "memory")
#define PG8_WAIT_L(n) asm volatile("s_waitcnt lgkmcnt(" #n ")" ::: "memory")
#define PG8_BAR __builtin_amdgcn_s_barrier()
#define PG8_SCHED __builtin_amdgcn_sched_barrier(0)
    Unit cur, nxt; int ui = 0;
    if (!S.next(0, cur)) return;
    f32x4 acc[2][2][4][2];
#pragma unroll
    for (int a = 0; a < 2; ++a)
#pragma unroll
        for (int b = 0; b < 2; ++b)
#pragma unroll
            for (int m = 0; m < 4; ++m)
#pragma unroll
                for (int n = 0; n < 2; ++n) acc[a][b][m][n] = (f32x4){0.f, 0.f, 0.f, 0.f};
    bf16x8 At[4][2], B0[2][2], B1[2][2];
    const char* cA = (const char*)g.A + (size_t)cur.pm * tsA + (size_t)(cur.pn >> g.ashift) * g.astride; const char* cB = (const char*)g.Bt + (size_t)cur.pn * tsB;
    S.a_ready(cur);
    if constexpr (SP2) {
        PG8_STAGE(PG8_SB(0, 0), cB, voffB); PG8_STAGE(PG8_SB(0, 1), cB + hsB, voffB); PG8_STAGE(PG8_SA(0, 0), cA, voffA); PG8_STAGE(PG8_SA(0, 1), cA + hsA, voffA);
        if (wr == 1) PG8_BAR;
        PG8_WAIT_V(2); PG8_BAR;
        PG8_STAGE(PG8_SB(1, 0), cB + kstepB, voffB); PG8_STAGE(PG8_SA(1, 0), cA + kstep, voffA); PG8_STAGE(PG8_SB(1, 1), cB + hsB + kstepB, voffB);
        PG8_WAIT_V(6); PG8_BAR;
    } else {
        PG8_STAGE(PG8_SB(0, 0), cB, voffB); PG8_STAGE(PG8_SA(0, 0), cA, voffA); PG8_STAGE(PG8_SB(0, 1), cB + hsB, voffB); PG8_STAGE(PG8_SA(0, 1), cA + hsA, voffA);
        if (wr == 1) PG8_BAR;
        PG8_WAIT_V(4); PG8_BAR;
        PG8_STAGE(PG8_SB(1, 0), cB + kstepB, voffB); PG8_STAGE(PG8_SA(1, 0), cA + kstep, voffA); PG8_STAGE(PG8_SB(1, 1), cB + hsB + kstepB, voffB);
        PG8_WAIT_V(6); PG8_BAR;
    }
    for (;;) {
        const bool has_next = S.next(ui + 1, nxt);
        const char* nA = has_next ? (const char*)g.A + (size_t)nxt.pm * tsA + (size_t)(nxt.pn >> g.ashift) * g.astride : cA; const char* nB = has_next ? (const char*)g.Bt + (size_t)nxt.pn * tsB : cB;
        for (int t = 0; t < nt; t += 2) {
            const bool last = (t == nt - 2);
            const char* a1 = cA + (size_t)(t + 1) * kstep;
            const char* a2 = last ? nA : cA + (size_t)(t + 2) * kstep; const char* b2 = last ? nB : cB + (size_t)(t + 2) * kstepB;
            const char* a3 = a2 + kstep; const char* b3 = b2 + kstepB;
            if (last && has_next) S.a_ready(nxt);
            bg.step();
            if constexpr (SP2) {
            PG8_LDB(B0, 0, 0); PG8_LDB(B1, 0, 1); PG8_SCHED; PG8_LDA(At, 0, 0); PG8_STAGE(PG8_SA(1, 1), a1 + hsA, voffA);
            PG8_WAIT_V(8); PG8_WAIT_L(0); PG8_BAR; PG8_MMA(0, 0, At, B0); PG8_MMA(0, 1, At, B1); PG8_BAR; PG8_SCHED;
            PG8_LDA(At, 0, 1); PG8_STAGE(PG8_SB(0, 0), b2, voffB); PG8_STAGE(PG8_SB(0, 1), b2 + hsB, voffB); PG8_STAGE(PG8_SA(0, 0), a2, voffA);
            PG8_WAIT_V(8); PG8_WAIT_L(0); PG8_BAR; PG8_MMA(1, 0, At, B0); PG8_MMA(1, 1, At, B1); PG8_BAR; PG8_SCHED;
            PG8_LDB(B0, 1, 0); PG8_LDB(B1, 1, 1); PG8_SCHED; PG8_LDA(At, 1, 0); PG8_STAGE(PG8_SA(0, 1), a2 + hsA, voffA);
            PG8_WAIT_V(8); PG8_WAIT_L(0); PG8_BAR; PG8_MMA(0, 0, At, B0); PG8_MMA(0, 1, At, B1); PG8_BAR; PG8_SCHED;
            PG8_LDA(At, 1, 1); PG8_STAGE(PG8_SB(1, 0), b3, voffB); PG8_STAGE(PG8_SB(1, 1), b3 + hsB, voffB); PG8_STAGE(PG8_SA(1, 0), a3, voffA);
            PG8_WAIT_V(8); PG8_WAIT_L(0); PG8_BAR; PG8_MMA(1, 0, At, B0); PG8_MMA(1, 1, At, B1); PG8_BAR; PG8_SCHED;
            } else {
            PG8_LDB(B0, 0, 0); PG8_SCHED; PG8_LDA(At, 0, 0); PG8_STAGE(PG8_SA(1, 1), a1 + hsA, voffA);
            PG8_WAIT_L(8); PG8_BAR; PG8_WAIT_L(0); PG8_MMA(0, 0, At, B0); PG8_BAR; PG8_SCHED;
            PG8_LDB(B1, 0, 1); PG8_STAGE(PG8_SB(0, 0), b2, voffB);
            PG8_BAR; PG8_WAIT_L(0); PG8_MMA(0, 1, At, B1); PG8_BAR;
            PG8_LDA(At, 0, 1); PG8_STAGE(PG8_SA(0, 0), a2, voffA);
            PG8_BAR; PG8_WAIT_L(0); PG8_MMA(1, 0, At, B0); PG8_BAR; PG8_SCHED;
            PG8_STAGE(PG8_SB(0, 1), b2 + hsB, voffB);
            PG8_WAIT_V(6); PG8_BAR; PG8_MMA(1, 1, At, B1); PG8_BAR;
            PG8_LDB(B0, 1, 0); PG8_SCHED; PG8_LDA(At, 1, 0); PG8_STAGE(PG8_SA(0, 1), a2 + hsA, voffA);
            PG8_WAIT_L(8); PG8_BAR; PG8_WAIT_L(0); PG8_MMA(0, 0, At, B0); PG8_BAR; PG8_SCHED;
            PG8_LDB(B1, 1, 1); PG8_STAGE(PG8_SB(1, 0), b3, voffB);
            PG8_BAR; PG8_WAIT_L(0); PG8_MMA(0, 1, At, B1); PG8_BAR;
            PG8_LDA(At, 1, 1); PG8_STAGE(PG8_SA(1, 0), a3, voffA);
            PG8_BAR; PG8_WAIT_L(0); PG8_MMA(1, 0, At, B0); PG8_BAR; PG8_SCHED;
            PG8_STAGE(PG8_SB(1, 1), b3 + hsB, voffB);
            PG8_WAIT_V(6); PG8_BAR; PG8_MMA(1, 1, At, B1); PG8_BAR;
            }
        }
        if constexpr (ALIGN_EPI) { if (wr == 0) PG8_BAR; }
        if constexpr (!Epi::AFTER_DRAIN) { E(acc, cur, wr, wc, fr, fq); S.done(cur); }
        if (!has_next) break;
#pragma unroll
        for (int a = 0; a < 2; ++a)
#pragma unroll
            for (int b = 0; b < 2; ++b)
#pragma unroll
                for (int m = 0; m < 4; ++m)
#pragma unroll
                    for (int n = 0; n < 2; ++n) acc[a][b][m][n] = (f32x4){0.f, 0.f, 0.f, 0.f};
        cur = nxt; cA = nA; cB = nB; ++ui;
        if constexpr (ALIGN_EPI) { if (wr == 1) PG8_BAR; }
    }
    bg.flush();
    PG8_WAIT_V(0);
    if constexpr (!ALIGN_EPI) { if (wr == 0) PG8_BAR; }
    PG8_BAR;
    if constexpr (Epi::AFTER_DRAIN) { E.fused(acc, cur, wr, wc, fr, fq, lds, wid, lane); S.done(cur); }
#undef PG8_SA
#undef PG8_SB
#undef PG8_STAGE
#undef PG8_LDA
#undef PG8_LDB
#undef PG8_MMA
#undef PG8_WAIT_V
#undef PG8_WAIT_L
#undef PG8_BAR
#undef PG8_SCHED
}
}

constexpr int D = 4096, NB = 4, SEQ = 2048, MPR = NB * SEQ  , NSMP = 32, MREAL = MPR + NSMP  , MP = 8448  ;
constexpr int HD = 128, NH = 8, GW = NH * HD  , QKVW = 3 * GW  , PW = 2048, INW = 3 * QKVW + PW + 2 * D  , FF = 11008;
constexpr int PHIST = 15;
constexpr float RMS_EPS = 1e-6f;
constexpr size_t O_Y = 0;
constexpr size_t O_KP0 = (size_t)MREAL * D;
constexpr size_t O_VP0 = O_KP0 + (size_t)NB * 128 * GW;
constexpr size_t O_KP1 = O_VP0 + (size_t)NB * 128 * GW;
constexpr size_t O_VP1 = O_KP1 + (size_t)NB * 512 * GW;
constexpr size_t O_KP2 = O_VP1 + (size_t)NB * 512 * GW;
constexpr size_t O_VP2 = O_KP2 + (size_t)NB * 2048 * GW;
constexpr size_t O_PP  = O_VP2 + (size_t)NB * 2048 * GW;
constexpr size_t O_KS0 = O_PP + (size_t)NB * PHIST * PW;
constexpr size_t O_VS0 = O_KS0 + (size_t)NSMP * 128 * GW;
constexpr size_t O_KS1 = O_VS0 + (size_t)NSMP * 128 * GW;
constexpr size_t O_VS1 = O_KS1 + (size_t)NSMP * 512 * GW;
constexpr size_t O_KS2 = O_VS1 + (size_t)NSMP * 512 * GW;
constexpr size_t O_VS2 = O_KS2 + (size_t)NSMP * 2048 * GW;
constexpr size_t O_PS  = O_VS2 + (size_t)NSMP * 2048 * GW;
constexpr size_t O_END = O_PS + (size_t)NSMP * PHIST * PW;

namespace pg8 {
__device__ __forceinline__ float bf_lo(unsigned w) { return __uint_as_float(w << 16); }
__device__ __forceinline__ float bf_hi(unsigned w) { return __uint_as_float(w & 0xffff0000u); }
__device__ __forceinline__ float sigmoidf_(float x) { return __builtin_amdgcn_rcpf(1.0f + __builtin_amdgcn_exp2f(-1.4426950408889634f * x)); }

struct EpiIn {
    static constexpr bool PERM = true, AFTER_DRAIN = false;
    bf16_t *QB; size_t qkv_stride  ; bf16_t* GB; float* UB; float* out; float qscale;
    __device__ __forceinline__ void operator()(const f32x4 (&acc)[2][2][4][2], const Unit& u, int wr, int wc, int fr, int fq) const {
        const int colt = u.pn * BM, cl = wc * 32 + 8 * fq, rbase = u.pm * BM + wr * 64 + fr;
        if (colt < 3 * QKVW) {
            const int which = colt / QKVW, c3 = colt - which * QKVW;
            bf16_t* B = QB + (size_t)which * qkv_stride; const float sc = which == 0 ? qscale : 1.0f;
#pragma unroll
            for (int ai = 0; ai < 2; ++ai)
#pragma unroll
                for (int m = 0; m < 4; ++m) { bf16_t* rowp = B + (size_t)(rbase + ai * HALF + m * 16) * QKVW + c3 + cl;
#pragma unroll
                    for (int bj = 0; bj < 2; ++bj) { const f32x4 v0 = acc[ai][bj][m][0] * sc, v1 = acc[ai][bj][m][1] * sc; u32x4 w;
                        w.x = cvt_pk_bf16(v0[0], v0[1]); w.y = cvt_pk_bf16(v0[2], v0[3]); w.z = cvt_pk_bf16(v1[0], v1[1]); w.w = cvt_pk_bf16(v1[2], v1[3]);
                        *(u32x4*)(rowp + bj * HALF) = w; } }
            if (which != 0) {
                const int g = c3 / GW, cg = c3 - g * GW + cl, W = g == 0 ? 128 : (g == 1 ? 512 : 2048);
                float* op = out + (g == 0 ? (which == 1 ? O_KP0 : O_VP0) : g == 1 ? (which == 1 ? O_KP1 : O_VP1) : (which == 1 ? O_KP2 : O_VP2));
                float* os = out + (g == 0 ? (which == 1 ? O_KS0 : O_VS0) : g == 1 ? (which == 1 ? O_KS1 : O_VS1) : (which == 1 ? O_KS2 : O_VS2));
#pragma unroll
                for (int ai = 0; ai < 2; ++ai)
#pragma unroll
                    for (int m = 0; m < 4; ++m) { const int row = rbase + ai * HALF + m * 16; float* dst = nullptr;
                        if (row < MPR) { const int b = row >> 11, tt = (row & (SEQ - 1)) - (SEQ - W); if (tt >= 0) dst = op + ((size_t)(b * W + tt)) * GW + cg; }
                        else if (row < MREAL) { dst = os + ((size_t)((row - MPR) * W + (W - 1))) * GW + cg; }
                        if (dst) {
#pragma unroll
                            for (int bj = 0; bj < 2; ++bj)
#pragma unroll
                                for (int n = 0; n < 2; ++n) __builtin_nontemporal_store(acc[ai][bj][m][n], (f32x4*)(dst + bj * HALF + 4 * n)); } }
            }
        } else if (colt < 3 * QKVW + PW) {
            const int c = colt - 3 * QKVW + cl;
#pragma unroll
            for (int ai = 0; ai < 2; ++ai)
#pragma unroll
                for (int m = 0; m < 4; ++m) { const int row = rbase + ai * HALF + m * 16; float* up = UB + (size_t)row * PW + c; float* dst = nullptr;
                    if (row < MPR) { const int b = row >> 11, tt = (row & (SEQ - 1)) - (SEQ - PHIST); if (tt >= 0) dst = out + O_PP + ((size_t)(b * PHIST + tt)) * PW + c; }
                    else if (row < MREAL) { dst = out + O_PS + ((size_t)((row - MPR) * PHIST + (PHIST - 1))) * PW + c; }
#pragma unroll
                    for (int bj = 0; bj < 2; ++bj)
#pragma unroll
                        for (int n = 0; n < 2; ++n) { *(f32x4*)(up + bj * HALF + 4 * n) = acc[ai][bj][m][n]; if (dst) *(f32x4*)(dst + bj * HALF + 4 * n) = acc[ai][bj][m][n]; } }
        } else {
            const int c = colt - (3 * QKVW + PW) + cl;
#pragma unroll
            for (int ai = 0; ai < 2; ++ai)
#pragma unroll
                for (int m = 0; m < 4; ++m) { bf16_t* rowp = GB + (size_t)(rbase + ai * HALF + m * 16) * (2 * D) + c;
#pragma unroll
                    for (int bj = 0; bj < 2; ++bj) { const f32x4 v0 = acc[ai][bj][m][0], v1 = acc[ai][bj][m][1]; u32x4 w;
                        w.x = cvt_pk_bf16(sigmoidf_(v0[0]), sigmoidf_(v0[1])); w.y = cvt_pk_bf16(sigmoidf_(v0[2]), sigmoidf_(v0[3]));
                        w.z = cvt_pk_bf16(sigmoidf_(v1[0]), sigmoidf_(v1[1])); w.w = cvt_pk_bf16(sigmoidf_(v1[2]), sigmoidf_(v1[3]));
                        *(u32x4*)(rowp + bj * HALF) = w; } }
        }
    }
};

#define EPI_FENCE() asm volatile("" ::: "memory")
struct EpiPool {
    static constexpr bool PERM = true, AFTER_DRAIN = false;
    const bf16_t* GB; const float* pscale; bf16_t* T;
    __device__ __forceinline__ void operator()(const f32x4 (&acc)[2][2][4][2], const Unit& u, int wr, int wc, int fr, int fq) const {
        const int col0 = u.pn * BM + wc * 32 + 8 * fq, rbase = u.pm * BM + wr * 64 + fr;
        f32x4 sv[2][2];
#pragma unroll
        for (int bj = 0; bj < 2; ++bj)
#pragma unroll
            for (int n = 0; n < 2; ++n) sv[bj][n] = *(const f32x4*)(pscale + col0 + bj * HALF + 4 * n);
#pragma unroll
        for (int ai = 0; ai < 2; ++ai) {
            u32x4 gq[4][2];
#pragma unroll
            for (int m = 0; m < 4; ++m)
#pragma unroll
                for (int bj = 0; bj < 2; ++bj) gq[m][bj] = *(const u32x4*)(GB + (size_t)(rbase + ai * HALF + m * 16) * (2 * D) + D + col0 + bj * HALF);
            EPI_FENCE();
#pragma unroll
            for (int m = 0; m < 4; ++m) { const size_t row = (size_t)(rbase + ai * HALF + m * 16);
#pragma unroll
                for (int bj = 0; bj < 2; ++bj) { const u32x4 g = gq[m][bj];
                    const f32x4 v0 = acc[ai][bj][m][0] * sv[bj][0], v1 = acc[ai][bj][m][1] * sv[bj][1]; u32x4 w;
                    w.x = cvt_pk_bf16(v0[0] * bf_lo(g.x), v0[1] * bf_hi(g.x)); w.y = cvt_pk_bf16(v0[2] * bf_lo(g.y), v0[3] * bf_hi(g.y));
                    w.z = cvt_pk_bf16(v1[0] * bf_lo(g.z), v1[1] * bf_hi(g.z)); w.w = cvt_pk_bf16(v1[2] * bf_lo(g.w), v1[3] * bf_hi(g.w));
                    *(u32x4*)(T + row * D + col0 + bj * HALF) = w; } }
            EPI_FENCE();
        }
    }
};
struct EpiUp {
    static constexpr bool PERM = true, AFTER_DRAIN = false;
    const bf16_t* GB; const bf16_t* T; bf16_t* MIX;
    __device__ __forceinline__ void operator()(const f32x4 (&acc)[2][2][4][2], const Unit& u, int wr, int wc, int fr, int fq) const {
        const int col0 = u.pn * BM + wc * 32 + 8 * fq, rbase = u.pm * BM + wr * 64 + fr;
#pragma unroll
        for (int ai = 0; ai < 2; ++ai) {
            u32x4 gq[4][2], tq[4][2];
#pragma unroll
            for (int m = 0; m < 4; ++m)
#pragma unroll
                for (int bj = 0; bj < 2; ++bj) { const size_t row = (size_t)(rbase + ai * HALF + m * 16);
                    gq[m][bj] = *(const u32x4*)(GB + row * (2 * D) + col0 + bj * HALF); tq[m][bj] = *(const u32x4*)(T + row * D + col0 + bj * HALF); }
            EPI_FENCE();
#pragma unroll
            for (int m = 0; m < 4; ++m) { const size_t row = (size_t)(rbase + ai * HALF + m * 16);
#pragma unroll
                for (int bj = 0; bj < 2; ++bj) { const u32x4 g = gq[m][bj], t = tq[m][bj];
                    const f32x4 v0 = acc[ai][bj][m][0], v1 = acc[ai][bj][m][1]; u32x4 w;
                    w.x = cvt_pk_bf16(v0[0] * bf_lo(g.x) + bf_lo(t.x), v0[1] * bf_hi(g.x) + bf_hi(t.x)); w.y = cvt_pk_bf16(v0[2] * bf_lo(g.y) + bf_lo(t.y), v0[3] * bf_hi(g.y) + bf_hi(t.y));
                    w.z = cvt_pk_bf16(v1[0] * bf_lo(g.z) + bf_lo(t.z), v1[1] * bf_hi(g.z) + bf_hi(t.z)); w.w = cvt_pk_bf16(v1[2] * bf_lo(g.w) + bf_lo(t.w), v1[3] * bf_hi(g.w) + bf_hi(t.w));
                    *(u32x4*)(MIX + row * D + col0 + bj * HALF) = w; } }
            EPI_FENCE();
        }
    }
};
struct EpiOut {
    static constexpr bool PERM = false, AFTER_DRAIN = false;
    const float* xp; const float* xs; float* y; bf16_t* X1B; float* rowss;
    __device__ __forceinline__ void operator()(const f32x4 (&acc)[2][2][4][2], const Unit& u, int wr, int wc, int fr, int fq) const {
        const int col0 = u.pn * BM + wc * 32 + 4 * fq, rbase = u.pm * BM + wr * 64 + fr;
        typedef unsigned u32x2v __attribute__((ext_vector_type(2)));
#pragma unroll
        for (int ai = 0; ai < 2; ++ai) {
            f32x4 xin[4][2][2];
#pragma unroll
            for (int m = 0; m < 4; ++m) { const int row = rbase + ai * HALF + m * 16; const int rc = row < MREAL ? row : MREAL - 1;
                const float* xr = (rc < MPR ? xp + (size_t)rc * D : xs + (size_t)(rc - MPR) * D) + col0;
#pragma unroll
                for (int bj = 0; bj < 2; ++bj)
#pragma unroll
                    for (int n = 0; n < 2; ++n) xin[m][bj][n] = *(const f32x4*)(xr + bj * HALF + n * 16); }
            EPI_FENCE();
#pragma unroll
            for (int m = 0; m < 4; ++m) { const int row = rbase + ai * HALF + m * 16; const bool real = row < MREAL; float ss = 0.f;
#pragma unroll
                for (int bj = 0; bj < 2; ++bj)
#pragma unroll
                    for (int n = 0; n < 2; ++n) { const f32x4 o = acc[ai][bj][m][n] + xin[m][bj][n];
                        if (real) *(f32x4*)(y + (size_t)row * D + col0 + bj * HALF + n * 16) = o;
                        u32x2v w; w.x = cvt_pk_bf16(o[0], o[1]); w.y = cvt_pk_bf16(o[2], o[3]); *(u32x2v*)((char*)X1B + bl_off<false>(row, col0 + bj * HALF + n * 16, D / 64)) = w;
                        ss += (o[0] * o[0] + o[1] * o[1]) + (o[2] * o[2] + o[3] * o[3]); }
                ss += __shfl_xor(ss, 16); ss += __shfl_xor(ss, 32);
                if (fq == 0 && real) atomicAdd(rowss + row, ss); }
            EPI_FENCE();
        }
    }
};
struct EpiFF {
    static constexpr bool PERM = true, AFTER_DRAIN = false;
    const float* rowss; bf16_t* FFB;
    __device__ __forceinline__ void operator()(const f32x4 (&acc)[2][2][4][2], const Unit& u, int wr, int wc, int fr, int fq) const {
        const int col0 = u.pn * HALF + wc * 32 + 8 * fq, rbase = u.pm * BM + wr * 64 + fr;
        float rs[2][4];
#pragma unroll
        for (int ai = 0; ai < 2; ++ai)
#pragma unroll
            for (int m = 0; m < 4; ++m) rs[ai][m] = rowss[rbase + ai * HALF + m * 16];
        EPI_FENCE();
#pragma unroll
        for (int ai = 0; ai < 2; ++ai)
#pragma unroll
            for (int m = 0; m < 4; ++m) { const int row = rbase + ai * HALF + m * 16; const float r = 1.0f / sqrtf(rs[ai][m] * (1.0f / D) + RMS_EPS);
                u32x4 w; float o[8];
#pragma unroll
                for (int n = 0; n < 2; ++n)
#pragma unroll
                    for (int j = 0; j < 4; ++j) { const float gv = acc[ai][0][m][n][j] * r, uv = acc[ai][1][m][n][j] * r; o[4 * n + j] = gv * sigmoidf_(gv) * uv; }
                w.x = cvt_pk_bf16(o[0], o[1]); w.y = cvt_pk_bf16(o[2], o[3]); w.z = cvt_pk_bf16(o[4], o[5]); w.w = cvt_pk_bf16(o[6], o[7]);
                *(u32x4*)(FFB + (size_t)row * FF + col0) = w; }
    }
};
struct EpiDown {
    static constexpr bool PERM = false, AFTER_DRAIN = false;
    float* y;
    __device__ __forceinline__ void operator()(const f32x4 (&acc)[2][2][4][2], const Unit& u, int wr, int wc, int fr, int fq) const {
        const int col0 = u.pn * BM + wc * 32 + 4 * fq, rbase = u.pm * BM + wr * 64 + fr;
#pragma unroll
        for (int ai = 0; ai < 2; ++ai) {
            f32x4 yin[4][2][2];
#pragma unroll
            for (int m = 0; m < 4; ++m) { const int row = rbase + ai * HALF + m * 16; const int rc = row < MREAL ? row : MREAL - 1; const float* yr = y + (size_t)rc * D + col0;
#pragma unroll
                for (int bj = 0; bj < 2; ++bj)
#pragma unroll
                    for (int n = 0; n < 2; ++n) yin[m][bj][n] = *(const f32x4*)(yr + bj * HALF + n * 16); }
            EPI_FENCE();
#pragma unroll
            for (int m = 0; m < 4; ++m) { const int row = rbase + ai * HALF + m * 16;
                if (row < MREAL) { float* yr = y + (size_t)row * D + col0;
#pragma unroll
                    for (int bj = 0; bj < 2; ++bj)
#pragma unroll
                        for (int n = 0; n < 2; ++n) *(f32x4*)(yr + bj * HALF + n * 16) = yin[m][bj][n] + acc[ai][bj][m][n]; } }
            EPI_FENCE();
        }
    }
};
}

constexpr int NWAVES = 8;
#ifndef MK_N_LAUNCHES
#define MK_N_LAUNCHES 1
#endif
constexpr int PER_PHASE = 9;
constexpr int N_LAUNCHES = MK_N_LAUNCHES;

constexpr size_t MiB = 1u << 20;
constexpr size_t al256(size_t x) { return (x + 255) & ~(size_t)255; }
constexpr size_t WS_CTL = 0, CTL_ZERO_BYTES = 1 * MiB;
constexpr size_t WS_WIN  = 1 * MiB;
constexpr size_t WS_WUP  = WS_WIN  + al256((size_t)INW * D * 2);
constexpr size_t WS_WPL  = WS_WUP  + al256((size_t)D * GW * 2);
constexpr size_t WS_WOUT = WS_WPL  + al256((size_t)D * 512 * 2);
constexpr size_t WS_WGU  = WS_WOUT + al256((size_t)D * D * 2);
constexpr size_t WS_WDN  = WS_WGU  + al256((size_t)2 * FF * D * 2);
constexpr size_t WS_HN   = WS_WDN  + al256((size_t)D * FF * 2);
constexpr size_t WS_QB   = WS_HN   + al256((size_t)MP * D * 2);
constexpr size_t WS_KB   = WS_QB   + al256((size_t)MP * QKVW * 2);
constexpr size_t WS_VB   = WS_KB   + al256((size_t)MP * QKVW * 2);
constexpr size_t WS_UB   = WS_VB   + al256((size_t)MP * QKVW * 2);
constexpr size_t WS_GB   = WS_UB   + al256((size_t)MP * PW * 4);
constexpr size_t WS_ATT  = WS_GB   + al256((size_t)MP * 2 * D * 2);
constexpr size_t WS_PL   = WS_ATT  + al256((size_t)MP * GW * 2);
constexpr size_t WS_T    = WS_PL   + al256((size_t)MP * PW * 2);
constexpr size_t WS_MIX  = WS_T    + al256((size_t)MP * D * 2);
constexpr size_t WS_X1B  = WS_MIX  + al256((size_t)MP * D * 2);
constexpr size_t WS_FFB  = WS_X1B  + al256((size_t)MP * D * 2);
constexpr size_t WS_DUMP = WS_FFB  + al256((size_t)MP * FF * 2);
constexpr size_t WS_END  = WS_DUMP + 2 * MiB;
constexpr int CW_BAR = 4096;
constexpr int CW_RSS = 16384;
static_assert((CW_RSS + MP) * 4 <= (int)CTL_ZERO_BYTES && CW_BAR + 3456 <= CW_RSS, "CTL map");

constexpr int RING_OFF = 0, RING_BYTES = 131072;
constexpr int LDSCTL_OFF = RING_BYTES, MISC_OFF = LDSCTL_OFF + 320;
constexpr int LDS_BYTES = 147456;
static_assert(MISC_OFF + 128 <= LDS_BYTES, "LDS map");

#define GAS __attribute__((address_space(1)))
#define LAS __attribute__((address_space(3)))
typedef unsigned short bf16;
typedef unsigned v4u __attribute__((ext_vector_type(4)));
typedef unsigned v2u __attribute__((ext_vector_type(2)));
typedef float f32x4 __attribute__((ext_vector_type(4)));
typedef GAS unsigned gu32;
#define RLX_AGENT __ATOMIC_RELAXED, __HIP_MEMORY_SCOPE_AGENT
#define LDS_WAIT() asm volatile("s_waitcnt lgkmcnt(0)" ::: "memory")
#define VM_WAIT() asm volatile("s_waitcnt vmcnt(0)" ::: "memory")
__device__ __forceinline__ unsigned f2bf(float f) { unsigned u = __builtin_bit_cast(unsigned, f); return (u + 0x7fffu + ((u >> 16) & 1u)) >> 16; }
__device__ __forceinline__ unsigned pk2(float lo, float hi) { return f2bf(lo) | (f2bf(hi) << 16); }
__device__ __forceinline__ float bflo(unsigned w) { return __uint_as_float(w << 16); }
__device__ __forceinline__ float bfhi(unsigned w) { return __uint_as_float(w & 0xffff0000u); }

#define XB_TMO      128
#define XB_XCNT(j)  (256  + 64 * (j))
#define XB_XSUB(j)  (1280 + 64 * (j))
#define XB_XGEN(j)  (2304 + 64 * (j))
#define XB_TOP      3328
#define XB_TOPGEN   3392
#define XCD_BAR_WORDS 3456
#define XB_SPIN_CAP (1u << 18)

__device__ __forceinline__ unsigned xb_ld(unsigned* p)              { return __hip_atomic_load(p, __ATOMIC_RELAXED, __HIP_MEMORY_SCOPE_AGENT); }
__device__ __forceinline__ unsigned xb_add(unsigned* p, unsigned v) { return __hip_atomic_fetch_add(p, v, __ATOMIC_RELAXED, __HIP_MEMORY_SCOPE_AGENT); }
__device__ __forceinline__ unsigned xb_xcc_id() { return (unsigned)__builtin_amdgcn_s_getreg((3 << 11) | 20) & 0xFu; }
#define XB_SPIN(cond, bar) do { unsigned _sp = 0; while (cond) { __builtin_amdgcn_s_sleep(1); \
    if ((++_sp & 255u) == 0u) { if (xb_ld(&(bar)[XB_TMO])) break; if (_sp > XB_SPIN_CAP) { atomicAdd(&(bar)[XB_TMO], 1u); break; } } } } while (0)

struct XcdBarrier {
    unsigned* bar; unsigned x;
    volatile LAS unsigned* st;
};

__device__ __forceinline__ XcdBarrier xcd_barrier_post(unsigned* bar, volatile LAS unsigned* st) {
    XcdBarrier b; b.bar = bar; b.x = xb_xcc_id(); b.st = st;
    if (threadIdx.x == 0) (void)xb_add(&bar[XB_XCNT(b.x)], 1u);
    return b;
}
__device__ __forceinline__ void xcd_barrier_complete(unsigned* bar, unsigned x, unsigned& nloc, unsigned& nx) {
    const unsigned G = gridDim.x * gridDim.y * gridDim.z;
    unsigned sum, cnt, mine, sp = 0u;
    for (;;) {
        sum = 0u; cnt = 0u; mine = 0u;
#pragma unroll
        for (unsigned j = 0; j < 16; ++j) { const unsigned c = xb_ld(&bar[XB_XCNT(j)]); sum += c; cnt += (c > 0u) ? 1u : 0u; mine = (j == x) ? c : mine; }
        if (sum == G) break;
        __builtin_amdgcn_s_sleep(1);
        if ((++sp & 255u) == 0u) { if (xb_ld(&bar[XB_TMO])) break; if (sp > XB_SPIN_CAP) { atomicAdd(&bar[XB_TMO], 1u); break; } }
    }
    nloc = mine > 0u ? mine : 1u; nx = cnt > 0u ? cnt : 1u;
}

__device__ __forceinline__ void xcd_barrier(const XcdBarrier& b) {
    asm volatile("s_waitcnt vmcnt(0)" ::: "memory");
    __syncthreads();
    if (threadIdx.x == 0) {
        unsigned* bar = b.bar;
        __builtin_amdgcn_s_waitcnt(0);
        unsigned nloc = b.st[0], nx = b.st[1];
        if (nloc == 0u) { xcd_barrier_complete(bar, b.x, nloc, nx); b.st[0] = nloc; b.st[1] = nx; }
        const unsigned old = xb_add(&bar[XB_XSUB(b.x)], 1u);
        const unsigned gen = old / nloc;
        if (old + 1u == (gen + 1u) * nloc) {
            __builtin_amdgcn_fence(__ATOMIC_RELEASE, "agent");
            asm volatile("s_waitcnt vmcnt(0)" ::: "memory");
            const unsigned og = xb_add(&bar[XB_TOP], 1u);
            const unsigned tg = og / nx;
            if (og + 1u == (tg + 1u) * nx) xb_add(&bar[XB_TOPGEN], 1u);
            else XB_SPIN(xb_ld(&bar[XB_TOPGEN]) == tg, bar);
            __builtin_amdgcn_fence(__ATOMIC_ACQUIRE, "agent");
            xb_add(&bar[XB_XGEN(b.x)], 1u);
            asm volatile("s_waitcnt vmcnt(0)" ::: "memory");
        } else {
            XB_SPIN(xb_ld(&bar[XB_XGEN(b.x)]) == gen, bar);
            __builtin_amdgcn_fence(__ATOMIC_ACQUIRE, "agent");
            asm volatile("s_waitcnt vmcnt(0)" ::: "memory");
        }
    }
    __syncthreads();
}


struct Frame {
    LAS unsigned char* lds;
    volatile LAS unsigned* MISC;
    gu32* ctl;
    int tid, lane, wave;
    int vcu, G;
    const float *p_XP, *p_XS, *p_CK0, *p_CV0, *p_CK1, *p_CV1, *p_CK2, *p_CV2, *p_SP, *p_NMIX, *p_WIN, *p_WUP, *p_WPOOL, *p_PSCALE, *p_WOUT, *p_NFFN, *p_WG, *p_WU, *p_WD, *p_NFIN;
    float* out; unsigned char* ws;
};
enum { I_XP = 0, I_XS, I_CK0, I_CV0, I_CK1, I_CV1, I_CK2, I_CV2, I_SP, I_NMIX, I_WIN, I_WUP, I_WPOOL, I_PSCALE, I_WOUT, I_NFFN, I_WG, I_WU, I_WD, I_NFIN };

__device__ __forceinline__ float wave_sum(float v) {
#pragma unroll
    for (int o = 1; o < 64; o <<= 1) v += __shfl_xor(v, o);
    return v;
}
__device__ __forceinline__ float wave_max(float v) {
#pragma unroll
    for (int o = 1; o < 64; o <<= 1) v = fmaxf(v, __shfl_xor(v, o));
    return v;
}
template <bool PERM, bool NTST = true>
__device__ __forceinline__ void p0_transpose_item(const float* W, int K, int N, bf16* WT, int k0, int n0, int out_row0, const float* kscale, LAS float* scr, int lane) {
    float wv[32];
#pragma unroll
    for (int i = 0; i < 32; ++i) wv[i] = __builtin_nontemporal_load(W + (size_t)(k0 + 2 * i + (lane >> 5)) * N + n0 + (lane & 31));
    if (kscale) {
#pragma unroll
        for (int i = 0; i < 32; ++i) wv[i] *= kscale[k0 + 2 * i + (lane >> 5)]; }
#pragma unroll
    for (int i = 0; i < 32; ++i) scr[(2 * i + (lane >> 5)) * 33 + (lane & 31)] = wv[i];
    LDS_WAIT(); asm volatile("" ::: "memory");
    const int c = lane & 7;
#pragma unroll
    for (int j = 0; j < 4; ++j) { const int n = (lane >> 3) + 8 * j; const LAS float* s = scr + (8 * c) * 33 + n;
        v4u o; o.x = pk2(s[0 * 33], s[1 * 33]); o.y = pk2(s[2 * 33], s[3 * 33]); o.z = pk2(s[4 * 33], s[5 * 33]); o.w = pk2(s[6 * 33], s[7 * 33]);
        GAS v4u* wp = (GAS v4u*)((GAS char*)WT + pg8::bl_off<PERM>(out_row0 + n, k0 + 8 * c, K >> 6));
        if (NTST) __builtin_nontemporal_store(o, wp); else *wp = o; }
    LDS_WAIT(); asm volatile("" ::: "memory");
}
__device__ __forceinline__ void rms_row_to_bf16(const float* xrow, const float* gain, bf16* obase, int m, int lane) {
    const GAS f32x4* xr = (const GAS f32x4*)xrow + lane; const GAS f32x4* gr = (const GAS f32x4*)gain + lane;
    f32x4 v[16]; float s = 0.f;
#pragma unroll
    for (int j = 0; j < 16; ++j) { v[j] = xr[64 * j]; s += (v[j].x * v[j].x + v[j].y * v[j].y) + (v[j].z * v[j].z + v[j].w * v[j].w); }
    const float rstd = 1.0f / sqrtf(wave_sum(s) * (1.0f / D) + RMS_EPS);
    GAS char* ob = (GAS char*)obase + pg8::bl_off<false>(m, 4 * lane, D / 64);
#pragma unroll
    for (int j = 0; j < 16; ++j) { const f32x4 g = gr[64 * j]; v2u w; w.x = pk2(v[j].x * rstd * g.x, v[j].y * rstd * g.y); w.y = pk2(v[j].z * rstd * g.z, v[j].w * rstd * g.w); *(GAS v2u*)(ob + (size_t)j * (4 * 32768)) = w; }
}
__device__ __forceinline__ void p0_cache_copy(const float* src, float* dst, int W, int gt, int NT) {
    const int per = (W - 1) * 256; const int total = NSMP * per;
    const GAS f32x4* s4 = (const GAS f32x4*)src; GAS f32x4* d4 = (GAS f32x4*)dst;
    for (int i0 = gt; i0 < total; i0 += 4 * NT) {
        f32x4 v[4]; int di[4];
#pragma unroll
        for (int k = 0; k < 4; ++k) { const int i = i0 + k * NT; const int n = i / per, rem = i - n * per; di[k] = n * W * 256 + rem; if (i < total) v[k] = s4[(size_t)di[k] + 256]; }
#pragma unroll
        for (int k = 0; k < 4; ++k) { const int i = i0 + k * NT; if (i < total) d4[(size_t)di[k]] = v[k]; }
    }
}
__device__ __forceinline__ void p0_prologue(Frame& F) {
    LAS float* scr = (LAS float*)(F.lds + RING_OFF + F.wave * 16384);
    const int gw = F.vcu * NWAVES + F.wave, NGW = F.G * NWAVES;
    bf16* WIN = (bf16*)(F.ws + WS_WIN); bf16* WUP = (bf16*)(F.ws + WS_WUP); bf16* WPL = (bf16*)(F.ws + WS_WPL); bf16* WOUT = (bf16*)(F.ws + WS_WOUT); bf16* WGU = (bf16*)(F.ws + WS_WGU); bf16* WDN = (bf16*)(F.ws + WS_WDN);
    constexpr int IT_IN = (D / 64) * (INW / 32), IT_UP = (GW / 64) * (D / 32), IT_PL1 = (512 / 64) * (GW / 32), IT_PL = 4 * IT_PL1, IT_OUT = (D / 64) * (D / 32), IT_G = (D / 64) * (FF / 32), IT_DN = (FF / 64) * (D / 32);
    constexpr int NITEMS = IT_IN + IT_UP + IT_PL + IT_OUT + IT_DN;
    for (int it = gw; it < NITEMS; it += NGW) {
        int r = it;
        if (r < IT_IN) { const int nb = r % (INW / 32), kb = r / (INW / 32); p0_transpose_item<true, false>(F.p_WIN, D, INW, WIN, 64 * kb, 32 * nb, 32 * nb, nullptr, scr, F.lane); continue; } r -= IT_IN;
        if (r < IT_UP) { const int nb = r % (D / 32), kb = r / (D / 32); p0_transpose_item<true>(F.p_WUP, GW, D, WUP, 64 * kb, 32 * nb, 32 * nb, nullptr, scr, F.lane); continue; } r -= IT_UP;
        if (r < IT_PL) { const int g = r / IT_PL1, q = r % IT_PL1, nb = q % (GW / 32), kb = q / (GW / 32);
            p0_transpose_item<true>(F.p_WPOOL + (size_t)g * 512 * GW, 512, GW, WPL, 64 * kb, 32 * nb, g * GW + 32 * nb, nullptr, scr, F.lane); continue; } r -= IT_PL;
        if (r < IT_OUT) { const int nb = r % (D / 32), kb = r / (D / 32); p0_transpose_item<false>(F.p_WOUT, D, D, WOUT, 64 * kb, 32 * nb, 32 * nb, nullptr, scr, F.lane); continue; } r -= IT_OUT;
        { const int nb = r % (D / 32), kb = r / (D / 32); p0_transpose_item<false>(F.p_WD, FF, D, WDN, 64 * kb, 32 * nb, 32 * nb, nullptr, scr, F.lane); }
    }
    bf16* HN = (bf16*)(F.ws + WS_HN);
    for (int m = gw; m < MP; m += NGW) {
        if (m < MPR) rms_row_to_bf16(F.p_XP + (size_t)m * D, F.p_NMIX, HN, m, F.lane);
        else if (m < MREAL) rms_row_to_bf16(F.p_XS + (size_t)(m - MPR) * D, F.p_NMIX, HN, m, F.lane);
        else { GAS char* o = (GAS char*)HN + pg8::bl_off<false>(m, 8 * F.lane, D / 64);
#pragma unroll
            for (int j = 0; j < 8; ++j) *(GAS v4u*)(o + (size_t)j * (8 * 32768)) = (v4u){0u, 0u, 0u, 0u}; }
    }
    const int gt = F.vcu * (NWAVES * 64) + F.tid, NT = F.G * NWAVES * 64;
    { float* rs = (float*)(F.ws + WS_CTL) + CW_RSS; for (int i = gt; i < MP; i += NT) rs[i] = 0.f; }
    { const GAS f32x4* s4 = (const GAS f32x4*)F.p_SP; GAS f32x4* d4 = (GAS f32x4*)(F.out + O_PS); constexpr int per = (PHIST - 1) * (PW / 4), tot = NSMP * per;
      for (int i = gt; i < tot; i += NT) { const int n = i / per, rem = i - n * per; d4[(size_t)n * PHIST * (PW / 4) + rem] = s4[(size_t)n * PHIST * (PW / 4) + (PW / 4) + rem]; } }
}

__device__ __forceinline__ void p2_convert_wgu(Frame& F, LAS float* scr, int gwave, int ngw) {
    bf16* WGU = (bf16*)(F.ws + WS_WGU); constexpr int IT_G = (D / 64) * (FF / 32);
    for (int r = gwave; r < 2 * IT_G; r += ngw) { const int up = r >= IT_G ? 1 : 0, q = r - up * IT_G, nb = q % (FF / 32), kb = q / (FF / 32), n0 = 32 * nb;
        if (up) p0_transpose_item<true>(F.p_WU, D, FF, WGU, 64 * kb, n0, (n0 >> 7) * 256 + (n0 & 127) + 128, F.p_NFFN, scr, F.lane);
        else    p0_transpose_item<true>(F.p_WG, D, FF, WGU, 64 * kb, n0, (n0 >> 7) * 256 + (n0 & 127), F.p_NFFN, scr, F.lane); }
}
__device__ __forceinline__ float alibi_slope_log2e(int g, int h) { return exp2f(-8.0f * (float)(g * 8 + h + 1) / 24.0f) * 1.4426950408889634f; }
__device__ __forceinline__ float dot8(v4u a, v4u b) {
    return (bflo(a.x) * bflo(b.x) + bfhi(a.x) * bfhi(b.x)) + (bflo(a.y) * bflo(b.y) + bfhi(a.y) * bfhi(b.y)) + (bflo(a.z) * bflo(b.z) + bfhi(a.z) * bfhi(b.z)) + (bflo(a.w) * bflo(b.w) + bfhi(a.w) * bfhi(b.w));
}
__device__ __forceinline__ void attn_naive_prompt(const bf16* QB, const bf16* KB, const bf16* VB, bf16* ATT, int m, int j, LAS float* pl, int lane) {
    const int t = m & (SEQ - 1);
    float Mx = -INFINITY, den = 0.f, a0 = 0.f, a1 = 0.f;
#pragma unroll 1
    for (int g = 0; g < 3; ++g) {
        const int d = g == 0 ? 1 : (g == 1 ? 4 : 16); const int tq = t / d; const int nk = (tq < 128 ? tq : 128) + 1;
        const float sl = alibi_slope_log2e(g, j) * (float)d;
        const size_t hoff = (size_t)g * GW + j * HD;
        const GAS v4u* qp = (const GAS v4u*)(QB + (size_t)m * QKVW + hoff);
        float s[3];
#pragma unroll
        for (int i = 0; i < 3; ++i) { const int jj = lane + 64 * i; s[i] = -INFINITY;
            if (jj < nk) { const GAS v4u* kp = (const GAS v4u*)(KB + (size_t)(m - d * jj) * QKVW + hoff); float acc = 0.f;
#pragma unroll
                for (int c = 0; c < 16; ++c) acc += dot8(qp[c], kp[c]);
                s[i] = acc - sl * (float)jj; } }
        const float mg = wave_max(fmaxf(fmaxf(s[0], s[1]), s[2])); const float nM = fmaxf(Mx, mg); const float so = __builtin_amdgcn_exp2f(Mx - nM);
        float ps = 0.f;
#pragma unroll
        for (int i = 0; i < 3; ++i) { const int jj = lane + 64 * i; const float p = (jj < nk) ? __builtin_amdgcn_exp2f(s[i] - nM) : 0.f; ps += p; if (jj < 129) pl[jj] = p; }
        den = den * so + wave_sum(ps); a0 *= so; a1 *= so; Mx = nM;
        LDS_WAIT(); asm volatile("" ::: "memory");
        const GAS unsigned* vp = (const GAS unsigned*)(VB + (size_t)m * QKVW + hoff) + lane;
        for (int jj = 0; jj < nk; ++jj) { const float p = pl[jj]; const unsigned w = vp[-(long)(d * jj) * (QKVW / 2)]; a0 += p * bflo(w); a1 += p * bfhi(w); }
        LDS_WAIT(); asm volatile("" ::: "memory");
    }
    const float inv = 1.0f / den;
    ((GAS unsigned*)(ATT + (size_t)m * GW + j * HD))[lane] = pk2(a0 * inv, a1 * inv);
}
typedef float f32x16 __attribute__((ext_vector_type(16)));
typedef short bf16x8_t __attribute__((ext_vector_type(8)));
typedef short s16x4_t __attribute__((ext_vector_type(4)));
constexpr int VPITCH = 272;
__device__ __forceinline__ int crow16(int i, int h) { return (i & 3) + 8 * (i >> 2) + 4 * h; }
__device__ __forceinline__ unsigned cvtpk(float lo, float hi) { typedef float f2 __attribute__((ext_vector_type(2))); typedef __bf16 b2 __attribute__((ext_vector_type(2))); const f2 v = {lo, hi}; const b2 b = __builtin_convertvector(v, b2); return __builtin_bit_cast(unsigned, b); }
__device__ __forceinline__ s16x4_t vtr(LAS const unsigned char* p) { typedef short v4i16_t __attribute__((ext_vector_type(4))); return __builtin_bit_cast(s16x4_t, __builtin_amdgcn_ds_read_tr16_b64_v4i16((LAS v4i16_t*)p)); }
__device__ __forceinline__ void attn_mfma_tile(const bf16* QB, const bf16* KB, const bf16* VB, bf16* NUM, float* ML, int item, LAS unsigned char* vlds, int lane) {
    const int blk = ((item & 63) + 21 * (item >> 11)) & 63, h = (item >> 6) & 7, bg = item >> 9, g = bg % 3, b = bg / 3;
    const int ds = 2 * g, d = 1 << ds, nbs = 6 - ds, r = blk >> nbs, ib = blk & ((1 << nbs) - 1), i0 = 32 * ib;
    const int r32 = lane & 31, hh = lane >> 5;
    const size_t colbase = (size_t)g * GW + h * HD;
    const int rowb = b * SEQ + r;
    const float sl = alibi_slope_log2e(g, h) * (float)d;
    const int rq = r32 - 4 * hh; const float slrq = sl * (float)rq;
    bf16x8_t qf[8];
    { const bf16* qrow = QB + (size_t)(rowb + d * (i0 + r32)) * QKVW + colbase + 8 * hh;
#pragma unroll
      for (int s_ = 0; s_ < 8; ++s_) qf[s_] = *(const GAS bf16x8_t*)(qrow + 16 * s_); }
    f32x16 S[5];
#pragma unroll
    for (int kb = 0; kb < 5; ++kb) {
        if (ib + kb >= 4) {
            const int kk0 = 32 * (ib + kb - 4);
            const bf16* krow = KB + (size_t)(rowb + d * (kk0 + r32)) * QKVW + colbase + 8 * hh;
            f32x16 acc;
#pragma unroll
            for (int i = 0; i < 16; ++i) acc[i] = 0.f;
#pragma unroll
            for (int s_ = 0; s_ < 8; ++s_) { const bf16x8_t kf = *(const GAS bf16x8_t*)(krow + 16 * s_); acc = __builtin_amdgcn_mfma_f32_32x32x16_bf16(kf, qf[s_], acc, 0, 0, 0); }
#pragma unroll
            for (int i = 0; i < 16; ++i) { const int ci = (i & 3) + 8 * (i >> 2);
                float v = fmaf(-sl, (float)(32 * (4 - kb) - ci), acc[i]) - slrq;
                if (kb == 0 && rq > ci) v = -INFINITY;
                if (kb == 4 && rq < ci) v = -INFINITY;
                acc[i] = v; }
            S[kb] = acc;
        } else {
#pragma unroll
            for (int i = 0; i < 16; ++i) S[kb][i] = -INFINITY;
        }
    }
    float mx = -INFINITY;
#pragma unroll
    for (int kb = 0; kb < 5; ++kb)
#pragma unroll
        for (int i = 0; i < 16; ++i) mx = fmaxf(mx, S[kb][i]);
    mx = fmaxf(mx, __shfl_xor(mx, 32));
    float den = 0.f;
#pragma unroll
    for (int kb = 0; kb < 5; ++kb)
#pragma unroll
        for (int i = 0; i < 16; ++i) { const float p = __builtin_amdgcn_exp2f(S[kb][i] - mx); S[kb][i] = p; den += p; }
    den += __shfl_xor(den, 32);
    f32x16 y[4];
#pragma unroll
    for (int c = 0; c < 4; ++c)
#pragma unroll
        for (int i = 0; i < 16; ++i) y[c][i] = 0.f;
    const int q4 = (lane & 15) >> 2, p4 = lane & 3, bk = (lane >> 4) & 1;
    LAS const unsigned char* vrd = vlds + (4 * hh + q4) * VPITCH + 32 * bk + 8 * p4;
#pragma unroll
    for (int kb = 0; kb < 5; ++kb) {
        if (ib + kb >= 4) {
            const int kk0 = 32 * (ib + kb - 4);
#pragma unroll
            for (int k = 0; k < 8; ++k) { const int id = lane + 64 * k, key = id >> 4, ch = id & 15;
                const v4u v = *(const GAS v4u*)(VB + (size_t)(rowb + d * (kk0 + key)) * QKVW + colbase + 8 * ch);
                *(LAS v4u*)(vlds + key * VPITCH + ch * 16) = v; }
#pragma unroll
            for (int s_ = 0; s_ < 2; ++s_) {
                v4u pk; pk.x = cvtpk(S[kb][8 * s_ + 0], S[kb][8 * s_ + 1]); pk.y = cvtpk(S[kb][8 * s_ + 2], S[kb][8 * s_ + 3]); pk.z = cvtpk(S[kb][8 * s_ + 4], S[kb][8 * s_ + 5]); pk.w = cvtpk(S[kb][8 * s_ + 6], S[kb][8 * s_ + 7]);
                const bf16x8_t xs = __builtin_bit_cast(bf16x8_t, pk);
#pragma unroll
                for (int c = 0; c < 4; ++c) { const s16x4_t lo = vtr(vrd + (16 * s_) * VPITCH + 64 * c), hi = vtr(vrd + (16 * s_ + 8) * VPITCH + 64 * c);
                    const bf16x8_t vf = __builtin_shufflevector(lo, hi, 0, 1, 2, 3, 4, 5, 6, 7);
                    y[c] = __builtin_amdgcn_mfma_f32_32x32x16_bf16(vf, xs, y[c], 0, 0, 0); }
            }
        }
    }
    const int m = rowb + d * (i0 + r32);
    bf16* np = NUM + ((size_t)g * MREAL + m) * GW + h * HD + 4 * hh;
#pragma unroll
    for (int c = 0; c < 4; ++c)
#pragma unroll
        for (int k = 0; k < 4; ++k) { v2u w; w.x = cvtpk(y[c][4 * k + 0], y[c][4 * k + 1]); w.y = cvtpk(y[c][4 * k + 2], y[c][4 * k + 3]); *(GAS v2u*)(np + 32 * c + 8 * k) = w; }
    if (hh == 0) { typedef float f2 __attribute__((ext_vector_type(2))); *(GAS f2*)(ML + (((size_t)g * MREAL + m) * NH + h) * 2) = (f2){mx, den}; }
}
__device__ __forceinline__ void attn_combine(const bf16* NUM, const float* ML, bf16* ATT, int gt, int NT) {
    typedef float f2 __attribute__((ext_vector_type(2)));
    for (int i = gt; i < MREAL * (GW / 8); i += NT) {
        const int m = i >> 7, c8 = i & 127, h = c8 >> 4;
        f2 st[3]; float M = -INFINITY;
#pragma unroll
        for (int g = 0; g < 3; ++g) { st[g] = *(const GAS f2*)(ML + (((size_t)g * MREAL + m) * NH + h) * 2); M = fmaxf(M, st[g].x); }
        float o[8] = {0.f, 0.f, 0.f, 0.f, 0.f, 0.f, 0.f, 0.f}; float dn = 0.f;
#pragma unroll
        for (int g = 0; g < 3; ++g) { const float e = __builtin_amdgcn_exp2f(st[g].x - M); dn += e * st[g].y;
            const v4u w = *(const GAS v4u*)(NUM + ((size_t)g * MREAL + m) * GW + 8 * c8);
            o[0] += e * bflo(w.x); o[1] += e * bfhi(w.x); o[2] += e * bflo(w.y); o[3] += e * bfhi(w.y); o[4] += e * bflo(w.z); o[5] += e * bfhi(w.z); o[6] += e * bflo(w.w); o[7] += e * bfhi(w.w); }
        const float inv = 1.0f / dn; v4u r; r.x = cvtpk(o[0] * inv, o[1] * inv); r.y = cvtpk(o[2] * inv, o[3] * inv); r.z = cvtpk(o[4] * inv, o[5] * inv); r.w = cvtpk(o[6] * inv, o[7] * inv);
        *(GAS v4u*)(ATT + (size_t)m * GW + 8 * c8) = r;
    }
}
template <int G_>
__device__ __forceinline__ void attn_sample_partial(const float* ck, const float* cv, const float* out, const bf16* QB, bf16* NUM, float* ML, int n, int j, LAS float* pl, int lane) {
    constexpr int d = G_ == 0 ? 1 : (G_ == 1 ? 4 : 16), W = G_ == 0 ? 128 : (G_ == 1 ? 512 : 2048);
    constexpr size_t OK_ = G_ == 0 ? O_KS0 : (G_ == 1 ? O_KS1 : O_KS2), OV_ = G_ == 0 ? O_VS0 : (G_ == 1 ? O_VS1 : O_VS2);
    const int m = MPR + n, g4 = lane >> 4, i16 = lane & 15;
    const float* nk_ = out + OK_ + ((size_t)n * W + (W - 1)) * GW + j * HD; const float* nv_ = out + OV_ + ((size_t)n * W + (W - 1)) * GW + j * HD;
    const float* kb = ck + (size_t)n * W * GW + j * HD; const float* vb = cv + (size_t)n * W * GW + j * HD;
    const float sl = alibi_slope_log2e(G_, j) * (float)d;
    float q[8];
    { const v4u w = *(const GAS v4u*)(QB + (size_t)m * QKVW + (size_t)G_ * GW + j * HD + 8 * i16);
      q[0] = bflo(w.x); q[1] = bfhi(w.x); q[2] = bflo(w.y); q[3] = bfhi(w.y); q[4] = bflo(w.z); q[5] = bfhi(w.z); q[6] = bflo(w.w); q[7] = bfhi(w.w); }
    float sc[3] = {-INFINITY, -INFINITY, -INFINITY};
#pragma unroll
    for (int c0 = 0; c0 < 33; c0 += 11) {
        f32x4 ka[11], kc[11];
#pragma unroll
        for (int u = 0; u < 11; ++u) { const int jj = 4 * (c0 + u) + g4; const int jc = jj <= 128 ? jj : 128;
            const float* kp = (jc == 0 ? nk_ : kb + (size_t)(W - d * jc) * GW) + 8 * i16; ka[u] = *(const GAS f32x4*)kp; kc[u] = *(const GAS f32x4*)(kp + 4); }
#pragma unroll
        for (int u = 0; u < 11; ++u) { const int c = c0 + u, jj = 4 * c + g4;
            float sdot = (ka[u].x * q[0] + ka[u].y * q[1]) + (ka[u].z * q[2] + ka[u].w * q[3]) + (kc[u].x * q[4] + kc[u].y * q[5]) + (kc[u].z * q[6] + kc[u].w * q[7]);
            sdot += __shfl_xor(sdot, 1); sdot += __shfl_xor(sdot, 2); sdot += __shfl_xor(sdot, 4); sdot += __shfl_xor(sdot, 8);
            const float sv = jj <= 128 ? sdot - sl * (float)jj : -INFINITY;
            if ((c & 15) == i16) sc[c >> 4] = sv; }
    }
    const float mx = wave_max(fmaxf(fmaxf(sc[0], sc[1]), sc[2]));
    float ps = 0.f;
#pragma unroll
    for (int k = 0; k < 3; ++k) { const int jj = 4 * (i16 + 16 * k) + g4; const float p = __builtin_amdgcn_exp2f(sc[k] - mx); ps += p; if (jj <= 128) pl[jj] = p; }
    const float den = wave_sum(ps);
    LDS_WAIT(); asm volatile("" ::: "memory");
    typedef float f32x2g __attribute__((ext_vector_type(2)));
    float a0 = 0.f, a1 = 0.f;
#pragma unroll 1
    for (int j0 = 0; j0 < 128; j0 += 16) { f32x2g vv[16];
#pragma unroll
        for (int u = 0; u < 16; ++u) { const int jj = j0 + u; const float* vp = jj == 0 ? nv_ : vb + (size_t)(W - d * jj) * GW; vv[u] = ((const GAS f32x2g*)vp)[lane]; }
#pragma unroll
        for (int u = 0; u < 16; ++u) { const float p = pl[j0 + u]; a0 += p * vv[u].x; a1 += p * vv[u].y; } }
    { const f32x2g v128 = ((const GAS f32x2g*)vb)[lane]; const float p = pl[128]; a0 += p * v128.x; a1 += p * v128.y; }
    LDS_WAIT(); asm volatile("" ::: "memory");
    ((GAS unsigned*)(NUM + ((size_t)G_ * MREAL + m) * GW + j * HD))[lane] = cvtpk(a0, a1);
    if (lane == 0) { *(GAS f32x2g*)(ML + (((size_t)G_ * MREAL + m) * NH + j) * 2) = (f32x2g){mx, den}; }
}
template <int WN>
__device__ __forceinline__ void pool_task(const float* UB, const float* sp, bf16* PL, int m, int c) {
    const f32x4 u0 = *(const GAS f32x4*)(UB + (size_t)m * PW + c); f32x4 r[WN - 1]; float wgt[WN - 1]; float cnt;
    if (m < MPR) { const int t = m & (SEQ - 1); cnt = (float)((t < WN - 1 ? t : WN - 1) + 1);
#pragma unroll
        for (int q = 1; q < WN; ++q) { const int qq = q <= t ? q : t; wgt[q - 1] = q <= t ? 1.f : 0.f; r[q - 1] = *(const GAS f32x4*)(UB + (size_t)(m - qq) * PW + c); } }
    else { const int n = m - MPR; cnt = (float)WN;
#pragma unroll
        for (int q = 1; q < WN; ++q) { wgt[q - 1] = 1.f; r[q - 1] = *(const GAS f32x4*)(sp + ((size_t)n * PHIST + (PHIST - q)) * PW + c); } }
    f32x4 tot = u0;
#pragma unroll
    for (int q = 1; q < WN; ++q) tot = tot + r[q - 1] * wgt[q - 1];
    const float ic = 1.0f / cnt; v2u o; o.x = pk2(tot.x * ic - u0.x, tot.y * ic - u0.y); o.y = pk2(tot.z * ic - u0.z, tot.w * ic - u0.w);
    *(GAS v2u*)(PL + (size_t)m * PW + c) = o;
}
template <int WN>
__device__ __forceinline__ void pool_chunk(const float* UB, bf16* PL, int b, int t0, int c) {
    const float* ub = UB + (size_t)b * SEQ * PW + c; bf16* pb = PL + (size_t)b * SEQ * PW + c;
    f32x4 ring[WN]; f32x4 tot = (f32x4){0.f, 0.f, 0.f, 0.f};
    if (t0 != 0) {
#pragma unroll
        for (int j = 0; j < WN; ++j) ring[j] = *(const GAS f32x4*)(ub + (size_t)(t0 - WN + j) * PW);
#pragma unroll
        for (int j = 0; j < WN; ++j) tot = tot + ring[j];
    } else {
#pragma unroll
        for (int j = 0; j < WN; ++j) ring[j] = (f32x4){0.f, 0.f, 0.f, 0.f};
    }
#pragma unroll
    for (int s0 = 0; s0 < 32; s0 += 16) {
        f32x4 nw[16];
#pragma unroll
        for (int u = 0; u < 16; ++u) nw[u] = *(const GAS f32x4*)(ub + (size_t)(t0 + s0 + u) * PW);
#pragma unroll
        for (int u = 0; u < 16; ++u) { const int s_ = s0 + u, t = t0 + s_; const f32x4 x = nw[u];
            tot = tot + (x - ring[s_ % WN]); ring[s_ % WN] = x;
            const int cn = t + 1 < WN ? t + 1 : WN; const float ic = 1.0f / (float)cn;
            v2u o; o.x = pk2(tot.x * ic - x.x, tot.y * ic - x.y); o.y = pk2(tot.z * ic - x.z, tot.w * ic - x.w);
            *(GAS v2u*)(pb + (size_t)t * PW) = o; }
    }
}
__device__ __forceinline__ void pool_naive(const Frame& F, const float* UB, bf16* PL, int gt, int NT) {
    constexpr int C4 = PW / 4, NCH = SEQ / 32;
    for (int i = gt; i < NB * NCH * C4; i += NT) {
        const int c4 = i % C4, rc = (i / C4) % NCH, b = i / (C4 * NCH), c = 4 * c4; const int grp = __builtin_amdgcn_readfirstlane(c >> 9);
        if (grp == 0) pool_chunk<2>(UB, PL, b, 32 * rc, c); else if (grp == 1) pool_chunk<4>(UB, PL, b, 32 * rc, c); else if (grp == 2) pool_chunk<8>(UB, PL, b, 32 * rc, c); else pool_chunk<16>(UB, PL, b, 32 * rc, c);
    }
    for (int i = gt; i < NSMP * C4; i += NT) {
        const int n = i / C4, c = 4 * (i - n * C4); const int grp = __builtin_amdgcn_readfirstlane(c >> 9);
        if (grp == 0) pool_task<2>(UB, F.p_SP, PL, MPR + n, c); else if (grp == 1) pool_task<4>(UB, F.p_SP, PL, MPR + n, c); else if (grp == 2) pool_task<8>(UB, F.p_SP, PL, MPR + n, c); else pool_task<16>(UB, F.p_SP, PL, MPR + n, c);
    }
}
constexpr int SK_RED_PITCH = 33;
template <int NACC, bool PERM, bool AIMG = false>
__device__ __forceinline__ void skinny_partial(const bf16* A, int lda, const bf16* B, int brow0, int K, LAS float* red, int wave, int lane) {
    const int r32 = lane & 31, hh = lane >> 5, ks = K >> 3, nst = ks >> 4, nt = K >> 6; const unsigned ku0 = (unsigned)(__builtin_amdgcn_readfirstlane(wave) * ks);
    const bf16* ap = A + (size_t)r32 * lda + wave * ks + 8 * hh;
    const GAS char* bb = (const GAS char*)B;
    const unsigned rb0 = (unsigned)pg8::bl_off<PERM>(brow0 + r32, 0, nt), x5 = rb0 & 32u, rbase = (rb0 ^ x5) + 16u * (unsigned)hh;
    const unsigned ra0 = (unsigned)pg8::bl_off<false>(MPR + r32, 0, nt), ax5 = ra0 & 32u, aloE = ((ra0 ^ ax5) + 16u * (unsigned)hh) + (ax5 ^ ((ku0 & 16u) << 1)), aloO = aloE ^ 32u;
    const unsigned loE = rbase + (x5 ^ ((ku0 & 16u) << 1)), loO = loE ^ 32u;
    f32x16 acc0, acc1;
#pragma unroll
    for (int i = 0; i < 16; ++i) { acc0[i] = 0.f; acc1[i] = 0.f; }
#pragma unroll 16
    for (int s_ = 0; s_ < nst; ++s_) {
        const unsigned ku = ku0 + 16u * (unsigned)s_; const GAS char* sb = bb + (size_t)((ku >> 6) * 32768u + ((ku >> 5) & 1u) * 1024u); const unsigned bo = (s_ & 1) ? loO : loE;
        const bf16x8_t af = AIMG ? *(const GAS bf16x8_t*)((const GAS char*)A + (size_t)((ku >> 6) * 32768u + ((ku >> 5) & 1u) * 1024u) + ((s_ & 1) ? aloO : aloE)) : *(const GAS bf16x8_t*)(ap + 16 * s_);
        const bf16x8_t bf0 = *(const GAS bf16x8_t*)(sb + bo);
        acc0 = __builtin_amdgcn_mfma_f32_32x32x16_bf16(af, bf0, acc0, 0, 0, 0);
        if (NACC == 2) { const bf16x8_t bf1 = *(const GAS bf16x8_t*)(sb + bo + 16384); acc1 = __builtin_amdgcn_mfma_f32_32x32x16_bf16(af, bf1, acc1, 0, 0, 0); }
    }
    LAS float* rw = red + wave * (NACC * 32 * SK_RED_PITCH);
#pragma unroll
    for (int i = 0; i < 16; ++i) { rw[crow16(i, hh) * SK_RED_PITCH + r32] = acc0[i]; if (NACC == 2) rw[(32 + crow16(i, hh)) * SK_RED_PITCH + r32] = acc1[i]; }
}
template <int NACC>
__device__ __forceinline__ void skinny_reduce(LAS const float* red, int tid, float (&v)[NACC][2]) {
    const int row = tid >> 4, c = (tid & 15) * 2;
#pragma unroll
    for (int a = 0; a < NACC; ++a) { float s0 = 0.f, s1 = 0.f;
#pragma unroll
        for (int w = 0; w < NWAVES; ++w) { const LAS float* p = red + w * (NACC * 32 * SK_RED_PITCH) + (a * 32 + row) * SK_RED_PITCH + c; s0 += p[0]; s1 += p[1]; }
        v[a][0] = s0; v[a][1] = s1; }
}
__device__ __forceinline__ void skinny_share(int nmain, int G, int c, int& idx, int& share) { const int first = nmain % G; if (first == 0) { idx = c; share = G; } else { idx = c - first; share = G - first; } }

__device__ __forceinline__ void final_norm_row(float* yrow, const float* gain, int lane) {
    GAS f32x4* xr = (GAS f32x4*)yrow + lane; const GAS f32x4* gr = (const GAS f32x4*)gain + lane;
    f32x4 v[16]; float s = 0.f;
#pragma unroll
    for (int j = 0; j < 16; ++j) { v[j] = xr[64 * j]; s += (v[j].x * v[j].x + v[j].y * v[j].y) + (v[j].z * v[j].z + v[j].w * v[j].w); }
    const float rstd = 1.0f / sqrtf(wave_sum(s) * (1.0f / D) + RMS_EPS);
#pragma unroll
    for (int j = 0; j < 16; ++j) { const f32x4 g = gr[64 * j]; xr[64 * j] = v[j] * rstd * g; }
}

typedef float f32x2e __attribute__((ext_vector_type(2)));
__device__ __forceinline__ float sigm(float x) { return __builtin_amdgcn_rcpf(1.0f + __builtin_amdgcn_exp2f(-1.4426950408889634f * x)); }
__device__ __forceinline__ void sk_emit_in(bf16* QB, size_t qkv_stride, bf16* GB, float* UB, float* out, float qscale, int n, int col, float v0, float v1) {
    const size_t m = (size_t)(MPR + n);
    if (col < 3 * QKVW) {
        const int which = col / QKVW, c3 = col - which * QKVW; const float sc = which == 0 ? qscale : 1.0f;
        *(GAS unsigned*)(QB + (size_t)which * qkv_stride + m * QKVW + c3) = cvtpk(v0 * sc, v1 * sc);
        if (which != 0) { const int g = c3 / GW, cg = c3 - g * GW, W = g == 0 ? 128 : (g == 1 ? 512 : 2048);
            float* os = out + (g == 0 ? (which == 1 ? O_KS0 : O_VS0) : g == 1 ? (which == 1 ? O_KS1 : O_VS1) : (which == 1 ? O_KS2 : O_VS2)) + ((size_t)n * W + (W - 1)) * GW + cg;
            *(GAS f32x2e*)os = (f32x2e){v0, v1}; }
    } else if (col < 3 * QKVW + PW) {
        const int c = col - 3 * QKVW; *(GAS f32x2e*)(UB + m * PW + c) = (f32x2e){v0, v1}; *(GAS f32x2e*)(out + O_PS + ((size_t)n * PHIST + (PHIST - 1)) * PW + c) = (f32x2e){v0, v1};
    } else { const int c = col - (3 * QKVW + PW); *(GAS unsigned*)(GB + m * (2 * D) + c) = cvtpk(sigm(v0), sigm(v1)); }
}
__device__ __forceinline__ void sk_emit_pool(const bf16* GB, const float* pscale, bf16* T, int n, int col, float v0, float v1) {
    const size_t m = (size_t)(MPR + n); const unsigned g = *(const GAS unsigned*)(GB + m * (2 * D) + D + col); const f32x2e ps = *(const GAS f32x2e*)(pscale + col);
    *(GAS unsigned*)(T + m * D + col) = cvtpk(v0 * ps.x * bflo(g), v1 * ps.y * bfhi(g));
}
__device__ __forceinline__ void sk_emit_up(const bf16* GB, const bf16* T, bf16* MIX, int n, int col, float v0, float v1) {
    const size_t m = (size_t)(MPR + n); const unsigned g = *(const GAS unsigned*)(GB + m * (2 * D) + col), t = *(const GAS unsigned*)(T + m * D + col);
    *(GAS unsigned*)(MIX + m * D + col) = cvtpk(v0 * bflo(g) + bflo(t), v1 * bfhi(g) + bfhi(t));
}
__device__ __forceinline__ void sk_emit_out(const float* xs, float* y, bf16* X1B, float* rowss, int n, int col, float v0, float v1, int tid) {
    const size_t m = (size_t)(MPR + n); const f32x2e x = *(const GAS f32x2e*)(xs + (size_t)n * D + col); const float o0 = x.x + v0, o1 = x.y + v1;
    *(GAS f32x2e*)(y + m * D + col) = (f32x2e){o0, o1}; *(GAS unsigned*)((GAS char*)X1B + pg8::bl_off<false>((int)m, col, D / 64)) = cvtpk(o0, o1);
    float ss = o0 * o0 + o1 * o1; ss += __shfl_xor(ss, 1); ss += __shfl_xor(ss, 2); ss += __shfl_xor(ss, 4); ss += __shfl_xor(ss, 8);
    if ((tid & 15) == 0) atomicAdd(rowss + m, ss);
}
__device__ __forceinline__ void sk_emit_ff(const float* rowss, bf16* FFB, int n, int f, float g0, float g1, float u0, float u1) {
    const size_t m = (size_t)(MPR + n); const float r = 1.0f / sqrtf(rowss[m] * (1.0f / D) + RMS_EPS); g0 *= r; g1 *= r; u0 *= r; u1 *= r;
    *(GAS unsigned*)(FFB + m * FF + f) = cvtpk(g0 * sigm(g0) * u0, g1 * sigm(g1) * u1);
}
__device__ __forceinline__ void sk_emit_down(float* y, int n, int col, float v0, float v1) {
    GAS f32x2e* p = (GAS f32x2e*)(y + (size_t)(MPR + n) * D + col); const f32x2e b = *p; *p = (f32x2e){b.x + v0, b.y + v1};
}

__device__ __forceinline__ int lane_now() { int l; asm volatile("v_mbcnt_lo_u32_b32 %0, -1, 0\n\tv_mbcnt_hi_u32_b32 %0, -1, %0" : "=v"(l)); return l; }
struct BgStream {
    unsigned long long src, dst, pdst, dump;
    unsigned left;
    f32x4 data; unsigned voff;
    __device__ __forceinline__ void init(const float* k0, const float* v0, const float* k1, const float* v1, const float* k2, const float* v2, float* out, unsigned char* dump_, int gwave) {
        dump = (unsigned long long)(uintptr_t)dump_; pdst = dump; src = (unsigned long long)(uintptr_t)k0; dst = dump; left = 0u;
        const int slot = gwave & 31; if (slot >= 24) return;
        const int w = (gwave >> 5) * 24 + slot; const float* sb; size_t db; int W, n, start, count;
        if (w < 1088) { const int t = w / 544, rem = w - t * 544, piece = rem % 17; n = rem / 17; W = 2048; start = piece * 482; count = (start + 482 <= 8188) ? 482 : 8188 - start; if (t == 0) { sb = k2; db = O_KS2; } else { sb = v2; db = O_VS2; } }
        else if (w < 1408) { const int rem0 = w - 1088, t = rem0 / 160, r2 = rem0 - t * 160, piece = r2 % 5; n = r2 / 5; W = 512; start = piece * 409; count = (start + 409 <= 2044) ? 409 : 2044 - start; if (t == 0) { sb = k1; db = O_KS1; } else { sb = v1; db = O_VS1; } }
        else { const int rem0 = w - 1408, t = rem0 >> 6, r2 = rem0 & 63; n = r2 >> 1; W = 128; start = (r2 & 1) * 254; count = 254; if (t == 0) { sb = k0; db = O_KS0; } else { sb = v0; db = O_VS0; } }
        src = (unsigned long long)(uintptr_t)sb + ((size_t)n * W + 1) * 4096 + (size_t)start * 1024; dst = (unsigned long long)(uintptr_t)out + db * 4 + (size_t)n * W * 4096 + (size_t)start * 1024; left = (unsigned)count;
    }
    __device__ __forceinline__ void begin(int lane) { voff = (unsigned)lane * 16u; data = (f32x4){0.f, 0.f, 0.f, 0.f}; pdst = dump; }
    __device__ __forceinline__ void step() {
        if (left) {
            asm volatile("global_store_dwordx4 %1, %0, %2 nt\n\tglobal_load_dwordx4 %0, %1, %3 nt" : "+v"(data) : "v"(voff), "s"(pdst), "s"(src) : "memory");
            pdst = dst; src += 1024; dst += 1024; --left;
        }
    }
    __device__ __forceinline__ void flush() {
        asm volatile("s_waitcnt vmcnt(0)\n\tglobal_store_dwordx4 %1, %0, %2 nt" : : "v"(data), "v"(voff), "s"(pdst) : "memory");
        pdst = dump;
    }
};

struct Args { const float* in[20]; float* out; unsigned char* ws; int ph_lo, ph_hi; };
__global__ void __launch_bounds__(NWAVES * 64, 2) mega_fwd(Args args) {
    extern __shared__ __attribute__((aligned(16))) unsigned char lds[];
    Frame F;
    F.lds = (LAS unsigned char*)lds;
    F.MISC = (volatile LAS unsigned*)(F.lds + MISC_OFF);
    F.tid = threadIdx.x; F.lane = F.tid & 63; F.wave = __builtin_amdgcn_readfirstlane(F.tid >> 6);
    F.G = gridDim.x; { const int bx = blockIdx.x; F.vcu = (F.G % 8 == 0) ? (bx % 8) * (F.G / 8) + bx / 8 : bx; }
    F.ws = args.ws; F.out = args.out; F.ctl = (gu32*)(args.ws + WS_CTL);
    F.p_XP = args.in[I_XP]; F.p_XS = args.in[I_XS]; F.p_CK0 = args.in[I_CK0]; F.p_CV0 = args.in[I_CV0]; F.p_CK1 = args.in[I_CK1]; F.p_CV1 = args.in[I_CV1]; F.p_CK2 = args.in[I_CK2]; F.p_CV2 = args.in[I_CV2]; F.p_SP = args.in[I_SP]; F.p_NMIX = args.in[I_NMIX]; F.p_WIN = args.in[I_WIN]; F.p_WUP = args.in[I_WUP]; F.p_WPOOL = args.in[I_WPOOL]; F.p_PSCALE = args.in[I_PSCALE]; F.p_WOUT = args.in[I_WOUT]; F.p_NFFN = args.in[I_NFFN]; F.p_WG = args.in[I_WG]; F.p_WU = args.in[I_WU]; F.p_WD = args.in[I_WD]; F.p_NFIN = args.in[I_NFIN];
    for (int u = F.tid; u < (LDS_BYTES - LDSCTL_OFF) / 4; u += NWAVES * 64) ((LAS unsigned*)(F.lds + LDSCTL_OFF))[u] = 0u;
    __syncthreads();
    XcdBarrier bar; bar.bar = (unsigned*)(F.ctl + CW_BAR); bar.x = 0; bar.st = nullptr;
    if (N_LAUNCHES != PER_PHASE) bar = xcd_barrier_post((unsigned*)(F.ctl + CW_BAR), F.MISC + 8);
#define GRID_BAR() do { if (N_LAUNCHES != PER_PHASE) xcd_barrier(bar); } while (0)
    const int lo = args.ph_lo, hi = args.ph_hi;
#define IN(k) (lo <= (k) && (k) < hi)
#define BOTH(k) (IN(k) && IN((k) + 1))
    bf16* WIN = (bf16*)(F.ws + WS_WIN); bf16* WUP = (bf16*)(F.ws + WS_WUP); bf16* WPL = (bf16*)(F.ws + WS_WPL); bf16* WOUT = (bf16*)(F.ws + WS_WOUT); bf16* WGU = (bf16*)(F.ws + WS_WGU); bf16* WDN = (bf16*)(F.ws + WS_WDN);
    bf16* HN = (bf16*)(F.ws + WS_HN); bf16* QB = (bf16*)(F.ws + WS_QB); bf16* KB = (bf16*)(F.ws + WS_KB); bf16* VB = (bf16*)(F.ws + WS_VB); float* UB = (float*)(F.ws + WS_UB); bf16* GB = (bf16*)(F.ws + WS_GB);
    bf16* ATT = (bf16*)(F.ws + WS_ATT); bf16* PL = (bf16*)(F.ws + WS_PL); bf16* TB = (bf16*)(F.ws + WS_T); bf16* MIX = (bf16*)(F.ws + WS_MIX); bf16* X1B = (bf16*)(F.ws + WS_X1B); bf16* FFB = (bf16*)(F.ws + WS_FFB);
    float* rowss = (float*)(args.ws + WS_CTL) + CW_RSS;
    bf16* NUMB = (bf16*)(F.ws + WS_FFB); float* MLB = (float*)(F.ws + WS_FFB + 64 * MiB);
    const int gw = F.vcu * NWAVES + F.wave, NGW = F.G * NWAVES;
    pg8::NoBg nobg;
    BgStream bgs; bgs.init(F.p_CK0, F.p_CV0, F.p_CK1, F.p_CV1, F.p_CK2, F.p_CV2, F.out, F.ws + WS_DUMP + (size_t)(F.vcu * NWAVES + F.wave) * 1024, F.vcu * NWAVES + F.wave); bgs.begin(lane_now());
    LAS float* SKRED = (LAS float*)(F.lds + RING_OFF);

    if (IN(0)) { p0_prologue(F); if (BOTH(0)) GRID_BAR(); }

    if (IN(1)) {
        pg8::Gemm g{HN, WIN, D, D, 30, 0}; pg8::StaticOrder S; S.init(MPR, INW, F.G, (int)blockIdx.x);
        static_assert(WS_KB - WS_QB == WS_VB - WS_KB, "q/k/v buffers equally spaced");
        pg8::EpiIn E{QB, (WS_KB - WS_QB) / 2, GB, UB, F.out, 0.08838834764831845f * 1.4426950408889634f};
        pg8::gemm_phase<pg8::EpiIn, pg8::StaticOrder, true, true, pg8::NoBg, true>(F.lds + RING_OFF, g, S, E, nobg);
        { int idx, share; skinny_share((MPR / 256) * (INW / 256), F.G, (int)blockIdx.x, idx, share);
          if (idx >= 0) for (int t = idx; t < INW / 32; t += share) {
              skinny_partial<1, true, true>(HN, D, WIN, 32 * t, D, SKRED, F.wave, F.lane); LDS_WAIT(); __syncthreads();
              float v[1][2]; skinny_reduce<1>(SKRED, F.tid, v);
              sk_emit_in(QB, (WS_KB - WS_QB) / 2, GB, UB, F.out, 0.08838834764831845f * 1.4426950408889634f, F.tid >> 4, 32 * t + 2 * (F.tid & 15), v[0][0], v[0][1]); __syncthreads(); } }
        if (BOTH(1)) GRID_BAR();
    }

    if (IN(2)) {
        LAS unsigned char* wb = F.lds + RING_OFF + F.wave * 16384;
        LAS float* pl = (LAS float*)(wb + 9216);
        _Pragma("unroll 1") for (int ph = 0; ph < 2; ++ph) {
            if ((ph == 0) == (F.wave < 4)) p2_convert_wgu(F, (LAS float*)wb, gw, NGW);
            else { for (int it = gw; it < NB * 3 * NH * 64; it += NGW) attn_mfma_tile(QB, KB, VB, NUMB, MLB, it, wb, F.lane); }
        }
        if (F.wave < 3) { const int t = F.vcu * 3 + F.wave;
            if (t < NSMP * NH * 3) { const int gq = t % 3, nj = t / 3, n = nj >> 3, j = nj & 7;
                if (gq == 0) attn_sample_partial<0>(F.p_CK0, F.p_CV0, F.out, QB, NUMB, MLB, n, j, pl, F.lane);
                else if (gq == 1) attn_sample_partial<1>(F.p_CK1, F.p_CV1, F.out, QB, NUMB, MLB, n, j, pl, F.lane);
                else attn_sample_partial<2>(F.p_CK2, F.p_CV2, F.out, QB, NUMB, MLB, n, j, pl, F.lane); } }
        pool_naive(F, UB, PL, F.vcu * (NWAVES * 64) + F.tid, F.G * NWAVES * 64);
        if (BOTH(2)) GRID_BAR();
    }

    if (IN(3)) {
        attn_combine(NUMB, MLB, ATT, F.vcu * (NWAVES * 64) + F.tid, F.G * NWAVES * 64);
        pg8::Gemm g{PL, WPL, 512, PW, 2, 512 * 2}; pg8::StaticOrder S; S.init(MPR, D, F.G, (int)blockIdx.x);
        pg8::EpiPool E{GB, F.p_PSCALE, TB};
        pg8::gemm_phase<pg8::EpiPool, pg8::StaticOrder, true, true>(F.lds + RING_OFF, g, S, E, nobg);
        { int idx, share; skinny_share((MPR / 256) * (D / 256), F.G, (int)blockIdx.x, idx, share);
          if (idx >= 0) for (int t = idx; t < D / 32; t += share) {
              skinny_partial<1, true>(PL + (size_t)MPR * PW + (t >> 5) * 512, PW, WPL, 32 * t, 512, SKRED, F.wave, F.lane); LDS_WAIT(); __syncthreads();
              float v[1][2]; skinny_reduce<1>(SKRED, F.tid, v);
              sk_emit_pool(GB, F.p_PSCALE, TB, F.tid >> 4, 32 * t + 2 * (F.tid & 15), v[0][0], v[0][1]); __syncthreads(); } }
        if (BOTH(3)) GRID_BAR();
    }
    if (IN(4)) {
        pg8::Gemm g{ATT, WUP, GW, GW, 30, 0}; pg8::StaticOrder S; S.init(MPR, D, F.G, (int)blockIdx.x);
        pg8::EpiUp E{GB, TB, MIX};
        pg8::gemm_phase<pg8::EpiUp, pg8::StaticOrder, true, true>(F.lds + RING_OFF, g, S, E, nobg);
        { int idx, share; skinny_share((MPR / 256) * (D / 256), F.G, (int)blockIdx.x, idx, share);
          if (idx >= 0) for (int t = idx; t < D / 32; t += share) {
              skinny_partial<1, true>(ATT + (size_t)MPR * GW, GW, WUP, 32 * t, GW, SKRED, F.wave, F.lane); LDS_WAIT(); __syncthreads();
              float v[1][2]; skinny_reduce<1>(SKRED, F.tid, v);
              sk_emit_up(GB, TB, MIX, F.tid >> 4, 32 * t + 2 * (F.tid & 15), v[0][0], v[0][1]); __syncthreads(); } }
        if (BOTH(4)) GRID_BAR();
    }

    if (IN(5)) {
        pg8::Gemm g{MIX, WOUT, D, D, 30, 0}; pg8::StaticOrder S; S.init(MPR, D, F.G, (int)blockIdx.x);
        pg8::EpiOut E{F.p_XP, F.p_XS, F.out + O_Y, X1B, rowss};
        pg8::gemm_phase<pg8::EpiOut, pg8::StaticOrder, true, true>(F.lds + RING_OFF, g, S, E, nobg);
        { int idx, share; skinny_share((MPR / 256) * (D / 256), F.G, (int)blockIdx.x, idx, share);
          if (idx >= 0) for (int t = idx; t < D / 32; t += share) {
              skinny_partial<1, false>(MIX + (size_t)MPR * D, D, WOUT, 32 * t, D, SKRED, F.wave, F.lane); LDS_WAIT(); __syncthreads();
              float v[1][2]; skinny_reduce<1>(SKRED, F.tid, v);
              sk_emit_out(F.p_XS, F.out + O_Y, X1B, rowss, F.tid >> 4, 32 * t + 2 * (F.tid & 15), v[0][0], v[0][1], F.tid); __syncthreads(); } }
        if (BOTH(5)) GRID_BAR();
    }

    if (IN(6)) {
        pg8::Gemm g{X1B, WGU, D, D, 30, 0}; pg8::StaticOrder S; S.init(MPR, 2 * FF, F.G, (int)blockIdx.x);
        pg8::EpiFF E{rowss, FFB};
        bgs.begin(lane_now());
        pg8::gemm_phase<pg8::EpiFF, pg8::StaticOrder, true, true, BgStream, true>(F.lds + RING_OFF, g, S, E, bgs);
        { int idx, share; skinny_share((MPR / 256) * (2 * FF / 256), F.G, (int)blockIdx.x, idx, share);
          if (idx >= 0) for (int t = idx; t < FF / 32; t += share) { const int f0 = 32 * t;
              skinny_partial<2, true, true>(X1B, D, WGU, (f0 >> 7) * 256 + (f0 & 127), D, SKRED, F.wave, F.lane); LDS_WAIT(); __syncthreads();
              float v[2][2]; skinny_reduce<2>(SKRED, F.tid, v);
              sk_emit_ff(rowss, FFB, F.tid >> 4, f0 + 2 * (F.tid & 15), v[0][0], v[0][1], v[1][0], v[1][1]); __syncthreads(); } }
        if (BOTH(6)) GRID_BAR();
    }

    if (IN(7)) {
        pg8::Gemm g{FFB, WDN, FF, FF, 30, 0}; pg8::StaticOrder S; S.init(MPR, D, F.G, (int)blockIdx.x);
        pg8::EpiDown E{F.out + O_Y};
        bgs.begin(lane_now());
        pg8::gemm_phase<pg8::EpiDown, pg8::StaticOrder, true, true, BgStream>(F.lds + RING_OFF, g, S, E, bgs);
        { int idx, share; skinny_share((MPR / 256) * (D / 256), F.G, (int)blockIdx.x, idx, share);
          if (idx >= 0) for (int t = idx; t < D / 32; t += share) {
              skinny_partial<1, false>(FFB + (size_t)MPR * FF, FF, WDN, 32 * t, FF, SKRED, F.wave, F.lane); LDS_WAIT(); __syncthreads();
              float v[1][2]; skinny_reduce<1>(SKRED, F.tid, v);
              sk_emit_down(F.out + O_Y, F.tid >> 4, 32 * t + 2 * (F.tid & 15), v[0][0], v[0][1]); __syncthreads(); } }
        if (BOTH(7)) GRID_BAR();
    }

    if (IN(8)) {
        bgs.begin(lane_now());
        while (bgs.left) { asm volatile("s_waitcnt vmcnt(0)" ::: "memory"); bgs.step(); }
        bgs.flush();
        { const int ln = lane_now(); for (int m = gw; m < MREAL; m += NGW) final_norm_row(F.out + O_Y + (size_t)m * D, F.p_NFIN, ln); }
    }
#undef IN
#undef BOTH
#undef GRID_BAR
}

extern "C" void kernel_launch(void* const* d_in, const int* in_sizes, int n_in, void* d_out, int out_size, void* d_ws, size_t ws_size, hipStream_t stream) {
    static int grid = 0;
    if (grid == 0) {
        if (n_in != 20 || in_sizes[0] != MPR * D || (size_t)out_size != O_END || ws_size < WS_END) {
            fprintf(stderr, "kernel_launch: shape mismatch: n_in %d in0 %d out %d (want %zu) ws %zu (want %zu); nothing launched\n", n_in, n_in > 0 ? in_sizes[0] : -1, out_size, (size_t)O_END, ws_size, (size_t)WS_END); grid = -1; return; }
        int dev = 0, cus = 0, per_cu = 0;
        if (hipGetDevice(&dev) != hipSuccess || hipDeviceGetAttribute(&cus, hipDeviceAttributeMultiprocessorCount, dev) != hipSuccess) { grid = -1; return; }
        if (hipFuncSetAttribute((const void*)mega_fwd, hipFuncAttributeMaxDynamicSharedMemorySize, LDS_BYTES) != hipSuccess) { fprintf(stderr, "kernel_launch: hipFuncSetAttribute failed\n"); grid = -1; return; }
        if (hipOccupancyMaxActiveBlocksPerMultiprocessor(&per_cu, (const void*)mega_fwd, NWAVES * 64, LDS_BYTES) != hipSuccess || per_cu < 1) { fprintf(stderr, "kernel_launch: occupancy query says %d blocks per CU\n", per_cu); }
        (void)hipGetLastError();
        grid = cus;
    }
    if (grid < 0) return;
    (void)hipMemsetAsync((char*)d_ws + WS_CTL, 0, CTL_ZERO_BYTES, stream);
    Args a{};
    for (int i = 0; i < 20; ++i) a.in[i] = (const float*)d_in[i];
    a.out = (float*)d_out; a.ws = (unsigned char*)d_ws;
    for (int li = 0; li < N_LAUNCHES; ++li) {
        a.ph_lo = (N_LAUNCHES == PER_PHASE) ? li : 0; a.ph_hi = (N_LAUNCHES == PER_PHASE) ? li + 1 : PER_PHASE;
        hipLaunchKernelGGL(mega_fwd, dim3(grid), dim3(NWAVES * 64), LDS_BYTES, stream, a);
    }
}
```
